# Optimizing an MI355X kernel written in HIP

```python
import math
import jax, jax.numpy as jnp
from jax import lax
import numpy as np

D_MODEL = 1024
BATCH = 8
SEQ = 2048
DEPTH = 2
DEC_BATCH = 128
DEC_SEQ = 4
PAST_LEN = 16384
PAGE_SIZE = 128

MIX_WIDTH = D_MODEL
N_MIXERS = 4
GROUP_WIDTH = MIX_WIDTH // N_MIXERS

SSM_WIDTH = GROUP_WIDTH
SSM_CH = 16
SSM_GROUPS = SSM_WIDTH // SSM_CH
SSM_STATE = 64

HGRN_WIDTH = GROUP_WIDTH
HGRN_HEAD = 64
HGRN_HEADS = HGRN_WIDTH // HGRN_HEAD
HGRN_CHUNK = 32
HGRN_NORM_EPS = 1e-5

RWKV_WIDTH = GROUP_WIDTH
RWKV_HEAD = 64
RWKV_HEADS = RWKV_WIDTH // RWKV_HEAD
DECAY_LORA = 64
AAA_LORA = 64
GATE_LORA = 128
RWKV_PROJ = 3 * RWKV_WIDTH + DECAY_LORA + AAA_LORA + GATE_LORA
RWKV_GN_EPS = 64e-5

POOL_WIDTH = MIX_WIDTH - SSM_WIDTH - HGRN_WIDTH - RWKV_WIDTH
POOL_WINDOWS = (2, 4, 8, 16)
POOL_CH = POOL_WIDTH // 4
POOL_BUF = 16 - 1

D_FF = 4 * D_MODEL
NORM_EPS = 1e-6
PROJ_WIDTH = SSM_WIDTH + 4 * HGRN_WIDTH + RWKV_PROJ + POOL_WIDTH
PROJ_SPLITS = (SSM_WIDTH, SSM_WIDTH + HGRN_WIDTH, SSM_WIDTH + 2 * HGRN_WIDTH, SSM_WIDTH + 3 * HGRN_WIDTH,
               SSM_WIDTH + 4 * HGRN_WIDTH, SSM_WIDTH + 4 * HGRN_WIDTH + RWKV_PROJ)
RWKV_SPLITS = (RWKV_WIDTH, 2 * RWKV_WIDTH, 3 * RWKV_WIDTH, 3 * RWKV_WIDTH + DECAY_LORA,
               3 * RWKV_WIDTH + DECAY_LORA + AAA_LORA)

kernel_name = 'hymba_s5_hgrn2_rwkv7_pool_step'


def _f32(a):
    return a.astype(jnp.float32)


def rmsnorm(x, g, eps=NORM_EPS):
    xf = _f32(x)
    y = xf * lax.rsqrt(jnp.mean(xf * xf, axis=-1, keepdims=True) + eps)
    return (y * _f32(g)).astype(x.dtype)


def s5_mixer(u, h0_re, h0_im, lam_re, lam_im, log_dt, b_re, b_im, c_re, c_im, d_skip, glu_w, glu_b):
    bsz, t_len, _ = u.shape
    uf = _f32(u)
    ug = uf.reshape(bsz, t_len, SSM_GROUPS, SSM_CH)
    lr, li = _f32(lam_re), _f32(lam_im)
    dt = jnp.exp(_f32(log_dt))[:, None]
    mag = jnp.exp(lr * dt)
    ab_re, ab_im = mag * jnp.cos(li * dt), mag * jnp.sin(li * dt)
    den = lr * lr + li * li
    zr, zi = ab_re - 1.0, ab_im
    cr = (zr * lr + zi * li) / den
    ci = (zi * lr - zr * li) / den
    br, bi = _f32(b_re), _f32(b_im)
    bb_re = cr[..., None] * br - ci[..., None] * bi
    bb_im = cr[..., None] * bi + ci[..., None] * br
    bu_re = jnp.einsum('gph,btgh->btgp', bb_re, ug)
    bu_im = jnp.einsum('gph,btgh->btgp', bb_im, ug)
    a_re = jnp.broadcast_to(ab_re, bu_re.shape)
    a_im = jnp.broadcast_to(ab_im, bu_im.shape)

    def combine(e1, e2):
        a1r, a1i, b1r, b1i = e1
        a2r, a2i, b2r, b2i = e2
        return (a2r * a1r - a2i * a1i, a2r * a1i + a2i * a1r,
                a2r * b1r - a2i * b1i + b2r, a2r * b1i + a2i * b1r + b2i)

    _, _, hr, hi = lax.associative_scan(combine, (a_re, a_im, bu_re, bu_im), axis=1)
    steps = jnp.arange(1, t_len + 1, dtype=jnp.float32)[:, None, None]
    pmag = jnp.exp(steps * (lr * dt))
    pw_re = pmag * jnp.cos(steps * (li * dt))
    pw_im = pmag * jnp.sin(steps * (li * dt))
    g_re = _f32(h0_re)[:, None]
    g_im = _f32(h0_im)[:, None]
    hr = hr + pw_re * g_re - pw_im * g_im
    hi = hi + pw_re * g_im + pw_im * g_re
    y = jnp.einsum('ghp,btgp->btgh', _f32(c_re), hr) - jnp.einsum('ghp,btgp->btgh', _f32(c_im), hi)
    y = y.reshape(bsz, t_len, SSM_WIDTH) + _f32(d_skip) * uf
    z = jax.nn.gelu(y)
    out = z * jax.nn.sigmoid(z @ _f32(glu_w) + _f32(glu_b))
    return out, hr[:, -1], hi[:, -1]


def gla_chunked(q, k, v, log_f, s0):
    bsz, t_len, n_h, _ = q.shape
    blk = min(HGRN_CHUNK, t_len)
    n_blk = -(-t_len // blk)
    pad = n_blk * blk - t_len

    def prep(a):
        a = jnp.pad(a, ((0, 0), (0, pad), (0, 0), (0, 0)))
        return a.reshape(bsz, n_blk, blk, n_h, a.shape[-1]).transpose(1, 0, 3, 2, 4)

    qc, kc, vc, gc = prep(q), prep(k), prep(v), prep(log_f)
    causal = jnp.tril(jnp.ones((blk, blk), dtype=bool))[:, :, None]

    def step(S, inp):
        qb, kb, vb, gb = inp
        b = jnp.cumsum(gb, axis=2)
        diff = jnp.where(causal, b[:, :, :, None, :] - b[:, :, None, :, :], -jnp.inf)
        att = jnp.einsum('bhtk,bhsk,bhtsk->bhts', qb, kb, jnp.exp(diff))
        o = jnp.einsum('bhts,bhsv->bhtv', att, vb) + jnp.einsum('bhtk,bhkv->bhtv', qb * jnp.exp(b), S)
        b_last = b[:, :, -1:, :]
        S = jnp.exp(b_last[:, :, 0, :])[..., None] * S + jnp.einsum('bhsk,bhsv->bhkv', kb * jnp.exp(b_last - b), vb)
        return S, o

    s_last, o = lax.scan(step, s0, (qc, kc, vc, gc))
    o = o.transpose(1, 0, 3, 2, 4).reshape(bsz, n_blk * blk, n_h, -1)[:, :t_len]
    return o, s_last


def hgrn2_mixer(p_q, p_f, p_i, p_g, s0, lb, norm_g):
    bsz, t_len, _ = p_q.shape
    hs = (bsz, t_len, HGRN_HEADS, HGRN_HEAD)
    zf = _f32(p_f)
    log_f = jnp.logaddexp(jnp.log1p(-lb) + jax.nn.log_sigmoid(zf), jnp.log(lb))
    k = (1.0 - lb) * jax.nn.sigmoid(-zf)
    q = jax.nn.silu(_f32(p_q))
    o, s_last = gla_chunked(q.reshape(hs), k.reshape(hs), _f32(p_i).reshape(hs), log_f.reshape(hs), _f32(s0))
    o = o * lax.rsqrt(jnp.mean(o * o, axis=-1, keepdims=True) + HGRN_NORM_EPS)
    o = o.reshape(bsz, t_len, HGRN_WIDTH) * _f32(norm_g) * jax.nn.silu(_f32(p_g))
    return o, s_last


def rwkv7_mixer(p, shift_buf, s0, mu, w0, w2, a0, a2, g2, k_k, k_a, r_k, ln_g, ln_b):
    bsz, t_len, _ = p.shape
    pf = _f32(p)
    prev = jnp.concatenate([_f32(shift_buf), pf[:, :-1]], axis=1)
    xs = pf + (prev - pf) * _f32(mu)
    xr, xk, xv, xw, xa, xg = jnp.split(xs, RWKV_SPLITS, axis=-1)
    w = -jax.nn.softplus(-(_f32(w0) + jnp.tanh(xw) @ _f32(w2))) - 0.5
    decay = jnp.exp(-jnp.exp(w))
    a = jax.nn.sigmoid(_f32(a0) + xa @ _f32(a2))
    g = jax.nn.sigmoid(xg) @ _f32(g2)
    hs = (bsz, t_len, RWKV_HEADS, RWKV_HEAD)
    kk = (xk * _f32(k_k)).reshape(hs)
    kk = kk / jnp.maximum(jnp.sqrt(jnp.sum(kk * kk, axis=-1, keepdims=True)), 1e-12)
    k = (xk * (1.0 + (a - 1.0) * _f32(k_a))).reshape(hs)
    r = xr.reshape(hs)
    v = xv.reshape(hs)

    def step(S, inp):
        r_t, w_t, k_t, v_t, kk_t, a_t = inp
        sa = jnp.einsum('bhvk,bhk->bhv', S, -kk_t)
        S = S * w_t[:, :, None, :] + sa[..., None] * (kk_t * a_t)[:, :, None, :] + v_t[..., None] * k_t[:, :, None, :]
        return S, jnp.einsum('bhvk,bhk->bhv', S, r_t)

    seq = tuple(jnp.moveaxis(z, 1, 0) for z in (r, decay.reshape(hs), k, v, kk, a.reshape(hs)))
    s_last, y = lax.scan(step, _f32(s0), seq)
    y = jnp.moveaxis(y, 0, 1)
    mean = jnp.mean(y, axis=-1, keepdims=True)
    var = jnp.mean(jnp.square(y - mean), axis=-1, keepdims=True)
    y = ((y - mean) * lax.rsqrt(var + RWKV_GN_EPS)).reshape(bsz, t_len, RWKV_WIDTH) * _f32(ln_g) + _f32(ln_b)
    bonus = jnp.sum(r * k * _f32(r_k).reshape(RWKV_HEADS, RWKV_HEAD), axis=-1, keepdims=True) * v
    y = (y + bonus.reshape(bsz, t_len, RWKV_WIDTH)) * g
    return y, s_last, pf[:, -1:]


def pool_mixer(u, buf, pos0, w_pool, scale):
    bsz, t_len, _ = u.shape
    ext = jnp.concatenate([_f32(buf), _f32(u)], axis=1)
    cs = jnp.pad(jnp.cumsum(ext, axis=1), ((0, 0), (1, 0), (0, 0)))
    end = cs[:, POOL_BUF + 1:]
    pos = pos0 + jnp.arange(t_len)
    means = []
    for gi, win in enumerate(POOL_WINDOWS):
        sl = slice(gi * POOL_CH, (gi + 1) * POOL_CH)
        s = end[..., sl] - cs[:, POOL_BUF + 1 - win: POOL_BUF + 1 - win + t_len, sl]
        cnt = jnp.minimum(pos + 1, win).astype(jnp.float32)[None, :, None]
        means.append(s / cnt)
    pooled = jnp.concatenate(means, axis=-1) - ext[:, POOL_BUF:]
    y = jnp.einsum('btgc,gcd->btgd', pooled.reshape(bsz, t_len, len(POOL_WINDOWS), POOL_CH), _f32(w_pool))
    y = y.reshape(bsz, t_len, POOL_WIDTH) * _f32(scale)
    return y, ext[:, -POOL_BUF:]


def sqrelu_mlp(x, w_up, w_down):
    return jnp.square(jax.nn.relu(x @ w_up)) @ w_down


def trunk(x, ssm_re0, ssm_im0, hgrn0, wkv0, shift0, pool0, pos0, P):
    lb_all = jnp.cumsum(jax.nn.softmax(_f32(P['hgrn_lb_logits']), axis=0), axis=0)
    lb_all = lb_all - lb_all[:1]
    h = x
    n_re, n_im, n_hg, n_wkv, n_sh, n_pool = [], [], [], [], [], []
    for l in range(DEPTH):
        xn = rmsnorm(h, P['norm1_g'][l])
        proj = xn @ P['w_in'][l]
        p_ssm, p_q, p_f, p_i, p_g, p_rwkv, p_pool = jnp.split(proj, PROJ_SPLITS, axis=-1)
        y_a, s_re, s_im = s5_mixer(p_ssm, ssm_re0[l], ssm_im0[l], P['ssm_lambda_re'][l], P['ssm_lambda_im'][l],
                                   P['ssm_log_dt'][l], P['ssm_b_re'][l], P['ssm_b_im'][l], P['ssm_c_re'][l],
                                   P['ssm_c_im'][l], P['ssm_d'][l], P['ssm_glu_w'][l], P['ssm_glu_b'][l])
        y_b, s_hg = hgrn2_mixer(p_q, p_f, p_i, p_g, hgrn0[l], lb_all[l], P['hgrn_norm_g'][l])
        y_c, s_wkv, s_sh = rwkv7_mixer(p_rwkv, shift0[l], wkv0[l], P['rwkv_mu'][l], P['rwkv_w0'][l], P['rwkv_w2'][l],
                                       P['rwkv_a0'][l], P['rwkv_a2'][l], P['rwkv_g2'][l], P['rwkv_k_k'][l],
                                       P['rwkv_k_a'][l], P['rwkv_r_k'][l], P['rwkv_ln_g'][l], P['rwkv_ln_b'][l])
        y_d, s_pool = pool_mixer(p_pool, pool0[l], pos0, P['pool_w'][l], P['pool_scale'][l])
        mixed = jnp.concatenate([y_a, y_b, y_c, y_d], axis=-1).astype(h.dtype)
        h = h + mixed @ P['w_out'][l]
        h = h + sqrelu_mlp(rmsnorm(h, P['norm2_g'][l]), P['mlp_up'][l], P['mlp_down'][l])
        n_re.append(s_re)
        n_im.append(s_im)
        n_hg.append(s_hg)
        n_wkv.append(s_wkv)
        n_sh.append(s_sh)
        n_pool.append(s_pool)
    y = rmsnorm(h, P['norm_f_g'])
    return y, (jnp.stack(n_re), jnp.stack(n_im), jnp.stack(n_hg), jnp.stack(n_wkv), jnp.stack(n_sh), jnp.stack(n_pool))


def setup_inputs(seed: int = 0) -> dict:
    key = jax.random.key(seed)
    keys = list(jax.random.split(key, 48))

    def nrm(shape, std):
        return std * jax.random.normal(keys.pop(), shape, jnp.float32)

    L = DEPTH
    d = {}
    d['x_prompt'] = nrm((BATCH, SEQ, D_MODEL), 1.0)
    d['x_sample'] = nrm((DEC_BATCH, DEC_SEQ, D_MODEL), 1.0)
    d['state_ssm_re'] = nrm((L, DEC_BATCH, SSM_GROUPS, SSM_STATE), 0.5)
    d['state_ssm_im'] = nrm((L, DEC_BATCH, SSM_GROUPS, SSM_STATE), 0.5)
    d['state_hgrn'] = nrm((L, DEC_BATCH, HGRN_HEADS, HGRN_HEAD, HGRN_HEAD), 0.5)
    d['state_wkv'] = nrm((L, DEC_BATCH, RWKV_HEADS, RWKV_HEAD, RWKV_HEAD), 0.3)
    d['state_shift'] = nrm((L, DEC_BATCH, 1, RWKV_PROJ), 1.0)
    d['state_pool'] = nrm((L, DEC_BATCH, POOL_BUF, POOL_WIDTH), 1.0)
    d['norm1_g'] = 1.0 + nrm((L, D_MODEL), 0.02)
    d['w_in'] = nrm((L, D_MODEL, PROJ_WIDTH), D_MODEL ** -0.5)
    n_idx = jnp.arange(SSM_STATE, dtype=jnp.float32)
    d['ssm_lambda_re'] = -0.5 + nrm((L, SSM_GROUPS, SSM_STATE), 0.01)
    d['ssm_lambda_im'] = jnp.pi * n_idx + nrm((L, SSM_GROUPS, SSM_STATE), 0.01)
    d['ssm_log_dt'] = jax.random.uniform(keys.pop(), (L, SSM_GROUPS), jnp.float32,
                                         minval=math.log(1e-3), maxval=math.log(1e-1))
    d['ssm_b_re'] = nrm((L, SSM_GROUPS, SSM_STATE, SSM_CH), (2 * SSM_CH) ** -0.5)
    d['ssm_b_im'] = nrm((L, SSM_GROUPS, SSM_STATE, SSM_CH), (2 * SSM_CH) ** -0.5)
    d['ssm_c_re'] = nrm((L, SSM_GROUPS, SSM_CH, SSM_STATE), 1.0)
    d['ssm_c_im'] = nrm((L, SSM_GROUPS, SSM_CH, SSM_STATE), 1.0)
    d['ssm_d'] = nrm((L, SSM_WIDTH), 1.0)
    d['ssm_glu_w'] = nrm((L, SSM_WIDTH, SSM_WIDTH), SSM_WIDTH ** -0.5)
    d['ssm_glu_b'] = nrm((L, SSM_WIDTH), 0.01)
    d['hgrn_lb_logits'] = nrm((L, HGRN_WIDTH), 0.1)
    d['hgrn_norm_g'] = 1.0 + nrm((L, HGRN_WIDTH), 0.02)
    d['rwkv_mu'] = jax.random.uniform(keys.pop(), (L, RWKV_PROJ), jnp.float32)
    ratio = jnp.arange(RWKV_WIDTH, dtype=jnp.float32) / (RWKV_WIDTH - 1)
    d['rwkv_w0'] = (-7.0 + 5.0 * ratio ** 0.85 + 0.5) + nrm((L, RWKV_WIDTH), 0.1)
    d['rwkv_w2'] = nrm((L, DECAY_LORA, RWKV_WIDTH), 0.1 * DECAY_LORA ** -0.5)
    d['rwkv_a0'] = nrm((L, RWKV_WIDTH), 0.1)
    d['rwkv_a2'] = nrm((L, AAA_LORA, RWKV_WIDTH), AAA_LORA ** -0.5)
    d['rwkv_g2'] = nrm((L, GATE_LORA, RWKV_WIDTH), GATE_LORA ** -0.5)
    d['rwkv_k_k'] = 0.85 + nrm((L, RWKV_WIDTH), 0.02)
    d['rwkv_k_a'] = 1.0 + nrm((L, RWKV_WIDTH), 0.02)
    d['rwkv_r_k'] = nrm((L, RWKV_WIDTH), 0.1)
    d['rwkv_ln_g'] = 1.0 + nrm((L, RWKV_WIDTH), 0.02)
    d['rwkv_ln_b'] = nrm((L, RWKV_WIDTH), 0.01)
    d['pool_w'] = nrm((L, len(POOL_WINDOWS), POOL_CH, POOL_CH), POOL_CH ** -0.5)
    d['pool_scale'] = 1.0 + nrm((L, POOL_WIDTH), 0.1)
    d['w_out'] = nrm((L, MIX_WIDTH, D_MODEL), MIX_WIDTH ** -0.5)
    d['norm2_g'] = 1.0 + nrm((L, D_MODEL), 0.02)
    d['mlp_up'] = nrm((L, D_MODEL, D_FF), D_MODEL ** -0.5)
    d['mlp_down'] = nrm((L, D_FF, D_MODEL), D_FF ** -0.5)
    d['norm_f_g'] = 1.0 + nrm((D_MODEL,), 0.02)
    return d


def reference(x_prompt, x_sample, state_ssm_re, state_ssm_im, state_hgrn, state_wkv, state_shift, state_pool,
              norm1_g, w_in, ssm_lambda_re, ssm_lambda_im, ssm_log_dt, ssm_b_re, ssm_b_im, ssm_c_re, ssm_c_im,
              ssm_d, ssm_glu_w, ssm_glu_b, hgrn_lb_logits, hgrn_norm_g, rwkv_mu, rwkv_w0, rwkv_w2, rwkv_a0,
              rwkv_a2, rwkv_g2, rwkv_k_k, rwkv_k_a, rwkv_r_k, rwkv_ln_g, rwkv_ln_b, pool_w, pool_scale, w_out,
              norm2_g, mlp_up, mlp_down, norm_f_g):
    P = dict(norm1_g=norm1_g, w_in=w_in, ssm_lambda_re=ssm_lambda_re, ssm_lambda_im=ssm_lambda_im,
             ssm_log_dt=ssm_log_dt, ssm_b_re=ssm_b_re, ssm_b_im=ssm_b_im, ssm_c_re=ssm_c_re, ssm_c_im=ssm_c_im,
             ssm_d=ssm_d, ssm_glu_w=ssm_glu_w, ssm_glu_b=ssm_glu_b, hgrn_lb_logits=hgrn_lb_logits,
             hgrn_norm_g=hgrn_norm_g, rwkv_mu=rwkv_mu, rwkv_w0=rwkv_w0, rwkv_w2=rwkv_w2, rwkv_a0=rwkv_a0,
             rwkv_a2=rwkv_a2, rwkv_g2=rwkv_g2, rwkv_k_k=rwkv_k_k, rwkv_k_a=rwkv_k_a, rwkv_r_k=rwkv_r_k,
             rwkv_ln_g=rwkv_ln_g, rwkv_ln_b=rwkv_ln_b, pool_w=pool_w, pool_scale=pool_scale, w_out=w_out,
             norm2_g=norm2_g, mlp_up=mlp_up, mlp_down=mlp_down, norm_f_g=norm_f_g)
    bp = x_prompt.shape[0]
    f32 = jnp.float32
    y_prompt, st_p = trunk(x_prompt,
                           jnp.zeros((DEPTH, bp, SSM_GROUPS, SSM_STATE), f32),
                           jnp.zeros((DEPTH, bp, SSM_GROUPS, SSM_STATE), f32),
                           jnp.zeros((DEPTH, bp, HGRN_HEADS, HGRN_HEAD, HGRN_HEAD), f32),
                           jnp.zeros((DEPTH, bp, RWKV_HEADS, RWKV_HEAD, RWKV_HEAD), f32),
                           jnp.zeros((DEPTH, bp, 1, RWKV_PROJ), f32),
                           jnp.zeros((DEPTH, bp, POOL_BUF, POOL_WIDTH), f32),
                           0, P)
    y_sample, st_s = trunk(x_sample, state_ssm_re, state_ssm_im, state_hgrn, state_wkv, state_shift, state_pool,
                           PAST_LEN, P)
    p_ssm_re, p_ssm_im, p_hgrn, p_wkv, p_shift, p_pool = st_p
    s_ssm_re, s_ssm_im, s_hgrn, s_wkv, s_shift, s_pool = st_s
    return (y_prompt, y_sample, p_ssm_re, p_ssm_im, p_hgrn, p_wkv, p_shift, p_pool,
            s_ssm_re, s_ssm_im, s_hgrn, s_wkv, s_shift, s_pool)
```

```cpp
#include <hip/hip_runtime.h>
#include <hip/hip_cooperative_groups.h>
#include <cstdio>
#include <cstdint>
namespace cg = cooperative_groups;
__device__ __forceinline__ int otid() { int t = threadIdx.x; asm volatile("" : "+v"(t)); return t; }
namespace pg8 {
#define PG8_LAS __attribute__((address_space(3)))
typedef unsigned short bf16_t;
typedef short bf16x8 __attribute__((ext_vector_type(8)));
typedef float f32x4 __attribute__((ext_vector_type(4)));
typedef unsigned u32x4 __attribute__((ext_vector_type(4)));
constexpr int BM = 256, BK = 64, HALF = 128, HTB = HALF * BK * 2  , STAGE_BYTES = 8 * HTB, NXCD = 8, WGM = 8;

__host__ __device__ __forceinline__ int lds_byte(int r, int c) { const int st = (r >> 4) * 2 + (c >> 5), rr = r & 15, cc = c & 31, ob = rr * 64 + cc * 2; return st * 1024 + (ob ^ (((ob >> 9) & 1) << 5)); }
__host__ __device__ __forceinline__ void stage_rc(int b, int& R, int& C) { const int st = b / 1024, sb = b % 1024, swz = sb ^ (((sb >> 9) & 1) << 5); R = (st >> 1) * 16 + swz / 64; C = (st & 1) * 32 + (swz % 64) / 2; }
__host__ __device__ __forceinline__ int perm32(int rho) { const int n = rho >> 4, i = rho & 15; return 8 * (i >> 2) + 4 * n + (i & 3); }

struct Unit { int pm, pn; };
struct Gemm { const bf16_t* A; const bf16_t* Bt; int M, N, K; };

struct StaticOrder {
    int nM, nN, nwg, G, c;
    __host__ __device__ void init(int M, int N, int G_, int c_) { nM = M / BM; nN = N / BM; nwg = nM * nN; G = G_; c = c_; }
    __host__ __device__ bool next(int i, Unit& u) const {
        const long L = (long)i * G + c; if (L >= nwg) return false;
        int wgid = (int)L; { const int q = nwg / NXCD, r = nwg % NXCD, xcd = wgid % NXCD, off = wgid / NXCD; wgid = (xcd < r ? xcd * (q + 1) : r * (q + 1) + (xcd - r) * q) + off; }
        const int nig = WGM * nN, gid = wgid / nig, fm = gid * WGM, gsz = (nM - fm) < WGM ? (nM - fm) : WGM;
        u.pm = fm + ((wgid % nig) % gsz); u.pn = (wgid % nig) / gsz; return true;
    }
    __device__ __forceinline__ void a_ready(const Unit&) const {}
    __device__ __forceinline__ void done(const Unit&) const {}
};
__device__ __forceinline__ unsigned cvt_pk_bf16(float lo, float hi) { unsigned r; asm volatile("v_cvt_pk_bf16_f32 %0, %1, %2" : "=v"(r) : "v"(lo), "v"(hi)); return r; }
template <int ACT  > struct EpiBf {
    static constexpr bool PERM = true, AFTER_DRAIN = false;
    bf16_t* O; int ldc;
    __device__ __forceinline__ void operator()(const f32x4 (&acc)[2][2][4][2], const Unit& u, int wr, int wc, int fr, int fq) const {
        const int row0 = u.pm * BM + wr * 64 + fr; const int col0 = u.pn * BM + wc * 32 + 8 * fq;
#pragma unroll
        for (int ai = 0; ai < 2; ++ai)
#pragma unroll
            for (int m = 0; m < 4; ++m) { bf16_t* rowp = O + (size_t)(row0 + ai * HALF + m * 16) * ldc + col0;
#pragma unroll
                for (int bj = 0; bj < 2; ++bj) { f32x4 v0 = acc[ai][bj][m][0], v1 = acc[ai][bj][m][1];
                    if (ACT == 1) {
#pragma unroll
                        for (int j = 0; j < 4; ++j) { const float a = fmaxf(v0[j], 0.f), b = fmaxf(v1[j], 0.f); v0[j] = a * a; v1[j] = b * b; } }
                    u32x4 w; w.x = cvt_pk_bf16(v0[0], v0[1]); w.y = cvt_pk_bf16(v0[2], v0[3]); w.z = cvt_pk_bf16(v1[0], v1[1]); w.w = cvt_pk_bf16(v1[2], v1[3]);
                    *(u32x4*)(rowp + bj * HALF) = w; } }
    }
};
struct EpiResid {
    static constexpr bool PERM = false, AFTER_DRAIN = false;
    float* H; int ldc;
    __device__ __forceinline__ void operator()(const f32x4 (&acc)[2][2][4][2], const Unit& u, int wr, int wc, int fr, int fq) const {
        const int row0 = u.pm * BM + wr * 64 + fr, col0 = u.pn * BM + wc * 32 + 4 * fq;
#pragma unroll
        for (int ai = 0; ai < 2; ++ai)
#pragma unroll
            for (int m = 0; m < 4; ++m) { float* rowp = H + (size_t)(row0 + ai * HALF + m * 16) * ldc + col0;
#pragma unroll
                for (int bj = 0; bj < 2; ++bj)
#pragma unroll
                    for (int n = 0; n < 2; ++n) { f32x4* p = (f32x4*)(rowp + bj * HALF + n * 16); *p = *p + acc[ai][bj][m][n]; } }
    }
};

template <class Epi, class Sched, bool STAMP = false>
__device__ __forceinline__ void gemm_phase(PG8_LAS unsigned char* lds, const Gemm g, const Sched& S, const Epi& E, unsigned long long* stamps) {
    const int tid = otid(), wid = __builtin_amdgcn_readfirstlane(tid >> 6), lane = tid & 63, wr = wid >> 2, wc = wid & 3, fr = lane & 15, fq = lane >> 4;
    const int K = g.K, nt = K / BK;
    int ts_lo = 0, ts_hi = 0, nts = 0; const unsigned long long rt_entry = STAMP ? (unsigned long long)wall_clock64() : 0ull;
#define PG8_STAMP() do { if (STAMP && wid == 0 && nts < 64) { const unsigned long long _c = (unsigned long long)clock64(); \
        ts_lo = (lane == nts) ? (int)(unsigned)_c : ts_lo; ts_hi = (lane == nts) ? (int)(unsigned)(_c >> 32) : ts_hi; ++nts; } } while (0)
    PG8_STAMP();
    unsigned voffA[2], voffB[2];
#pragma unroll
    for (int i = 0; i < 2; ++i) { int R, C; stage_rc(tid * 16 + i * 8192, R, C); const int Rb = Epi::PERM ? ((R & ~31) + perm32(R & 31)) : R;
        voffA[i] = (unsigned)(R * K + C) * 2u; voffB[i] = (unsigned)(Rb * K + C) * 2u; }
    const size_t kstep = (size_t)(BK * 2);
    const size_t hstep = (size_t)HALF * K * 2;
    const size_t tstep = 2 * hstep;
    const unsigned ldsw = (unsigned)wid * 1024u;
    const int aoff = lds_byte(wr * 64 + fr, fq * 8), boff = lds_byte(wc * 32 + fr, fq * 8);
#define PG8_SA(b, h) (((b) * 2 + (h)) * HTB)
#define PG8_SB(b, h) ((4 + (b) * 2 + (h)) * HTB)
#define PG8_STAGE(bufoff, gbase, voff) do { _Pragma("unroll") for (int _i = 0; _i < 2; ++_i) \
        __builtin_amdgcn_global_load_lds((const unsigned*)((const char*)(gbase) + (voff)[_i]), (PG8_LAS unsigned*)(lds + (bufoff) + ldsw + _i * 8192), 16, 0, 0); } while (0)
#define PG8_LDA(dst, b, h) do { _Pragma("unroll") for (int m = 0; m < 4; ++m) _Pragma("unroll") for (int k = 0; k < 2; ++k) dst[m][k] = *(const PG8_LAS bf16x8*)(lds + PG8_SA(b, h) + aoff + m * 2048 + k * 1024); } while (0)
#define PG8_LDB(dst, b, h) do { _Pragma("unroll") for (int n = 0; n < 2; ++n) _Pragma("unroll") for (int k = 0; k < 2; ++k) dst[n][k] = *(const PG8_LAS bf16x8*)(lds + PG8_SB(b, h) + boff + n * 2048 + k * 1024); } while (0)
#define PG8_MMA(ai, bj, At, Bt) do { __builtin_amdgcn_s_setprio(1); _Pragma("unroll") for (int m = 0; m < 4; ++m) _Pragma("unroll") for (int n = 0; n < 2; ++n) _Pragma("unroll") for (int k = 0; k < 2; ++k) \
        acc[ai][bj][m][n] = __builtin_amdgcn_mfma_f32_16x16x32_bf16(Bt[n][k], At[m][k], acc[ai][bj][m][n], 0, 0, 0); __builtin_amdgcn_s_setprio(0); } while (0)
#define PG8_WAIT_V(n) asm volatile("s_waitcnt vmcnt(" #n ")" ::: "memory")
#define PG8_WAIT_L(n) asm volatile("s_waitcnt lgkmcnt(" #n ")" ::: "memory")
#define PG8_BAR __builtin_amdgcn_s_barrier()
#define PG8_SCHED __builtin_amdgcn_sched_barrier(0)
    Unit cur, nxt; int ui = 0;
    if (!S.next(0, cur)) return;
    f32x4 acc[2][2][4][2];
#pragma unroll
    for (int a = 0; a < 2; ++a)
#pragma unroll
        for (int b = 0; b < 2; ++b)
#pragma unroll
            for (int m = 0; m < 4; ++m)
#pragma unroll
                for (int n = 0; n < 2; ++n) acc[a][b][m][n] = (f32x4){0.f, 0.f, 0.f, 0.f};
    bf16x8 At[4][2], B0[2][2], B1[2][2];
    const char* cA = (const char*)g.A + (size_t)cur.pm * tstep; const char* cB = (const char*)g.Bt + (size_t)cur.pn * tstep;
    S.a_ready(cur);
    PG8_STAGE(PG8_SB(0, 0), cB, voffB); PG8_STAGE(PG8_SA(0, 0), cA, voffA); PG8_STAGE(PG8_SB(0, 1), cB + hstep, voffB); PG8_STAGE(PG8_SA(0, 1), cA + hstep, voffA);
    if (wr == 1) PG8_BAR;
    PG8_WAIT_V(4); PG8_BAR;
    PG8_STAGE(PG8_SB(1, 0), cB + kstep, voffB); PG8_STAGE(PG8_SA(1, 0), cA + kstep, voffA); PG8_STAGE(PG8_SB(1, 1), cB + hstep + kstep, voffB);
    PG8_WAIT_V(6); PG8_BAR;
    PG8_STAMP();
    for (;;) {
        const bool has_next = S.next(ui + 1, nxt);
        const char* nA = has_next ? (const char*)g.A + (size_t)nxt.pm * tstep : cA; const char* nB = has_next ? (const char*)g.Bt + (size_t)nxt.pn * tstep : cB;
        for (int t = 0; t < nt; t += 2) {
            const bool last = (t == nt - 2);
            const char* a1 = cA + (size_t)(t + 1) * kstep;
            const char* a2 = last ? nA : cA + (size_t)(t + 2) * kstep; const char* b2 = last ? nB : cB + (size_t)(t + 2) * kstep;
            const char* a3 = a2 + kstep; const char* b3 = b2 + kstep;
            if (last && has_next) S.a_ready(nxt);
            PG8_LDB(B0, 0, 0); PG8_SCHED; PG8_LDA(At, 0, 0); PG8_STAGE(PG8_SA(1, 1), a1 + hstep, voffA);
            PG8_WAIT_L(8); PG8_BAR; PG8_WAIT_L(0); PG8_MMA(0, 0, At, B0); PG8_BAR; PG8_SCHED;
            PG8_LDB(B1, 0, 1); PG8_STAGE(PG8_SB(0, 0), b2, voffB);
            PG8_BAR; PG8_WAIT_L(0); PG8_MMA(0, 1, At, B1); PG8_BAR;
            PG8_LDA(At, 0, 1); PG8_STAGE(PG8_SA(0, 0), a2, voffA);
            PG8_BAR; PG8_WAIT_L(0); PG8_MMA(1, 0, At, B0); PG8_BAR; PG8_SCHED;
            PG8_STAGE(PG8_SB(0, 1), b2 + hstep, voffB);
            PG8_WAIT_V(6); PG8_BAR; PG8_MMA(1, 1, At, B1); PG8_BAR;
            PG8_LDB(B0, 1, 0); PG8_SCHED; PG8_LDA(At, 1, 0); PG8_STAGE(PG8_SA(0, 1), a2 + hstep, voffA);
            PG8_WAIT_L(8); PG8_BAR; PG8_WAIT_L(0); PG8_MMA(0, 0, At, B0); PG8_BAR; PG8_SCHED;
            PG8_LDB(B1, 1, 1); PG8_STAGE(PG8_SB(1, 0), b3, voffB);
            PG8_BAR; PG8_WAIT_L(0); PG8_MMA(0, 1, At, B1); PG8_BAR;
            PG8_LDA(At, 1, 1); PG8_STAGE(PG8_SA(1, 0), a3, voffA);
            PG8_BAR; PG8_WAIT_L(0); PG8_MMA(1, 0, At, B0); PG8_BAR; PG8_SCHED;
            PG8_STAGE(PG8_SB(1, 1), b3 + hstep, voffB);
            PG8_WAIT_V(6); PG8_BAR; PG8_MMA(1, 1, At, B1); PG8_BAR;
        }
        PG8_STAMP();
        if constexpr (!Epi::AFTER_DRAIN) { E(acc, cur, wr, wc, fr, fq); S.done(cur); }
        PG8_STAMP();
        if (!has_next) break;
#pragma unroll
        for (int a = 0; a < 2; ++a)
#pragma unroll
            for (int b = 0; b < 2; ++b)
#pragma unroll
                for (int m = 0; m < 4; ++m)
#pragma unroll
                    for (int n = 0; n < 2; ++n) acc[a][b][m][n] = (f32x4){0.f, 0.f, 0.f, 0.f};
        cur = nxt; cA = nA; cB = nB; ++ui;
    }
    PG8_WAIT_V(0);
    if (wr == 0) PG8_BAR;
    PG8_BAR;
    if constexpr (Epi::AFTER_DRAIN) { E.fused(acc, cur, wr, wc, fr, fq, lds, wid, lane); S.done(cur); }
    PG8_STAMP();
    if (STAMP && wid == 0) { stamps[lane] = lane < nts ? (((unsigned long long)(unsigned)ts_hi << 32) | (unsigned)ts_lo) : 0ull;
        if (lane == 62) stamps[62] = rt_entry; if (lane == 63) stamps[63] = (unsigned long long)wall_clock64(); }
#undef PG8_STAMP
#undef PG8_SA
#undef PG8_SB
#undef PG8_STAGE
#undef PG8_LDA
#undef PG8_LDB
#undef PG8_MMA
#undef PG8_WAIT_V
#undef PG8_WAIT_L
#undef PG8_BAR
#undef PG8_SCHED
}
}
using pg8::bf16_t; using pg8::bf16x8; using pg8::f32x4; using pg8::u32x4; using pg8::cvt_pk_bf16;
typedef unsigned u32x2 __attribute__((ext_vector_type(2)));
typedef float f32x2v __attribute__((ext_vector_type(2)));

constexpr int MT = 16896, MP = 16384;
constexpr size_t OFF_PROJ = 0;
constexpr size_t OFF_MIXED = 86507520;
constexpr size_t OFF_RW = 121110528;
constexpr size_t RWSZ = (size_t)MT * 256;
constexpr size_t OFF_Y = 224919552;
constexpr size_t OFF_UPT = OFF_Y, OFF_DOWNT = OFF_Y + 8388608;
constexpr size_t OFF_WINT = 242221056;
constexpr size_t OFF_WOUTT = 247463936;
constexpr size_t OFF_HST = 249561088;
constexpr size_t OFF_HD = 257949696;
constexpr size_t OFF_S5E = 258080768;
constexpr size_t OFF_C12 = 260177920;
constexpr size_t OFF_S5C = 261259264;
constexpr size_t OFF_CMT = OFF_S5C + 147456;
constexpr size_t OFF_GLUT = OFF_CMT + 65536;
constexpr size_t OFF_W2T = OFF_GLUT + 131072;
constexpr size_t OFF_A2T = OFF_W2T + 32768;
constexpr size_t OFF_G2T = OFF_A2T + 32768;
constexpr size_t OFF_PWT = OFF_G2T + 65536;
constexpr size_t OFF_LB = OFF_PWT + 32768;
constexpr size_t OFF_CTR = OFF_LB + 1024;
constexpr size_t OFF_HIDDEN = 0;
constexpr size_t OFF_XN2 = 138412032;
constexpr size_t WS_END = OFF_CTR + 256;
constexpr size_t O_PSRE = 17301504, O_PSIM = O_PSRE + 16384, O_PHG = O_PSIM + 16384, O_PWKV = O_PHG + 262144, O_PSH = O_PWKV + 262144, O_PPOOL = O_PSH + 16384,
    O_SSRE = O_PPOOL + 61440, O_SSIM = O_SSRE + 262144, O_SHG = O_SSIM + 262144, O_SWKV = O_SHG + 4194304, O_SSH = O_SWKV + 4194304, O_SPOOL = O_SSH + 262144;
constexpr int LDS_BYTES = 131072 + 1024;
constexpr int LDS_TASK_OFF = 131072;

struct Params { const float* in[40]; float* out; unsigned char* ws; };

__device__ __forceinline__ float bf2f(bf16_t v) { return __uint_as_float(((unsigned)v) << 16); }
__device__ __forceinline__ float bflo(unsigned w) { return __uint_as_float(w << 16); }
__device__ __forceinline__ float bfhi(unsigned w) { return __uint_as_float(w & 0xffff0000u); }
__device__ __forceinline__ bf16_t f2bf(float f) { return (bf16_t)(cvt_pk_bf16(f, 0.f) & 0xffffu); }
__device__ __forceinline__ void unpack8(const u32x4 v, float* o) { o[0] = bflo(v.x); o[1] = bfhi(v.x); o[2] = bflo(v.y); o[3] = bfhi(v.y); o[4] = bflo(v.z); o[5] = bfhi(v.z); o[6] = bflo(v.w); o[7] = bfhi(v.w); }
__device__ __forceinline__ void unpack4(const u32x2 v, float* o) { o[0] = bflo(v.x); o[1] = bfhi(v.x); o[2] = bflo(v.y); o[3] = bfhi(v.y); }
__device__ __forceinline__ u32x2 pack4(const float* o) { u32x2 r; r.x = cvt_pk_bf16(o[0], o[1]); r.y = cvt_pk_bf16(o[2], o[3]); return r; }
__device__ __forceinline__ float sigm(float x) { return 1.f / (1.f + __expf(-x)); }
__device__ __forceinline__ float tanh_(float x) { return 1.f - 2.f / (1.f + __expf(2.f * x)); }
__device__ __forceinline__ float gelu_t(float x) { return 0.5f * x * (1.f + tanh_(0.7978845608f * (x + 0.044715f * x * x * x))); }
__device__ __forceinline__ float wave_sum(float v) {
#pragma unroll
    for (int o = 1; o < 64; o <<= 1) v += __shfl_xor(v, o);
    return v; }
__device__ __forceinline__ void row_info(int r, int& b, int& t, bool& pr) { pr = r < MP; if (pr) { b = r >> 11; t = r & 2047; } else { b = (r - MP) >> 2; t = (r - MP) & 3; } }
#define MFMA16(a, b, c) __builtin_amdgcn_mfma_f32_16x16x32_bf16((a), (b), (c), 0, 0, 0)
#define LDSWAIT() asm volatile("s_waitcnt lgkmcnt(0)" ::: "memory")

__device__ __forceinline__ void transpose_item(const float* W, int K, int N, bf16_t* WT, float* scr, int item, int lane) {
    const int nblk = N >> 5, kb = item / nblk, nb = item - kb * nblk, k0 = kb << 6, n0 = nb << 5;
#pragma unroll 8
    for (int i = 0; i < 32; ++i) { const int kk = 2 * i + (lane >> 5); scr[kk * 33 + (lane & 31)] = W[(size_t)(k0 + kk) * N + n0 + (lane & 31)]; }
    LDSWAIT();
    const int c = lane & 7;
#pragma unroll
    for (int j = 0; j < 4; ++j) { const int n = (lane >> 3) + 8 * j; const float* s = scr + (8 * c) * 33 + n;
        u32x4 o; o.x = cvt_pk_bf16(s[0], s[33]); o.y = cvt_pk_bf16(s[66], s[99]); o.z = cvt_pk_bf16(s[132], s[165]); o.w = cvt_pk_bf16(s[198], s[231]);
        *(u32x4*)(WT + (size_t)(n0 + n) * K + k0 + 8 * c) = o; }
    LDSWAIT();
}
__device__ __forceinline__ void norm_rows(const Params& P, int l, int which) {
    const int tid = otid(), lane = tid & 63, wave = tid >> 6, gw = blockIdx.x * 8 + wave, NGW = gridDim.x * 8;
    const float* g = which == 0 ? P.in[8] + l * 1024 : (which == 1 ? P.in[36] + l * 1024 : P.in[39]);
    bf16_t* XN = (bf16_t*)(P.ws + (which == 0 ? OFF_MIXED : OFF_XN2));
    for (int r = gw; r < MT; r += NGW) {
        float* hrow = P.out + (size_t)r * 1024;
        const float* src = hrow;
        if (which == 0 && l == 0) src = (r < MP) ? P.in[0] + (size_t)r * 1024 : P.in[1] + (size_t)(r - MP) * 1024;
        f32x4 v[4]; float s = 0.f;
#pragma unroll
        for (int j = 0; j < 4; ++j) { v[j] = ((const f32x4*)src)[lane + 64 * j]; s += v[j].x * v[j].x + v[j].y * v[j].y + v[j].z * v[j].z + v[j].w * v[j].w; }
        s = wave_sum(s);
        const float rstd = rsqrtf(s * (1.f / 1024.f) + 1e-6f);
#pragma unroll
        for (int j = 0; j < 4; ++j) {
            const f32x4 gg = ((const f32x4*)g)[lane + 64 * j];
            if (which == 0 && l == 0) ((f32x4*)hrow)[lane + 64 * j] = v[j];
            f32x4 o = v[j] * rstd * gg;
            if (which == 2) ((f32x4*)hrow)[lane + 64 * j] = o;
            else { u32x2 w; w.x = cvt_pk_bf16(o.x, o.y); w.y = cvt_pk_bf16(o.z, o.w); *(u32x2*)(XN + (size_t)r * 1024 + (lane + 64 * j) * 4) = w; }
        }
    }
}
__device__ __forceinline__ void phaseA(const Params& P, int l, unsigned char* smem) {
    const int tid = otid(), lane = tid & 63, wave = tid >> 6, gw = blockIdx.x * 8 + wave, NGW = gridDim.x * 8;
    norm_rows(P, l, 0);
    float* scr = (float*)smem + wave * (64 * 33);
    for (int it = gw; it < 1280 + 512; it += NGW) {
        if (it < 1280) transpose_item(P.in[9] + (size_t)l * 1024 * 2560, 1024, 2560, (bf16_t*)(P.ws + OFF_WINT), scr, it, lane);
        else transpose_item(P.in[35] + (size_t)l * 1024 * 1024, 1024, 1024, (bf16_t*)(P.ws + OFF_WOUTT), scr, it - 1280, lane);
    }
    const int gt = blockIdx.x * 512 + tid, NT = gridDim.x * 512;
    float* S5C = (float*)(P.ws + OFF_S5C);
    for (int idx = gt; idx < 1024; idx += NT) {
        const int g = idx >> 6;
        const float lr = P.in[10][l * 1024 + idx], li = P.in[11][l * 1024 + idx], dt = expf(P.in[12][l * 16 + g]);
        const float mag = expf(lr * dt); float sn, cs; sincosf(li * dt, &sn, &cs);
        const float abr = mag * cs, abi = mag * sn;
        const float magL = expf(64.f * lr * dt); float snL, csL; sincosf(64.f * li * dt, &snL, &csL);
        S5C[idx] = abr; S5C[1024 + idx] = abi; S5C[2048 + idx] = magL * csL; S5C[3072 + idx] = magL * snL;
        const float den = lr * lr + li * li, zr = abr - 1.f, zi = abi;
        const float cr = (zr * lr + zi * li) / den, ci = (zi * lr - zr * li) / den;
        const float* br = P.in[13] + ((size_t)l * 1024 + idx) * 16; const float* bi = P.in[14] + ((size_t)l * 1024 + idx) * 16;
        for (int h = 0; h < 16; ++h) { S5C[4096 + idx * 16 + h] = cr * br[h] - ci * bi[h]; S5C[4096 + 16384 + idx * 16 + h] = cr * bi[h] + ci * br[h]; }
    }
    bf16_t* CMT = (bf16_t*)(P.ws + OFF_CMT);
    for (int idx = gt; idx < 32768; idx += NT) { const int gh = idx >> 7, pp = idx & 127;
        const float v = pp < 64 ? P.in[15][((size_t)l * 256 + gh) * 64 + pp] : -P.in[16][((size_t)l * 256 + gh) * 64 + pp - 64]; CMT[idx] = f2bf(v); }
    bf16_t* GLUT = (bf16_t*)(P.ws + OFF_GLUT);
    for (int idx = gt; idx < 65536; idx += NT) { const int n = idx >> 8, k = idx & 255; GLUT[idx] = f2bf(P.in[18][(size_t)l * 65536 + k * 256 + n]); }
    bf16_t* W2T = (bf16_t*)(P.ws + OFF_W2T); bf16_t* A2T = (bf16_t*)(P.ws + OFF_A2T); bf16_t* G2T = (bf16_t*)(P.ws + OFF_G2T); bf16_t* PWT = (bf16_t*)(P.ws + OFF_PWT);
    for (int idx = gt; idx < 16384; idx += NT) { const int c = idx >> 6, j = idx & 63;
        W2T[idx] = f2bf(P.in[24][(size_t)l * 16384 + j * 256 + c]); A2T[idx] = f2bf(P.in[26][(size_t)l * 16384 + j * 256 + c]);
        const int gi = idx >> 12, d = (idx >> 6) & 63, cc = idx & 63; PWT[idx] = f2bf(P.in[33][(size_t)l * 16384 + gi * 4096 + cc * 64 + d]); }
    for (int idx = gt; idx < 32768; idx += NT) { const int c = idx >> 7, j = idx & 127; G2T[idx] = f2bf(P.in[27][(size_t)l * 32768 + j * 256 + c]); }
    float* LB = (float*)(P.ws + OFF_LB);
    for (int idx = gt; idx < 256; idx += NT) LB[idx] = (l == 0) ? 0.f : sigm(P.in[20][256 + idx] - P.in[20][idx]);
    if (gt == 0) { ((unsigned*)(P.ws + OFF_CTR))[l] = 0u; }
}
__device__ __forceinline__ void phaseG(const Params& P, int l, unsigned char* smem) {
    const int tid = otid(), lane = tid & 63, wave = tid >> 6, gw = blockIdx.x * 8 + wave, NGW = gridDim.x * 8;
    norm_rows(P, l, 1);
    float* scr = (float*)smem + wave * (64 * 33);
    for (int it = gw; it < 4096; it += NGW) {
        if (it < 2048) transpose_item(P.in[37] + (size_t)l * 1024 * 4096, 1024, 4096, (bf16_t*)(P.ws + OFF_UPT), scr, it, lane);
        else transpose_item(P.in[38] + (size_t)l * 4096 * 1024, 4096, 1024, (bf16_t*)(P.ws + OFF_DOWNT), scr, it - 2048, lane);
    }
}

__device__ __forceinline__ void rwkv_prep_tile(const Params& P, int l, unsigned char* smem, int tile) {
    const int tid = otid(), lane = tid & 63, wave = tid >> 6, fr = lane & 15, fq = lane >> 4;
    const int r0 = tile * 64;
    const bf16_t* PROJ = (const bf16_t*)(P.ws + OFF_PROJ);
    bf16_t* MIXED = (bf16_t*)(P.ws + OFF_MIXED);
    bf16_t* Aop = (bf16_t*)smem;
    const float* mu = P.in[22] + l * 1024;
    const float* shs = P.in[6] + (size_t)l * 128 * 1024;
    __syncthreads();
#pragma unroll 1
    for (int i = 0; i < 4; ++i) {
        const int item = tid + 512 * i, tok = item >> 5, j0 = (item & 31) * 8, r = r0 + tok;
        int b, t; bool pr; row_info(r, b, t, pr);
        float p[8], q[8], o[8];
        unpack8(*(const u32x4*)(PROJ + (size_t)r * 2560 + 2048 + j0), p);
        if (t > 0) unpack8(*(const u32x4*)(PROJ + (size_t)(r - 1) * 2560 + 2048 + j0), q);
        else if (!pr) { const float* s = shs + (size_t)b * 1024 + 768 + j0;
#pragma unroll
            for (int e = 0; e < 8; ++e) q[e] = s[e]; }
        else {
#pragma unroll
            for (int e = 0; e < 8; ++e) q[e] = 0.f; }
#pragma unroll
        for (int e = 0; e < 8; ++e) { const float xs = p[e] + (q[e] - p[e]) * mu[768 + j0 + e]; o[e] = j0 < 64 ? tanh_(xs) : (j0 < 128 ? xs : sigm(xs)); }
        u32x4 w; w.x = cvt_pk_bf16(o[0], o[1]); w.y = cvt_pk_bf16(o[2], o[3]); w.z = cvt_pk_bf16(o[4], o[5]); w.w = cvt_pk_bf16(o[6], o[7]);
        *(u32x4*)(Aop + tok * 264 + j0) = w;
    }
#pragma unroll 1
    for (int tok = 0; tok < 64; ++tok) { const int r = r0 + tok; int b, t; bool pr; row_info(r, b, t, pr);
        if (pr ? (t == 2047) : (t == 3)) { float* dst = P.out + (pr ? O_PSH + (size_t)(l * 8 + b) * 1024 : O_SSH + (size_t)(l * 128 + b) * 1024);
            for (int idx = tid; idx < 1024; idx += 512) dst[idx] = bf2f(PROJ[(size_t)r * 2560 + 1280 + idx]); } }
    __syncthreads();
    const int hd = wave & 3, th = wave >> 2;
    const bf16_t* W2T = (const bf16_t*)(P.ws + OFF_W2T); const bf16_t* A2T = (const bf16_t*)(P.ws + OFF_A2T); const bf16_t* G2T = (const bf16_t*)(P.ws + OFF_G2T);
    f32x4 accw[4][2], acca[4][2], accg[4][2];
#pragma unroll
    for (int nt = 0; nt < 4; ++nt)
#pragma unroll
        for (int mt = 0; mt < 2; ++mt) { accw[nt][mt] = (f32x4){0.f, 0.f, 0.f, 0.f}; acca[nt][mt] = accw[nt][mt]; accg[nt][mt] = accw[nt][mt]; }
#pragma unroll
    for (int nt = 0; nt < 4; ++nt) { const int n = hd * 64 + nt * 16 + fr;
#pragma unroll
        for (int ks = 0; ks < 2; ++ks) {
            const bf16x8 wf = *(const bf16x8*)(W2T + n * 64 + ks * 32 + fq * 8), af = *(const bf16x8*)(A2T + n * 64 + ks * 32 + fq * 8);
#pragma unroll
            for (int mt = 0; mt < 2; ++mt) { const bf16_t* xr = Aop + (th * 32 + mt * 16 + fr) * 264 + ks * 32 + fq * 8;
                accw[nt][mt] = MFMA16(wf, *(const bf16x8*)xr, accw[nt][mt]); acca[nt][mt] = MFMA16(af, *(const bf16x8*)(xr + 64), acca[nt][mt]); } }
#pragma unroll
        for (int ks = 0; ks < 4; ++ks) { const bf16x8 gf = *(const bf16x8*)(G2T + n * 128 + ks * 32 + fq * 8);
#pragma unroll
            for (int mt = 0; mt < 2; ++mt) accg[nt][mt] = MFMA16(gf, *(const bf16x8*)(Aop + (th * 32 + mt * 16 + fr) * 264 + 128 + ks * 32 + fq * 8), accg[nt][mt]); } }
    float* RW = (float*)(P.ws + OFF_RW);
    float* C12 = (float*)(P.ws + OFF_C12);
    const float* w0 = P.in[23] + l * 256; const float* a0 = P.in[25] + l * 256; const float* kkw = P.in[28] + l * 256; const float* kaw = P.in[29] + l * 256; const float* rkw = P.in[30] + l * 256;
#pragma unroll
    for (int mt = 0; mt < 2; ++mt) {
        const int r = r0 + th * 32 + mt * 16 + fr; int b, t; bool pr; row_info(r, b, t, pr);
        float kkr[4][4], av[4][4], xrr[4][4]; float ss = 0.f, bs = 0.f, c2 = 0.f;
#pragma unroll
        for (int nt = 0; nt < 4; ++nt) {
            const int c0 = hd * 64 + nt * 16 + fq * 4;
            float pr_[4], pk_[4], pv_[4], qr_[4], qk_[4], qv_[4];
            const bf16_t* row = PROJ + (size_t)r * 2560 + 1280 + c0;
            unpack4(*(const u32x2*)(row), pr_); unpack4(*(const u32x2*)(row + 256), pk_); unpack4(*(const u32x2*)(row + 512), pv_);
            if (t > 0) { unpack4(*(const u32x2*)(row - 2560), qr_); unpack4(*(const u32x2*)(row - 2560 + 256), qk_); unpack4(*(const u32x2*)(row - 2560 + 512), qv_); }
            else if (!pr) { const float* s = shs + (size_t)b * 1024 + c0;
#pragma unroll
                for (int j = 0; j < 4; ++j) { qr_[j] = s[j]; qk_[j] = s[256 + j]; qv_[j] = s[512 + j]; } }
            else {
#pragma unroll
                for (int j = 0; j < 4; ++j) { qr_[j] = 0.f; qk_[j] = 0.f; qv_[j] = 0.f; } }
            f32x4 owr, ow, ok, ov; float gg[4];
#pragma unroll
            for (int j = 0; j < 4; ++j) { const int c = c0 + j;
                const float xr = pr_[j] + (qr_[j] - pr_[j]) * mu[c], xk = pk_[j] + (qk_[j] - pk_[j]) * mu[256 + c], xv = pv_[j] + (qv_[j] - pv_[j]) * mu[512 + c];
                const float wp = w0[c] + accw[nt][mt][j];
                const float nx = -wp;
                const float sp = fmaxf(nx, 0.f) + __logf(1.f + __expf(-fabsf(nx)));
                const float wv = -sp - 0.5f;
                const float dec = __expf(-__expf(wv));
                const float a = sigm(a0[c] + acca[nt][mt][j]);
                const float kr = xk * kkw[c]; ss += kr * kr;
                const float k = xk * (1.f + (a - 1.f) * kaw[c]);
                bs += xr * k * rkw[c]; c2 += xr * k;
                kkr[nt][j] = kr; av[nt][j] = a; xrr[nt][j] = xr;
                owr[j] = dec * xr; ow[j] = dec; ok[j] = k; ov[j] = xv; gg[j] = accg[nt][mt][j]; }
            const size_t o = (size_t)r * 256 + c0;
            *(f32x4*)(RW + 1 * RWSZ + o) = owr; *(f32x4*)(RW + 2 * RWSZ + o) = ow; *(f32x4*)(RW + 4 * RWSZ + o) = ok; *(f32x4*)(RW + 5 * RWSZ + o) = ov;
            *(u32x2*)(MIXED + (size_t)r * 1024 + 512 + c0) = pack4(gg);
        }
        ss += __shfl_xor(ss, 16); ss += __shfl_xor(ss, 32); bs += __shfl_xor(bs, 16); bs += __shfl_xor(bs, 32); c2 += __shfl_xor(c2, 16); c2 += __shfl_xor(c2, 32);
        const float inv = 1.f / fmaxf(sqrtf(ss), 1e-12f); float c1 = 0.f;
#pragma unroll
        for (int nt = 0; nt < 4; ++nt) { const int c0 = hd * 64 + nt * 16 + fq * 4; f32x4 okk, okka;
#pragma unroll
            for (int j = 0; j < 4; ++j) { const float kk = kkr[nt][j] * inv, kka = kk * av[nt][j]; okk[j] = kk; okka[j] = kka; c1 += kka * xrr[nt][j]; }
            const size_t o = (size_t)r * 256 + c0; *(f32x4*)(RW + 0 * RWSZ + o) = okk; *(f32x4*)(RW + 3 * RWSZ + o) = okka; }
        c1 += __shfl_xor(c1, 16); c1 += __shfl_xor(c1, 32);
        if (fq == 0) *(f32x4*)(C12 + (size_t)r * 16 + hd * 4) = (f32x4){c1, c2, bs, 0.f};
    }
}

__device__ __forceinline__ void pool_tile(const Params& P, int l, unsigned char* smem, int tile) {
    const int tid = otid(), lane = tid & 63, wave = tid >> 6, fr = lane & 15, fq = lane >> 4;
    const int r0 = tile * 64;
    const bf16_t* PROJ = (const bf16_t*)(P.ws + OFF_PROJ);
    bf16_t* MIXED = (bf16_t*)(P.ws + OFF_MIXED);
    bf16_t* Pop = (bf16_t*)smem;
    const float* pst = P.in[7] + (size_t)l * 128 * 15 * 256;
    __syncthreads();
#pragma unroll 1
    for (int i = 0; i < 4; ++i) {
        const int item = tid + 512 * i, tok = item >> 5, ch0 = (item & 31) * 8, r = r0 + tok, win = 2 << (ch0 >> 6);
        int b, t; bool pr; row_info(r, b, t, pr);
        float s[8], u[8];
#pragma unroll
        for (int e = 0; e < 8; ++e) s[e] = 0.f;
        for (int j = 0; j < win; ++j) { const int tt = t - j; float x[8];
            if (tt >= 0) unpack8(*(const u32x4*)(PROJ + (size_t)(r - j) * 2560 + 2304 + ch0), x);
            else if (!pr) { const float* bp = pst + ((size_t)b * 15 + 15 + tt) * 256 + ch0;
#pragma unroll
                for (int e = 0; e < 8; ++e) x[e] = bp[e]; }
            else break;
            if (j == 0) {
#pragma unroll
                for (int e = 0; e < 8; ++e) u[e] = x[e]; }
#pragma unroll
            for (int e = 0; e < 8; ++e) s[e] += x[e]; }
        const float cnt = pr ? (float)min(t + 1, win) : (float)win, ic = 1.f / cnt; float o[8];
#pragma unroll
        for (int e = 0; e < 8; ++e) o[e] = s[e] * ic - u[e];
        u32x4 w; w.x = cvt_pk_bf16(o[0], o[1]); w.y = cvt_pk_bf16(o[2], o[3]); w.z = cvt_pk_bf16(o[4], o[5]); w.w = cvt_pk_bf16(o[6], o[7]);
        *(u32x4*)(Pop + tok * 264 + ch0) = w;
    }
    if (r0 < MP) { if ((r0 & 2047) == 1984) { const int b = r0 >> 11; float* dst = P.out + O_PPOOL + (size_t)(l * 8 + b) * 3840;
            for (int idx = tid; idx < 3840; idx += 512) { const int j = idx >> 8, ch = idx & 255; dst[idx] = bf2f(PROJ[(size_t)(b * 2048 + 2033 + j) * 2560 + 2304 + ch]); } } }
    else { const int b0 = (r0 - MP) >> 2;
        for (int idx = tid; idx < 16 * 3840; idx += 512) { const int bb = idx / 3840, rem = idx - bb * 3840, j = rem >> 8, ch = rem & 255, b = b0 + bb;
            const float v = j < 11 ? pst[((size_t)b * 15 + j + 4) * 256 + ch] : bf2f(PROJ[(size_t)(MP + b * 4 + j - 11) * 2560 + 2304 + ch]);
            P.out[O_SPOOL + (size_t)(l * 128 + b) * 3840 + rem] = v; } }
    __syncthreads();
    const bf16_t* PWT = (const bf16_t*)(P.ws + OFF_PWT);
    const float* scale = P.in[34] + l * 256;
    f32x4 acc[2][4];
#pragma unroll
    for (int nt = 0; nt < 2; ++nt)
#pragma unroll
        for (int mt = 0; mt < 4; ++mt) acc[nt][mt] = (f32x4){0.f, 0.f, 0.f, 0.f};
#pragma unroll
    for (int nt = 0; nt < 2; ++nt) { const int n0 = wave * 32 + nt * 16, gi = n0 >> 6;
#pragma unroll
        for (int ks = 0; ks < 2; ++ks) { const bf16x8 wf = *(const bf16x8*)(PWT + (n0 + fr) * 64 + ks * 32 + fq * 8);
#pragma unroll
            for (int mt = 0; mt < 4; ++mt) acc[nt][mt] = MFMA16(wf, *(const bf16x8*)(Pop + (mt * 16 + fr) * 264 + gi * 64 + ks * 32 + fq * 8), acc[nt][mt]); } }
#pragma unroll
    for (int nt = 0; nt < 2; ++nt)
#pragma unroll
        for (int mt = 0; mt < 4; ++mt) { const int r = r0 + mt * 16 + fr, ch = wave * 32 + nt * 16 + fq * 4; float o[4];
#pragma unroll
            for (int j = 0; j < 4; ++j) o[j] = acc[nt][mt][j] * scale[ch + j];
            *(u32x2*)(MIXED + (size_t)r * 1024 + 768 + ch) = pack4(o); }
}

__device__ __forceinline__ void s5_task(const Params& P, int l, unsigned char* smem, int mode, int tile) {
    const int tid = otid(), lane = tid & 63, wave = tid >> 6, fr = lane & 15, fq = lane >> 4;
    const bool prompt = tile < 256;
    const int b = tile >> 5, c = tile & 31, st8 = tile - 256;
    const int r0 = prompt ? b * 2048 + c * 64 : MP + st8 * 64, b0 = st8 * 16;
    const bf16_t* PROJ = (const bf16_t*)(P.ws + OFF_PROJ);
    bf16_t* MIXED = (bf16_t*)(P.ws + OFF_MIXED);
    bf16_t* U = (bf16_t*)smem;
    bf16_t* Zb = (bf16_t*)(smem + 32768);
    bf16_t* Hb = (bf16_t*)(smem + 32768 + 33792 + wave * 4352);
    __syncthreads();
#pragma unroll
    for (int i = 0; i < 4; ++i) { const int item = tid + 512 * i, tok = item >> 5, j0 = (item & 31) * 8;
        *(u32x4*)(U + tok * 256 + j0) = *(const u32x4*)(PROJ + (size_t)(r0 + tok) * 2560 + j0); }
    __syncthreads();
    const float* S5C = (const float*)(P.ws + OFF_S5C);
    const bf16_t* CMT = (const bf16_t*)(P.ws + OFF_CMT);
    float* S5E = (float*)(P.ws + OFF_S5E);
    const float* dsk = P.in[17] + l * 256;
#pragma unroll 1
    for (int gg = 0; gg < 2; ++gg) {
        const int g = 2 * wave + gg, gp = g * 64 + lane;
        const float ar = S5C[gp], ai = S5C[1024 + gp];
        float bbr[16], bbi[16];
#pragma unroll
        for (int q = 0; q < 4; ++q) { const f32x4 x = *(const f32x4*)(S5C + 4096 + gp * 16 + q * 4), y = *(const f32x4*)(S5C + 4096 + 16384 + gp * 16 + q * 4);
#pragma unroll
            for (int j = 0; j < 4; ++j) { bbr[q * 4 + j] = x[j]; bbi[q * 4 + j] = y[j]; } }
        float hr = 0.f, hi = 0.f;
        if (prompt && mode == 1) { const float alr = S5C[2048 + gp], ali = S5C[3072 + gp];
            for (int j = 0; j < c; ++j) { const f32x2v e = *(const f32x2v*)(S5E + ((size_t)((b * 32 + j) * 16 + g) * 64 + lane) * 2);
                const float nr = alr * hr - ali * hi + e.x, ni = alr * hi + ali * hr + e.y; hr = nr; hi = ni; } }
#pragma unroll 1
        for (int st = 0; st < 4; ++st) {
#pragma unroll 4
            for (int tt = 0; tt < 16; ++tt) { const int t = st * 16 + tt;
                if (!prompt && (t & 3) == 0) { const size_t so = ((size_t)(l * 128 + b0 + (t >> 2)) * 16 + g) * 64 + lane; hr = P.in[2][so]; hi = P.in[3][so]; }
                float u[16]; unpack8(*(const u32x4*)(U + t * 256 + g * 16), u); unpack8(*(const u32x4*)(U + t * 256 + g * 16 + 8), u + 8);
                float bur = 0.f, bui = 0.f;
#pragma unroll
                for (int h = 0; h < 16; ++h) { bur += bbr[h] * u[h]; bui += bbi[h] * u[h]; }
                const float nr = ar * hr - ai * hi + bur, ni = ar * hi + ai * hr + bui; hr = nr; hi = ni;
                if (mode == 1) { Hb[tt * 136 + lane] = f2bf(hr); Hb[tt * 136 + 64 + lane] = f2bf(hi);
                    if (prompt) { if (c == 31 && t == 63) { const size_t so = ((size_t)(l * 8 + b) * 16 + g) * 64 + lane; P.out[O_PSRE + so] = hr; P.out[O_PSIM + so] = hi; } }
                    else if ((t & 3) == 3) { const size_t so = ((size_t)(l * 128 + b0 + (t >> 2)) * 16 + g) * 64 + lane; P.out[O_SSRE + so] = hr; P.out[O_SSIM + so] = hi; } }
            }
            if (mode == 1) {
                f32x4 acc = (f32x4){0.f, 0.f, 0.f, 0.f};
#pragma unroll
                for (int ks = 0; ks < 4; ++ks) acc = MFMA16(*(const bf16x8*)(CMT + (g * 16 + fr) * 128 + ks * 32 + fq * 8), *(const bf16x8*)(Hb + fr * 136 + ks * 32 + fq * 8), acc);
                const int t = st * 16 + fr, ch = g * 16 + fq * 4; float u4[4], z[4];
                unpack4(*(const u32x2*)(U + t * 256 + ch), u4);
#pragma unroll
                for (int j = 0; j < 4; ++j) z[j] = gelu_t(acc[j] + dsk[ch + j] * u4[j]);
                *(u32x2*)(Zb + t * 264 + ch) = pack4(z);
            }
        }
        if (mode == 0) *(f32x2v*)(S5E + ((size_t)((b * 32 + c) * 16 + g) * 64 + lane) * 2) = (f32x2v){hr, hi};
    }
    if (mode == 1) {
        __syncthreads();
        const bf16_t* GLUT = (const bf16_t*)(P.ws + OFF_GLUT);
        const float* gb = P.in[19] + l * 256;
        f32x4 acc[2][4];
#pragma unroll
        for (int nt = 0; nt < 2; ++nt)
#pragma unroll
            for (int mt = 0; mt < 4; ++mt) acc[nt][mt] = (f32x4){0.f, 0.f, 0.f, 0.f};
#pragma unroll
        for (int ks = 0; ks < 8; ++ks)
#pragma unroll
            for (int nt = 0; nt < 2; ++nt) { const bf16x8 wf = *(const bf16x8*)(GLUT + (wave * 32 + nt * 16 + fr) * 256 + ks * 32 + fq * 8);
#pragma unroll
                for (int mt = 0; mt < 4; ++mt) acc[nt][mt] = MFMA16(wf, *(const bf16x8*)(Zb + (mt * 16 + fr) * 264 + ks * 32 + fq * 8), acc[nt][mt]); }
#pragma unroll
        for (int nt = 0; nt < 2; ++nt)
#pragma unroll
            for (int mt = 0; mt < 4; ++mt) { const int tok = mt * 16 + fr, ch = wave * 32 + nt * 16 + fq * 4; float z4[4], o[4];
                unpack4(*(const u32x2*)(Zb + tok * 264 + ch), z4);
#pragma unroll
                for (int j = 0; j < 4; ++j) o[j] = z4[j] * sigm(acc[nt][mt][j] + gb[ch + j]);
                *(u32x2*)(MIXED + (size_t)(r0 + tok) * 1024 + ch) = pack4(o); }
    }
}

__device__ __forceinline__ void hgrn_task(const Params& P, int l, unsigned char* smem, int mode, int b, int hd, int sc) {
    const int tid = otid();
    const bf16_t* PROJ = (const bf16_t*)(P.ws + OFF_PROJ);
    bf16_t* MIXED = (bf16_t*)(P.ws + OFF_MIXED);
    float* Qp = (float*)smem; float* Kn = Qp + 2176; float* Kd = Kn + 2176; float* V = Kd + 2176; float* S = V + 2176; float* Att = S + 4352; float* TOT = Att + 1056; float* EB = TOT + 512;
    float* HST = (float*)(P.ws + OFF_HST); float* HD = (float*)(P.ws + OFF_HD);
    const int k = tid & 63, sg = tid >> 6, k8 = tid >> 3, v8 = (tid & 7) * 8;
    const float lbv = ((const float*)(P.ws + OFF_LB))[hd * 64 + k];
    float sreg[8];
#pragma unroll
    for (int e = 0; e < 8; ++e) sreg[e] = 0.f;
    if (mode == 1) {
        for (int j = 0; j < sc; ++j) { const size_t bi = (size_t)((b * 4 + hd) * 16 + j); const float d = HD[bi * 64 + k8];
            const f32x4 x0 = *(const f32x4*)(HST + (bi * 64 + k8) * 64 + v8), x1 = *(const f32x4*)(HST + (bi * 64 + k8) * 64 + v8 + 4);
#pragma unroll
            for (int e = 0; e < 4; ++e) { sreg[e] = d * sreg[e] + x0[e]; sreg[4 + e] = d * sreg[4 + e] + x1[e]; } }
    } else if (mode == 2) { const float* sp = P.in[4] + (((size_t)(l * 128 + b) * 4 + hd) * 64 + k8) * 64 + v8;
#pragma unroll
        for (int e = 0; e < 8; ++e) sreg[e] = sp[e]; }
    __syncthreads();
#pragma unroll
    for (int e = 0; e < 8; ++e) S[k8 * 68 + v8 + e] = sreg[e];
    float dsum = 0.f;
    const int nch = mode == 2 ? 1 : 4, L = mode == 2 ? 4 : 32;
#pragma unroll 1
    for (int ch = 0; ch < nch; ++ch) {
        const int r0 = mode == 2 ? MP + b * 4 : b * 2048 + sc * 128 + ch * 32;
        __syncthreads();
        float lf[4], kv[4], q[4], vv[4], cs[4];
#pragma unroll
        for (int e = 0; e < 4; ++e) { const int s = 4 * sg + e; lf[e] = 0.f; kv[e] = 0.f; q[e] = 0.f; vv[e] = 0.f;
            if (s < L) { const bf16_t* row = PROJ + (size_t)(r0 + s) * 2560 + hd * 64 + k;
                const float z = bf2f(row[512]); const float f = lbv + (1.f - lbv) * sigm(z); lf[e] = __logf(f); kv[e] = 1.f - f;
                if (mode != 0) { const float pq = bf2f(row[256]); q[e] = pq * sigm(pq); }
                vv[e] = bf2f(row[768]); } }
        cs[0] = lf[0]; cs[1] = cs[0] + lf[1]; cs[2] = cs[1] + lf[2]; cs[3] = cs[2] + lf[3];
        TOT[sg * 64 + k] = cs[3];
        __syncthreads();
        float off = 0.f, blast = 0.f;
#pragma unroll
        for (int j = 0; j < 8; ++j) { const float tj = TOT[j * 64 + k]; if (j < sg) off += tj; blast += tj; }
#pragma unroll
        for (int e = 0; e < 4; ++e) { const int s = 4 * sg + e; const float bsv = off + cs[e];
            Qp[s * 68 + k] = q[e] * __expf(bsv); Kn[s * 68 + k] = kv[e] * __expf(-bsv); Kd[s * 68 + k] = kv[e] * __expf(blast - bsv); V[s * 68 + k] = vv[e]; }
        if (sg == 0) { EB[k] = __expf(blast); dsum += blast; }
        __syncthreads();
        if (mode != 0) {
            const int t = tid >> 4, s0 = tid & 15;
            float a0 = 0.f, a1 = 0.f;
#pragma unroll 4
            for (int kq = 0; kq < 16; ++kq) { const f32x4 q4 = *(const f32x4*)(Qp + t * 68 + 4 * kq), ka = *(const f32x4*)(Kn + s0 * 68 + 4 * kq), kb = *(const f32x4*)(Kn + (s0 + 16) * 68 + 4 * kq);
                a0 += q4.x * ka.x + q4.y * ka.y + q4.z * ka.z + q4.w * ka.w; a1 += q4.x * kb.x + q4.y * kb.y + q4.z * kb.z + q4.w * kb.w; }
            Att[t * 33 + s0] = (s0 <= t) ? a0 : 0.f; Att[t * 33 + s0 + 16] = (s0 + 16 <= t) ? a1 : 0.f;
            __syncthreads();
            const int v4 = (tid & 15) * 4; f32x4 o = (f32x4){0.f, 0.f, 0.f, 0.f};
            for (int s = 0; s < L; ++s) { const float a = Att[t * 33 + s]; o += a * *(const f32x4*)(V + s * 68 + v4); }
#pragma unroll 8
            for (int kk = 0; kk < 64; ++kk) { const float qq = Qp[t * 68 + kk]; o += qq * *(const f32x4*)(S + kk * 68 + v4); }
            float ss = o.x * o.x + o.y * o.y + o.z * o.z + o.w * o.w;
            ss += __shfl_xor(ss, 1); ss += __shfl_xor(ss, 2); ss += __shfl_xor(ss, 4); ss += __shfl_xor(ss, 8);
            const float rn = rsqrtf(ss * (1.f / 64.f) + 1e-5f);
            if (t < L) { const int r = r0 + t, ci = hd * 64 + v4; const f32x4 ng = *(const f32x4*)(P.in[21] + l * 256 + ci); float pg[4], ov[4];
                unpack4(*(const u32x2*)(PROJ + (size_t)r * 2560 + 1024 + ci), pg);
#pragma unroll
                for (int j = 0; j < 4; ++j) ov[j] = o[j] * rn * ng[j] * (pg[j] * sigm(pg[j]));
                *(u32x2*)(MIXED + (size_t)r * 1024 + 256 + ci) = pack4(ov); }
            __syncthreads();
        }
        { const float eb = EB[k8];
#pragma unroll
            for (int e = 0; e < 8; ++e) sreg[e] *= eb;
            for (int s = 0; s < L; ++s) { const float kd = Kd[s * 68 + k8]; const f32x4 x0 = *(const f32x4*)(V + s * 68 + v8), x1 = *(const f32x4*)(V + s * 68 + v8 + 4);
#pragma unroll
                for (int e = 0; e < 4; ++e) { sreg[e] += kd * x0[e]; sreg[4 + e] += kd * x1[e]; } }
#pragma unroll
            for (int e = 0; e < 8; ++e) S[k8 * 68 + v8 + e] = sreg[e]; }
    }
    float* dst = nullptr;
    if (mode == 0) { const size_t bi = (size_t)((b * 4 + hd) * 16 + sc); dst = HST + (bi * 64 + k8) * 64 + v8; if (sg == 0) HD[bi * 64 + k] = __expf(dsum); }
    else if (mode == 1) { if (sc == 15) dst = P.out + O_PHG + (((size_t)(l * 8 + b) * 4 + hd) * 64 + k8) * 64 + v8; }
    else dst = P.out + O_SHG + (((size_t)(l * 128 + b) * 4 + hd) * 64 + k8) * 64 + v8;
    if (dst) { *(f32x4*)dst = (f32x4){sreg[0], sreg[1], sreg[2], sreg[3]}; *(f32x4*)(dst + 4) = (f32x4){sreg[4], sreg[5], sreg[6], sreg[7]}; }
}

template <int CTRL> __device__ __forceinline__ float dpp_add(float x) { return x + __int_as_float(__builtin_amdgcn_update_dpp(0, __float_as_int(x), CTRL, 0xF, 0xF, false)); }
__device__ __forceinline__ float row16_sum(float x) { x = dpp_add<0xB1>(x); x = dpp_add<0x4E>(x); x = dpp_add<0x141>(x); x = dpp_add<0x140>(x); return x; }
__device__ __forceinline__ void rwkv_scan_task(const Params& P, int l, unsigned char* smem, bool prompt, int b, int hd, int rq) {
    const int tid = otid(), lane = tid & 63, wave = tid >> 6;
    const int T = prompt ? 2048 : 4, row0 = prompt ? b * 2048 : MP + b * 4;
    const float* RW = (const float*)(P.ws + OFF_RW);
    const float* C12 = (const float*)(P.ws + OFF_C12);
    float* Y = (float*)(P.ws + OFF_Y);
    constexpr int BUFF = 32 * 340;
    float* buf = (float*)smem;
    const bool loader = wave >= 4;
    const int ltid = tid - 256;
    const int rr = lane >> 4, i4 = (lane & 15) * 4, srow = rq * 16 + wave * 4 + rr;
    f32x4 S = (f32x4){0.f, 0.f, 0.f, 0.f};
    if (!loader && !prompt) S = *(const f32x4*)(P.in[5] + (((size_t)(l * 128 + b) * 4 + hd) * 64 + srow) * 64 + i4);
    const int nchunks = (T + 31) >> 5;
    __syncthreads();
#pragma unroll 1
    for (int c = -1; c < nchunks; ++c) {
        if (loader) {
            if (c + 1 < nchunks) { const int t0 = (c + 1) * 32, n = min(32, T - t0); float* bw = buf + ((c + 1) & 1) * BUFF;
                f32x4 x[5][2]; float vx[2]; float cx = 0.f;
#pragma unroll
                for (int i = 0; i < 2; ++i) { const int idx = ltid + 256 * i, stp = idx >> 4, q = idx & 15; const size_t o = (size_t)(row0 + t0 + stp) * 256 + hd * 64 + q * 4;
#pragma unroll
                    for (int vct = 0; vct < 5; ++vct) x[vct][i] = (stp < n) ? *(const f32x4*)(RW + vct * RWSZ + o) : (f32x4){0.f, 0.f, 0.f, 0.f};
                    vx[i] = (stp < n) ? RW[5 * RWSZ + (size_t)(row0 + t0 + stp) * 256 + hd * 64 + rq * 16 + q] : 0.f; }
                if (ltid < 64) { const int stp = ltid >> 1; if (stp < n) cx = C12[(size_t)(row0 + t0 + stp) * 16 + hd * 4 + (ltid & 1)]; }
#pragma unroll
                for (int i = 0; i < 2; ++i) { const int idx = ltid + 256 * i, stp = idx >> 4, q = idx & 15;
#pragma unroll
                    for (int vct = 0; vct < 5; ++vct) *(f32x4*)(bw + vct * 2048 + stp * 64 + q * 4) = x[vct][i];
                    bw[10240 + stp * 16 + q] = vx[i]; }
                if (ltid < 64) bw[10752 + (ltid >> 1) * 4 + (ltid & 1)] = cx;
            }
        } else if (c >= 0) {
            const int t0 = c * 32, n = min(32, T - t0); const float* br = buf + (c & 1) * BUFF;
#pragma unroll 4
            for (int s = 0; s < n; ++s) {
                const f32x4 kk = *(const f32x4*)(br + s * 64 + i4), wr = *(const f32x4*)(br + 2048 + s * 64 + i4), w = *(const f32x4*)(br + 4096 + s * 64 + i4),
                            kka = *(const f32x4*)(br + 6144 + s * 64 + i4), kv = *(const f32x4*)(br + 8192 + s * 64 + i4);
                const float v = br[10240 + s * 16 + wave * 4 + rr]; const f32x2v cc = *(const f32x2v*)(br + 10752 + s * 4);
                float p1 = S.x * kk.x + S.y * kk.y + S.z * kk.z + S.w * kk.w, p2 = S.x * wr.x + S.y * wr.y + S.z * wr.z + S.w * wr.w;
                p1 = row16_sum(p1); p2 = row16_sum(p2);
                const float sa = -p1, y = p2 + sa * cc.x + v * cc.y;
                S = S * w + sa * kka + v * kv;
                if ((lane & 15) == 0) Y[(size_t)(row0 + t0 + s) * 256 + hd * 64 + srow] = y;
            }
        }
        __syncthreads();
    }
    if (!loader) { float* dst = P.out + (prompt ? O_PWKV + (((size_t)(l * 8 + b) * 4 + hd) * 64 + srow) * 64 : O_SWKV + (((size_t)(l * 128 + b) * 4 + hd) * 64 + srow) * 64) + i4; *(f32x4*)dst = S; }
}

__device__ __forceinline__ void phaseC(const Params& P, int l, unsigned char* smem) {
    for (int t = blockIdx.x; t < 1296; t += gridDim.x) {
        if (t < 512) hgrn_task(P, l, smem, 0, t >> 6, (t >> 4) & 3, t & 15);
        else if (t < 776) rwkv_prep_tile(P, l, smem, t - 512);
        else if (t < 1040) pool_tile(P, l, smem, t - 776);
        else s5_task(P, l, smem, 0, t - 1040);
    }
}
__device__ __forceinline__ void phaseD(const Params& P, int l, unsigned char* smem) {
    const int tid = otid();
    if (blockIdx.x < 128) rwkv_scan_task(P, l, smem, true, blockIdx.x >> 4, (blockIdx.x >> 2) & 3, blockIdx.x & 3);
    unsigned* ctr = (unsigned*)(P.ws + OFF_CTR) + l;
    volatile int* s_task = (volatile int*)(smem + LDS_TASK_OFF);
    for (;;) {
        __syncthreads();
        if (tid == 0) *s_task = (int)atomicAdd(ctr, 1u);
        __syncthreads();
        const int t = *s_task;
        if (t >= 3336) break;
        if (t < 512) hgrn_task(P, l, smem, 1, t >> 6, (t >> 4) & 3, t & 15);
        else if (t < 776) s5_task(P, l, smem, 1, t - 512);
        else if (t < 1288) { const int u = t - 776; hgrn_task(P, l, smem, 2, u >> 2, u & 3, 0); }
        else { const int u = t - 1288; rwkv_scan_task(P, l, smem, false, u >> 4, (u >> 2) & 3, u & 3); }
    }
}
__device__ __forceinline__ void phaseE(const Params& P, int l) {
    const int tid = otid(), lane = tid & 63, wave = tid >> 6, gw = blockIdx.x * 8 + wave, NGW = gridDim.x * 8;
    const float* Y = (const float*)(P.ws + OFF_Y); const float* Vb = (const float*)(P.ws + OFF_RW) + 5 * RWSZ; const float* C12 = (const float*)(P.ws + OFF_C12);
    bf16_t* MIXED = (bf16_t*)(P.ws + OFF_MIXED);
    const int c0 = lane * 4, hd = lane >> 4;
    const f32x4 lg = *(const f32x4*)(P.in[31] + l * 256 + c0), lbb = *(const f32x4*)(P.in[32] + l * 256 + c0);
    for (int r = gw; r < MT; r += NGW) {
        const f32x4 y = *(const f32x4*)(Y + (size_t)r * 256 + c0), v = *(const f32x4*)(Vb + (size_t)r * 256 + c0);
        float s = y.x + y.y + y.z + y.w; s += __shfl_xor(s, 1); s += __shfl_xor(s, 2); s += __shfl_xor(s, 4); s += __shfl_xor(s, 8);
        const float mean = s * (1.f / 64.f); const f32x4 d = y - mean;
        float q = d.x * d.x + d.y * d.y + d.z * d.z + d.w * d.w; q += __shfl_xor(q, 1); q += __shfl_xor(q, 2); q += __shfl_xor(q, 4); q += __shfl_xor(q, 8);
        const float rs = rsqrtf(q * (1.f / 64.f) + 64e-5f); const float bs = C12[(size_t)r * 16 + hd * 4 + 2];
        float g[4], o[4]; unpack4(*(const u32x2*)(MIXED + (size_t)r * 1024 + 512 + c0), g);
#pragma unroll
        for (int j = 0; j < 4; ++j) o[j] = (d[j] * rs * lg[j] + lbb[j] + bs * v[j]) * g[j];
        *(u32x2*)(MIXED + (size_t)r * 1024 + 512 + c0) = pack4(o);
    }
}

template <class Epi> __device__ __forceinline__ void run_gemm(unsigned char* smem, const bf16_t* A, const bf16_t* Bt, int N, int K, const Epi& E) {
    pg8::Gemm g; g.A = A; g.Bt = Bt; g.M = MT; g.N = N; g.K = K;
    pg8::StaticOrder S; S.init(MT, N, (int)gridDim.x, (int)blockIdx.x);
    __syncthreads();
    pg8::gemm_phase<Epi, pg8::StaticOrder, false>((PG8_LAS unsigned char*)smem, g, S, E, nullptr);
    __syncthreads();
}

constexpr int NPHASE = 19;
__global__ void __launch_bounds__(512, 2) mega(Params P, int ph_lo, int ph_hi) {
    extern __shared__ __attribute__((aligned(16))) unsigned char smem[];
    cg::grid_group grid = cg::this_grid();
#pragma unroll 1
    for (int ph = ph_lo; ph < ph_hi; ++ph) {
        const int l = ph / 9, sub = ph - l * 9;
        if (ph == 18) norm_rows(P, 0, 2);
        else if (sub == 0) phaseA(P, l, smem);
        else if (sub == 1) { pg8::EpiBf<0> E; E.O = (bf16_t*)(P.ws + OFF_PROJ); E.ldc = 2560; run_gemm(smem, (const bf16_t*)(P.ws + OFF_MIXED), (const bf16_t*)(P.ws + OFF_WINT), 2560, 1024, E); }
        else if (sub == 2) phaseC(P, l, smem);
        else if (sub == 3) phaseD(P, l, smem);
        else if (sub == 4) phaseE(P, l);
        else if (sub == 5 || sub == 8) { pg8::EpiResid E; E.H = P.out; E.ldc = 1024;
            if (sub == 5) run_gemm(smem, (const bf16_t*)(P.ws + OFF_MIXED), (const bf16_t*)(P.ws + OFF_WOUTT), 1024, 1024, E);
            else run_gemm(smem, (const bf16_t*)(P.ws + OFF_HIDDEN), (const bf16_t*)(P.ws + OFF_DOWNT), 1024, 4096, E); }
        else if (sub == 6) phaseG(P, l, smem);
        else if (sub == 7) { pg8::EpiBf<1> E; E.O = (bf16_t*)(P.ws + OFF_HIDDEN); E.ldc = 4096; run_gemm(smem, (const bf16_t*)(P.ws + OFF_XN2), (const bf16_t*)(P.ws + OFF_UPT), 4096, 1024, E); }
        if (ph + 1 < ph_hi) grid.sync();
    }
}

#ifndef N_LAUNCH_MODE
#define N_LAUNCH_MODE 1
#endif
extern "C" void kernel_launch(void* const* d_in, const int* in_sizes, int n_in, void* d_out, int out_size, void* d_ws, size_t ws_size, hipStream_t stream) {
    static int grid = 0;
    if (grid == 0) {
        if (n_in != 40 || ws_size < WS_END) { fprintf(stderr, "kernel_launch: unexpected n_in %d / ws %zu\n", n_in, ws_size); grid = -1; return; }
        int dev = 0, cus = 0, per_cu = 0;
        hipGetDevice(&dev); hipDeviceGetAttribute(&cus, hipDeviceAttributeMultiprocessorCount, dev);
        if (hipFuncSetAttribute((const void*)mega, hipFuncAttributeMaxDynamicSharedMemorySize, LDS_BYTES) != hipSuccess) { fprintf(stderr, "kernel_launch: hipFuncSetAttribute failed\n"); grid = -1; return; }
        if (hipOccupancyMaxActiveBlocksPerMultiprocessor(&per_cu, (const void*)mega, 512, LDS_BYTES) != hipSuccess || per_cu < 1) { fprintf(stderr, "kernel_launch: occupancy query says %d\n", per_cu); per_cu = 1; }
        (void)hipGetLastError();
        grid = cus;
    }
    if (grid < 0) return;
    Params p{};
    for (int i = 0; i < 40; ++i) p.in[i] = (const float*)d_in[i];
    p.out = (float*)d_out; p.ws = (unsigned char*)d_ws;
#if N_LAUNCH_MODE == 1
    int lo = 0, hi = NPHASE;
    void* args[] = {&p, &lo, &hi};
    hipError_t e = hipLaunchCooperativeKernel((const void*)mega, dim3(grid), dim3(512), args, LDS_BYTES, stream);
    if (e != hipSuccess) fprintf(stderr, "cooperative launch failed: %s (grid %d)\n", hipGetErrorString(e), grid);
#else
    for (int ph = 0; ph < NPHASE; ++ph) hipLaunchKernelGGL(mega, dim3(grid), dim3(512), LDS_BYTES, stream, p, ph, ph + 1);
#endif
}
```

```cpp
#include <hip/hip_runtime.h>
#include <hip/hip_cooperative_groups.h>
#include <cstdio>
#include <cstdint>
namespace cg = cooperative_groups;
__device__ __forceinline__ int otid() { int t = threadIdx.x; asm volatile("" : "+v"(t)); return t; }
namespace pg8 {
#define PG8_LAS __attribute__((address_space(3)))
typedef unsigned short bf16_t;
typedef short bf16x8 __attribute__((ext_vector_type(8)));
typedef float f32x4 __attribute__((ext_vector_type(4)));
typedef unsigned u32x4 __attribute__((ext_vector_type(4)));
constexpr int BM = 256, BK = 64, HALF = 128, HTB = HALF * BK * 2  , STAGE_BYTES = 8 * HTB, NXCD = 8, WGM = 8;

__host__ __device__ __forceinline__ int lds_byte(int r, int c) { const int st = (r >> 4) * 2 + (c >> 5), rr = r & 15, cc = c & 31, ob = rr * 64 + cc * 2; return st * 1024 + (ob ^ (((ob >> 9) & 1) << 5)); }
__host__ __device__ __forceinline__ void stage_rc(int b, int& R, int& C) { const int st = b / 1024, sb = b % 1024, swz = sb ^ (((sb >> 9) & 1) << 5); R = (st >> 1) * 16 + swz / 64; C = (st & 1) * 32 + (swz % 64) / 2; }
__host__ __device__ __forceinline__ int perm32(int rho) { const int n = rho >> 4, i = rho & 15; return 8 * (i >> 2) + 4 * n + (i & 3); }

struct Unit { int pm, pn, kb, nt; };
struct Gemm { const bf16_t* A; const bf16_t* Bt; int M, N, K, ld; };

struct StaticOrder {
    int nM, nN, nwg, G, c;
    __host__ __device__ void init(int M, int N, int G_, int c_) { nM = M / BM; nN = N / BM; nwg = nM * nN; G = G_; c = c_; }
    __host__ __device__ bool next(int i, Unit& u) const {
        const long L = (long)i * G + c; if (L >= nwg) return false;
        int wgid = (int)L; { const int q = nwg / NXCD, r = nwg % NXCD, xcd = wgid % NXCD, off = wgid / NXCD; wgid = (xcd < r ? xcd * (q + 1) : r * (q + 1) + (xcd - r) * q) + off; }
        const int nig = WGM * nN, gid = wgid / nig, fm = gid * WGM, gsz = (nM - fm) < WGM ? (nM - fm) : WGM;
        u.pm = fm + ((wgid % nig) % gsz); u.pn = (wgid % nig) / gsz; u.kb = 0; u.nt = 0; return true;
    }
    __device__ __forceinline__ void a_ready(const Unit&) const {}
    __device__ __forceinline__ void done(const Unit&) const {}
};
__device__ __forceinline__ unsigned cvt_pk_bf16(float lo, float hi) { unsigned r; asm volatile("v_cvt_pk_bf16_f32 %0, %1, %2" : "=v"(r) : "v"(lo), "v"(hi)); return r; }
struct EpiBf {
    static constexpr bool PERM = true, AFTER_DRAIN = false;
    bf16_t* O; int ldc; int ACT; const float* rsq;
    __device__ __forceinline__ void init(f32x4 (&acc)[2][2][4][2], const Unit&, int, int, int, int) const {
#pragma unroll
        for (int a = 0; a < 2; ++a)
#pragma unroll
            for (int b = 0; b < 2; ++b)
#pragma unroll
                for (int m = 0; m < 4; ++m)
#pragma unroll
                    for (int n = 0; n < 2; ++n) acc[a][b][m][n] = (f32x4){0.f, 0.f, 0.f, 0.f}; }
    __device__ __forceinline__ void operator()(const f32x4 (&acc)[2][2][4][2], const Unit& u, int wr, int wc, int fr, int fq) const {
        const int row0 = u.pm * BM + wr * 64 + fr; const int col0 = u.pn * BM + wc * 32 + 8 * fq;
#pragma unroll
        for (int ai = 0; ai < 2; ++ai)
#pragma unroll
            for (int m = 0; m < 4; ++m) { bf16_t* rowp = O + (size_t)(row0 + ai * HALF + m * 16) * ldc + col0; const float rstd = rsqrtf(rsq[row0 + ai * HALF + m * 16] * (1.f / 1024.f) + 1e-6f);
#pragma unroll
                for (int bj = 0; bj < 2; ++bj) { f32x4 v0 = acc[ai][bj][m][0] * rstd, v1 = acc[ai][bj][m][1] * rstd;
                    if (ACT) {
#pragma unroll
                        for (int j = 0; j < 4; ++j) { const float a = fmaxf(v0[j], 0.f), b = fmaxf(v1[j], 0.f); v0[j] = a * a; v1[j] = b * b; } }
                    u32x4 w; w.x = cvt_pk_bf16(v0[0], v0[1]); w.y = cvt_pk_bf16(v0[2], v0[3]); w.z = cvt_pk_bf16(v1[0], v1[1]); w.w = cvt_pk_bf16(v1[2], v1[3]);
                    *(u32x4*)(rowp + bj * HALF) = w; } }
    }
};
struct EpiResid {
    static constexpr bool PERM = false, AFTER_DRAIN = false;
    float* H; const float* Hin; int ldc; bf16_t* HB; float* rsq; float* PART; int kbytes;
    __device__ __forceinline__ void init(f32x4 (&acc)[2][2][4][2], const Unit& u, int wr, int wc, int fr, int fq) const {
        if (u.pm >= 64) {
#pragma unroll
        for (int a = 0; a < 2; ++a)
#pragma unroll
            for (int b = 0; b < 2; ++b)
#pragma unroll
                for (int m = 0; m < 4; ++m)
#pragma unroll
                    for (int n = 0; n < 2; ++n) acc[a][b][m][n] = (f32x4){0.f, 0.f, 0.f, 0.f};
            return; }
        const int row0 = u.pm * BM + wr * 64 + fr, col0 = u.pn * BM + wc * 32 + 4 * fq;
#pragma unroll
        for (int ai = 0; ai < 2; ++ai)
#pragma unroll
            for (int m = 0; m < 4; ++m) { const float* rowp = Hin + (size_t)(row0 + ai * HALF + m * 16) * ldc + col0;
#pragma unroll
                for (int bj = 0; bj < 2; ++bj)
#pragma unroll
                    for (int n = 0; n < 2; ++n) acc[ai][bj][m][n] = *(const f32x4*)(rowp + bj * HALF + n * 16); }
    }
    __device__ __forceinline__ void operator()(const f32x4 (&acc)[2][2][4][2], const Unit& u, int wr, int wc, int fr, int fq) const {
        if (u.pm >= 64) { const int ks = u.kb / kbytes, row0 = (u.pm - 64) * BM + wr * 64 + fr, col0 = u.pn * BM + wc * 32 + 4 * fq;
#pragma unroll
            for (int ai = 0; ai < 2; ++ai)
#pragma unroll
                for (int m = 0; m < 4; ++m) { float* rowp = PART + ((size_t)ks * 512 + row0 + ai * HALF + m * 16) * 1024 + col0;
#pragma unroll
                    for (int bj = 0; bj < 2; ++bj)
#pragma unroll
                        for (int n = 0; n < 2; ++n) *(f32x4*)(rowp + bj * HALF + n * 16) = acc[ai][bj][m][n]; }
            return; }
        const int row0 = u.pm * BM + wr * 64 + fr, col0 = u.pn * BM + wc * 32 + 4 * fq, lane = fq * 16 + fr;
#pragma unroll
        for (int ai = 0; ai < 2; ++ai)
#pragma unroll
            for (int m = 0; m < 4; ++m) { const int row = row0 + ai * HALF + m * 16; float* rowp = H + (size_t)row * ldc + col0; bf16_t* hbp = HB + (size_t)row * ldc + col0; float ss = 0.f;
#pragma unroll
                for (int bj = 0; bj < 2; ++bj)
#pragma unroll
                    for (int n = 0; n < 2; ++n) { const f32x4 v = acc[ai][bj][m][n]; *(f32x4*)(rowp + bj * HALF + n * 16) = v;
                        ss += v.x * v.x + v.y * v.y + v.z * v.z + v.w * v.w;
                        typedef unsigned u32x2_ __attribute__((ext_vector_type(2))); *(u32x2_*)(hbp + bj * HALF + n * 16) = (u32x2_){cvt_pk_bf16(v.x, v.y), cvt_pk_bf16(v.z, v.w)}; }
                ss += __int_as_float(__builtin_amdgcn_ds_bpermute((lane ^ 16) << 2, __float_as_int(ss))); ss += __int_as_float(__builtin_amdgcn_ds_bpermute((lane ^ 32) << 2, __float_as_int(ss)));
                if (fq == 0) unsafeAtomicAdd(rsq + row, ss); }
    }
};

template <class Epi, class Sched, bool STAMP = false>
__device__ __forceinline__ void gemm_phase(PG8_LAS unsigned char* lds, const Gemm g, const Sched& S, const Epi& E, unsigned long long* stamps) {
    const int tid = otid(), wid = __builtin_amdgcn_readfirstlane(tid >> 6), lane = tid & 63, wr = wid >> 2, wc = wid & 3, fr = lane & 15, fq = lane >> 4;
    const int K = g.ld, nt = g.K / BK;
    int ts_lo = 0, ts_hi = 0, nts = 0; const unsigned long long rt_entry = STAMP ? (unsigned long long)wall_clock64() : 0ull;
#define PG8_STAMP() do { if (STAMP && wid == 0 && nts < 64) { const unsigned long long _c = (unsigned long long)clock64(); \
        ts_lo = (lane == nts) ? (int)(unsigned)_c : ts_lo; ts_hi = (lane == nts) ? (int)(unsigned)(_c >> 32) : ts_hi; ++nts; } } while (0)
    PG8_STAMP();
    unsigned voffA[2], voffB[2];
#pragma unroll
    for (int i = 0; i < 2; ++i) { int R, C; stage_rc(tid * 16 + i * 8192, R, C); const int Rb = Epi::PERM ? ((R & ~31) + perm32(R & 31)) : R;
        voffA[i] = (unsigned)(R * K + C) * 2u; voffB[i] = (unsigned)(Rb * K + C) * 2u; }
    const size_t kstep = (size_t)(BK * 2);
    const size_t hstep = (size_t)HALF * K * 2;
    const size_t tstep = 2 * hstep;
    const unsigned ldsw = (unsigned)wid * 1024u;
    const int aoff = lds_byte(wr * 64 + fr, fq * 8), boff = lds_byte(wc * 32 + fr, fq * 8);
#define PG8_SA(b, h) (((b) * 2 + (h)) * HTB)
#define PG8_SB(b, h) ((4 + (b) * 2 + (h)) * HTB)
#define PG8_STAGE(bufoff, gbase, voff) do { _Pragma("unroll") for (int _i = 0; _i < 2; ++_i) \
        __builtin_amdgcn_global_load_lds((const unsigned*)((const char*)(gbase) + (voff)[_i]), (PG8_LAS unsigned*)(lds + (bufoff) + ldsw + _i * 8192), 16, 0, 0); } while (0)
#define PG8_LDA(dst, b, h) do { _Pragma("unroll") for (int m = 0; m < 4; ++m) _Pragma("unroll") for (int k = 0; k < 2; ++k) dst[m][k] = *(const PG8_LAS bf16x8*)(lds + PG8_SA(b, h) + aoff + m * 2048 + k * 1024); } while (0)
#define PG8_LDB(dst, b, h) do { _Pragma("unroll") for (int n = 0; n < 2; ++n) _Pragma("unroll") for (int k = 0; k < 2; ++k) dst[n][k] = *(const PG8_LAS bf16x8*)(lds + PG8_SB(b, h) + boff + n * 2048 + k * 1024); } while (0)
#define PG8_MMA(ai, bj, At, Bt) do { __builtin_amdgcn_s_setprio(1); _Pragma("unroll") for (int m = 0; m < 4; ++m) _Pragma("unroll") for (int n = 0; n < 2; ++n) _Pragma("unroll") for (int k = 0; k < 2; ++k) \
        acc[ai][bj][m][n] = __builtin_amdgcn_mfma_f32_16x16x32_bf16(Bt[n][k], At[m][k], acc[ai][bj][m][n], 0, 0, 0); __builtin_amdgcn_s_setprio(0); } while (0)
#define PG8_WAIT_V(n) asm volatile("s_waitcnt vmcnt(" #n ")" ::: "memory")
#define PG8_WAIT_L(n) asm volatile("s_waitcnt lgkmcnt(" #n ")" ::: "memory")
#define PG8_BAR __builtin_amdgcn_s_barrier()
#define PG8_SCHED __builtin_amdgcn_sched_barrier(0)
    Unit cur, nxt; int ui = 0;
    if (!S.next(0, cur)) return;
    f32x4 acc[2][2][4][2];
    bf16x8 At[4][2], B0[2][2], B1[2][2];
    const char* cA = (const char*)g.A + (size_t)cur.pm * tstep + cur.kb; const char* cB = (const char*)g.Bt + (size_t)cur.pn * tstep + cur.kb;
    S.a_ready(cur);
    E.init(acc, cur, wr, wc, fr, fq);
    PG8_STAGE(PG8_SB(0, 0), cB, voffB); PG8_STAGE(PG8_SA(0, 0), cA, voffA); PG8_STAGE(PG8_SB(0, 1), cB + hstep, voffB); PG8_STAGE(PG8_SA(0, 1), cA + hstep, voffA);
    if (wr == 1) PG8_BAR;
    PG8_WAIT_V(4); PG8_BAR;
    PG8_STAGE(PG8_SB(1, 0), cB + kstep, voffB); PG8_STAGE(PG8_SA(1, 0), cA + kstep, voffA); PG8_STAGE(PG8_SB(1, 1), cB + hstep + kstep, voffB);
    PG8_WAIT_V(6); PG8_BAR;
    PG8_STAMP();
    for (;;) {
        const bool has_next = S.next(ui + 1, nxt);
        const char* nA = has_next ? (const char*)g.A + (size_t)nxt.pm * tstep + nxt.kb : cA; const char* nB = has_next ? (const char*)g.Bt + (size_t)nxt.pn * tstep + nxt.kb : cB;
        const int unt = cur.nt > 0 ? cur.nt : nt;
        for (int t = 0; t < unt; t += 2) {
            const bool last = (t == unt - 2);
            const char* a1 = cA + (size_t)(t + 1) * kstep;
            const char* a2 = last ? nA : cA + (size_t)(t + 2) * kstep; const char* b2 = last ? nB : cB + (size_t)(t + 2) * kstep;
            const char* a3 = a2 + kstep; const char* b3 = b2 + kstep;
            if (last && has_next) S.a_ready(nxt);
            PG8_LDB(B0, 0, 0); PG8_SCHED; PG8_LDA(At, 0, 0); PG8_STAGE(PG8_SA(1, 1), a1 + hstep, voffA);
            PG8_WAIT_L(8); PG8_BAR; PG8_WAIT_L(0); PG8_MMA(0, 0, At, B0); PG8_BAR; PG8_SCHED;
            PG8_LDB(B1, 0, 1); PG8_STAGE(PG8_SB(0, 0), b2, voffB);
            PG8_BAR; PG8_WAIT_L(0); PG8_MMA(0, 1, At, B1); PG8_BAR;
            PG8_LDA(At, 0, 1); PG8_STAGE(PG8_SA(0, 0), a2, voffA);
            PG8_BAR; PG8_WAIT_L(0); PG8_MMA(1, 0, At, B0); PG8_BAR; PG8_SCHED;
            PG8_STAGE(PG8_SB(0, 1), b2 + hstep, voffB);
            PG8_WAIT_V(6); PG8_BAR; PG8_MMA(1, 1, At, B1); PG8_BAR;
            PG8_LDB(B0, 1, 0); PG8_SCHED; PG8_LDA(At, 1, 0); PG8_STAGE(PG8_SA(0, 1), a2 + hstep, voffA);
            PG8_WAIT_L(8); PG8_BAR; PG8_WAIT_L(0); PG8_MMA(0, 0, At, B0); PG8_BAR; PG8_SCHED;
            PG8_LDB(B1, 1, 1); PG8_STAGE(PG8_SB(1, 0), b3, voffB);
            PG8_BAR; PG8_WAIT_L(0); PG8_MMA(0, 1, At, B1); PG8_BAR;
            PG8_LDA(At, 1, 1); PG8_STAGE(PG8_SA(1, 0), a3, voffA);
            PG8_BAR; PG8_WAIT_L(0); PG8_MMA(1, 0, At, B0); PG8_BAR; PG8_SCHED;
            PG8_STAGE(PG8_SB(1, 1), b3 + hstep, voffB);
            PG8_WAIT_V(6); PG8_BAR; PG8_MMA(1, 1, At, B1); PG8_BAR;
        }
        PG8_STAMP();
        if constexpr (!Epi::AFTER_DRAIN) { E(acc, cur, wr, wc, fr, fq); S.done(cur); }
        PG8_STAMP();
        if (!has_next) break;
    E.init(acc, nxt, wr, wc, fr, fq);
        cur = nxt; cA = nA; cB = nB; ++ui;
    }
    PG8_WAIT_V(0);
    if (wr == 0) PG8_BAR;
    PG8_BAR;
    if constexpr (Epi::AFTER_DRAIN) { E.fused(acc, cur, wr, wc, fr, fq, lds, wid, lane); S.done(cur); }
    PG8_STAMP();
    if (STAMP && wid == 0) { stamps[lane] = lane < nts ? (((unsigned long long)(unsigned)ts_hi << 32) | (unsigned)ts_lo) : 0ull;
        if (lane == 62) stamps[62] = rt_entry; if (lane == 63) stamps[63] = (unsigned long long)wall_clock64(); }
#undef PG8_STAMP
#undef PG8_SA
#undef PG8_SB
#undef PG8_STAGE
#undef PG8_LDA
#undef PG8_LDB
#undef PG8_MMA
#undef PG8_WAIT_V
#undef PG8_WAIT_L
#undef PG8_BAR
#undef PG8_SCHED
}
}
using pg8::bf16_t; using pg8::bf16x8; using pg8::f32x4; using pg8::u32x4; using pg8::cvt_pk_bf16;
typedef unsigned u32x2 __attribute__((ext_vector_type(2)));
typedef float f32x2v __attribute__((ext_vector_type(2)));

constexpr int MT = 16896, MP = 16384;
constexpr size_t OFF_PROJ = 0;
constexpr size_t OFF_MIXED = 86507520;
constexpr size_t OFF_RW = 121110528;
constexpr size_t RWSZ = (size_t)MT * 256;
constexpr size_t OFF_Y = 224919552;
constexpr size_t OFF_UPT = OFF_Y, OFF_DOWNT = OFF_Y + 8388608;
constexpr size_t OFF_WINT = 242221056;
constexpr size_t OFF_WOUTT = 247463936;
constexpr size_t OFF_HST = 249561088;
constexpr size_t OFF_HD = 257949696;
constexpr size_t OFF_S5E = 258080768;
constexpr size_t OFF_C12 = 260177920;
constexpr size_t OFF_S5C = 261259264;
constexpr size_t OFF_CMT = OFF_S5C + 147456;
constexpr size_t OFF_GLUT = OFF_CMT + 65536;
constexpr size_t OFF_W2T = OFF_GLUT + 131072;
constexpr size_t OFF_A2T = OFF_W2T + 32768;
constexpr size_t OFF_G2T = OFF_A2T + 32768;
constexpr size_t OFF_PWT = OFF_G2T + 65536;
constexpr size_t OFF_LB = OFF_PWT + 32768;
constexpr size_t OFF_CTR = OFF_LB + 1024;
constexpr size_t OFF_HIDDEN = 0;
constexpr size_t OFF_XN2 = 138412032;
constexpr size_t OFF_BBT = OFF_CTR + 256;
constexpr size_t OFF_RSQ1 = OFF_BBT + 131072;
constexpr size_t OFF_RSQ2 = OFF_RSQ1 + 67584;
constexpr size_t OFF_HB1 = 173015040;
constexpr size_t CSTRIDE = 1048576;
constexpr size_t OFF_PART = 207618048;
constexpr size_t WS_END = OFF_RSQ2 + 67584;
constexpr size_t O_PSRE = 17301504, O_PSIM = O_PSRE + 16384, O_PHG = O_PSIM + 16384, O_PWKV = O_PHG + 262144, O_PSH = O_PWKV + 262144, O_PPOOL = O_PSH + 16384,
    O_SSRE = O_PPOOL + 61440, O_SSIM = O_SSRE + 262144, O_SHG = O_SSIM + 262144, O_SWKV = O_SHG + 4194304, O_SSH = O_SWKV + 4194304, O_SPOOL = O_SSH + 262144;
constexpr int LDS_BYTES = 147456;
constexpr int LDS_TASK_OFF = 146432;

struct Params { const float* in[40]; float* out; unsigned char* ws; };
#define AS4 __attribute__((address_space(4)))
struct KP { const AS4 char* k;
    __device__ __forceinline__ const float* in(int i) const { return *(const float* const AS4*)(k + 8 * i); }
    __device__ __forceinline__ float* out() const { return *(float* const AS4*)(k + 320); }
    __device__ __forceinline__ unsigned char* ws() const { return *(unsigned char* const AS4*)(k + 328); } };
__device__ __forceinline__ KP get_kp() { int z = 0; asm volatile("" : "+s"(z)); z = __builtin_amdgcn_readfirstlane(z); KP p; p.k = (const AS4 char*)__builtin_amdgcn_kernarg_segment_ptr() + z; return p; }

__device__ __forceinline__ float bf2f(bf16_t v) { return __uint_as_float(((unsigned)v) << 16); }
__device__ __forceinline__ float bflo(unsigned w) { return __uint_as_float(w << 16); }
__device__ __forceinline__ float bfhi(unsigned w) { return __uint_as_float(w & 0xffff0000u); }
__device__ __forceinline__ bf16_t f2bf(float f) { return (bf16_t)(cvt_pk_bf16(f, 0.f) & 0xffffu); }
__device__ __forceinline__ void unpack8(const u32x4 v, float* o) { o[0] = bflo(v.x); o[1] = bfhi(v.x); o[2] = bflo(v.y); o[3] = bfhi(v.y); o[4] = bflo(v.z); o[5] = bfhi(v.z); o[6] = bflo(v.w); o[7] = bfhi(v.w); }
__device__ __forceinline__ void unpack4(const u32x2 v, float* o) { o[0] = bflo(v.x); o[1] = bfhi(v.x); o[2] = bflo(v.y); o[3] = bfhi(v.y); }
__device__ __forceinline__ u32x2 pack4(const float* o) { u32x2 r; r.x = cvt_pk_bf16(o[0], o[1]); r.y = cvt_pk_bf16(o[2], o[3]); return r; }
__device__ __forceinline__ float sigm(float x) { return __builtin_amdgcn_rcpf(1.f + __expf(-x)); }
__device__ __forceinline__ float tanh_(float x) { return 1.f - 2.f * __builtin_amdgcn_rcpf(1.f + __expf(2.f * x)); }
__device__ __forceinline__ float gelu_t(float x) { return 0.5f * x * (1.f + tanh_(0.7978845608f * (x + 0.044715f * x * x * x))); }
__device__ __forceinline__ float shx(float v, int lane, int m) { return __int_as_float(__builtin_amdgcn_ds_bpermute((lane ^ m) << 2, __float_as_int(v))); }
__device__ __forceinline__ float wave_sum(float v, int lane) {
#pragma unroll
    for (int o = 1; o < 64; o <<= 1) v += shx(v, lane, o);
    return v; }
__device__ __forceinline__ void row_info(int r, int& b, int& t, bool& pr) { pr = r < MP; if (pr) { b = r >> 11; t = r & 2047; } else { b = (r - MP) >> 2; t = (r - MP) & 3; } }
#define MFMA16(a, b, c) __builtin_amdgcn_mfma_f32_16x16x32_bf16((a), (b), (c), 0, 0, 0)
#define LDSWAIT() asm volatile("s_waitcnt lgkmcnt(0)" ::: "memory")

__device__ __forceinline__ void transpose_item(const float* W, int K, int N, bf16_t* WT, float* scr, int item, int lane, const float* gk) {
    const int nblk = N >> 5, kb = item / nblk, nb = item - kb * nblk, k0 = kb << 6, n0 = nb << 5;
    float tv[32];
#pragma unroll
    for (int i = 0; i < 32; ++i) { const int kk = 2 * i + (lane >> 5); tv[i] = W[(size_t)(k0 + kk) * N + n0 + (lane & 31)]; }
    if (gk) {
#pragma unroll
        for (int i = 0; i < 32; ++i) tv[i] *= gk[k0 + 2 * i + (lane >> 5)]; }
#pragma unroll
    for (int i = 0; i < 32; ++i) { const int kk = 2 * i + (lane >> 5); scr[kk * 33 + (lane & 31)] = tv[i]; }
    LDSWAIT();
    const int c = lane & 7;
#pragma unroll
    for (int j = 0; j < 4; ++j) { const int n = (lane >> 3) + 8 * j; const float* s = scr + (8 * c) * 33 + n;
        u32x4 o; o.x = cvt_pk_bf16(s[0], s[33]); o.y = cvt_pk_bf16(s[66], s[99]); o.z = cvt_pk_bf16(s[132], s[165]); o.w = cvt_pk_bf16(s[198], s[231]);
        *(u32x4*)(WT + (size_t)(n0 + n) * K + k0 + 8 * c) = o; }
    LDSWAIT();
}
__device__ __forceinline__ void norm_rows(const KP& P, int l, int which) {
    const int tid = otid(), lane = tid & 63, wave = tid >> 6, gw = blockIdx.x * 8 + wave, NGW = gridDim.x * 8;
    const bool all = (which == 2) || (which == 0 && l == 0);
    const int nsplit = which == 1 ? 4 : ((which == 0 && l == 0) ? 0 : 8);
    const int rlo = all ? 0 : MP;
    bf16_t* HB = (bf16_t*)(P.ws() + (which == 0 ? OFF_HB1 : OFF_XN2));
    float* RSQ = (float*)(P.ws() + (which == 0 ? OFF_RSQ1 : OFF_RSQ2));
    f32x4 gg[4];
#pragma unroll
    for (int j = 0; j < 4; ++j) gg[j] = ((const f32x4*)P.in(39))[lane + 64 * j];
#pragma unroll 1
    for (int rb = rlo + gw; rb < MT; rb += 4 * NGW) {
        f32x4 v[4][4];
#pragma unroll
        for (int q = 0; q < 4; ++q) { const int r = rb + q * NGW;
            if (r < MT) { const float* src = P.out() + (size_t)r * 1024;
                if (l == 0 && which != 2 && !(which == 1 && false)) { if (which == 0 || which == 1) src = (r < MP) ? P.in(0) + (size_t)r * 1024 : P.in(1) + (size_t)(r - MP) * 1024; }
#pragma unroll
                for (int j = 0; j < 4; ++j) v[q][j] = ((const f32x4*)src)[lane + 64 * j];
                if (nsplit > 0 && r >= MP) { const float* pp = (const float*)(P.ws() + OFF_PART) + (size_t)(r - MP) * 1024;
#pragma unroll 1
                    for (int k0 = 0; k0 < nsplit; k0 += 4) { f32x4 pv[4][4];
#pragma unroll
                        for (int ks = 0; ks < 4; ++ks)
#pragma unroll
                            for (int j = 0; j < 4; ++j) pv[ks][j] = ((const f32x4*)(pp + (size_t)(k0 + ks) * 512 * 1024))[lane + 64 * j];
#pragma unroll
                        for (int ks = 0; ks < 4; ++ks)
#pragma unroll
                            for (int j = 0; j < 4; ++j) v[q][j] += pv[ks][j]; } } }
            else {
#pragma unroll
                for (int j = 0; j < 4; ++j) v[q][j] = (f32x4){0.f, 0.f, 0.f, 0.f}; } }
#pragma unroll
        for (int q = 0; q < 4; ++q) { const int r = rb + q * NGW; float s = 0.f;
#pragma unroll
            for (int j = 0; j < 4; ++j) s += v[q][j].x * v[q][j].x + v[q][j].y * v[q][j].y + v[q][j].z * v[q][j].z + v[q][j].w * v[q][j].w;
            s = wave_sum(s, lane);
            if (r < MT) { float* hrow = P.out() + (size_t)r * 1024;
                if (which == 2) { const float rstd = rsqrtf(s * (1.f / 1024.f) + 1e-6f);
#pragma unroll
                    for (int j = 0; j < 4; ++j) ((f32x4*)hrow)[lane + 64 * j] = v[q][j] * rstd * gg[j]; }
                else { if (lane == 0) RSQ[r] = s;
#pragma unroll
                    for (int j = 0; j < 4; ++j) { if (r >= MP && !(which == 0 && l == 0)) ((f32x4*)hrow)[lane + 64 * j] = v[q][j];
                        u32x2 w; w.x = cvt_pk_bf16(v[q][j].x, v[q][j].y); w.y = cvt_pk_bf16(v[q][j].z, v[q][j].w); *(u32x2*)(HB + (size_t)r * 1024 + (lane + 64 * j) * 4) = w; } } }
        }
    }
}
__device__ __forceinline__ void phaseA(const KP& P, int l0, unsigned char* smem) {
    const int l = l0;
    const int tid = otid(), lane = tid & 63, wave = tid >> 6, gw = blockIdx.x * 8 + wave, NGW = gridDim.x * 8;
#ifdef PROBE_SEL
    const unsigned long long a0_ = __builtin_amdgcn_s_memrealtime();
#endif
    norm_rows(P, l, 0);
#ifdef PROBE_SEL
    const unsigned long long a1_ = __builtin_amdgcn_s_memrealtime();
#endif
    float* scr = (float*)smem + wave * (64 * 33);
    if (l == 0) for (int it = gw; it < 1280; it += NGW) transpose_item(P.in(9), 1024, 2560, (bf16_t*)(P.ws() + OFF_WINT), scr, it, lane, P.in(8));
#ifdef PROBE_SEL
    const unsigned long long a2_ = __builtin_amdgcn_s_memrealtime();
#endif
    {
    const int gt = blockIdx.x * 512 + tid, NT = gridDim.x * 512;
    float* S5C = (float*)(P.ws() + OFF_S5C + l * CSTRIDE);
    for (int e = gt; e < 16384; e += NT) {
        const int idx = e >> 4, h = e & 15, g = idx >> 6, pp = idx & 63;
        const float lr = P.in(10)[l * 1024 + idx], li = P.in(11)[l * 1024 + idx], dt = expf(P.in(12)[l * 16 + g]);
        const float mag = expf(lr * dt); float sn, cs; sincosf(li * dt, &sn, &cs);
        const float abr = mag * cs, abi = mag * sn;
        if (h == 0) { const float magL = expf(64.f * lr * dt); float snL, csL; sincosf(64.f * li * dt, &snL, &csL);
            S5C[idx] = abr; S5C[1024 + idx] = abi; S5C[2048 + idx] = magL * csL; S5C[3072 + idx] = magL * snL; }
        const float den = lr * lr + li * li, zr = abr - 1.f, zi = abi;
        const float cr = (zr * lr + zi * li) / den, ci = (zi * lr - zr * li) / den;
        const float br = P.in(13)[((size_t)l * 1024 + idx) * 16 + h], bi = P.in(14)[((size_t)l * 1024 + idx) * 16 + h];
        bf16_t* BBT = (bf16_t*)(P.ws() + OFF_BBT + l * CSTRIDE);
        BBT[(g * 128 + pp) * 32 + h] = f2bf(cr * br - ci * bi); BBT[(g * 128 + 64 + pp) * 32 + h] = f2bf(cr * bi + ci * br); BBT[(g * 128 + pp) * 32 + 16 + h] = 0; BBT[(g * 128 + 64 + pp) * 32 + 16 + h] = 0;
    }
    bf16_t* CMT = (bf16_t*)(P.ws() + OFF_CMT + l * CSTRIDE);
    for (int idx = gt; idx < 32768; idx += NT) { const int gh = idx >> 7, pp = idx & 127;
        const float v = pp < 64 ? P.in(15)[((size_t)l * 256 + gh) * 64 + pp] : -P.in(16)[((size_t)l * 256 + gh) * 64 + pp - 64]; CMT[idx] = f2bf(v); }
    bf16_t* GLUT = (bf16_t*)(P.ws() + OFF_GLUT + l * CSTRIDE);
    for (int idx = gt; idx < 65536; idx += NT) { const int n = idx >> 8, k = idx & 255; GLUT[idx] = f2bf(P.in(18)[(size_t)l * 65536 + k * 256 + n]); }
    bf16_t* W2T = (bf16_t*)(P.ws() + OFF_W2T + l * CSTRIDE); bf16_t* A2T = (bf16_t*)(P.ws() + OFF_A2T + l * CSTRIDE); bf16_t* G2T = (bf16_t*)(P.ws() + OFF_G2T + l * CSTRIDE); bf16_t* PWT = (bf16_t*)(P.ws() + OFF_PWT + l * CSTRIDE);
    for (int idx = gt; idx < 16384; idx += NT) { const int c = idx >> 6, j = idx & 63;
        W2T[idx] = f2bf(P.in(24)[(size_t)l * 16384 + j * 256 + c]); A2T[idx] = f2bf(P.in(26)[(size_t)l * 16384 + j * 256 + c]);
        const int gi = idx >> 12, d = (idx >> 6) & 63, cc = idx & 63; PWT[idx] = f2bf(P.in(33)[(size_t)l * 16384 + gi * 4096 + cc * 64 + d]); }
    for (int idx = gt; idx < 32768; idx += NT) { const int c = idx >> 7, j = idx & 127; G2T[idx] = f2bf(P.in(27)[(size_t)l * 32768 + j * 256 + c]); }
    float* LB = (float*)(P.ws() + OFF_LB + l * CSTRIDE);
    for (int idx = gt; idx < 256; idx += NT) LB[idx] = (l == 0) ? 0.f : sigm(P.in(20)[256 + idx] - P.in(20)[idx]);
    }
#ifdef PROBE_SEL
    if (l == 0 && tid == 0 && (blockIdx.x == 0 || blockIdx.x == 100)) { float* sl = (float*)(P.ws() + OFF_CTR) + (blockIdx.x == 0 ? 56 : 60); const unsigned long long a3_ = __builtin_amdgcn_s_memrealtime();
        sl[0] = (float)(a1_ - a0_) * 0.01f; sl[1] = (float)(a2_ - a1_) * 0.01f; sl[2] = (float)(a3_ - a2_) * 0.01f; }
#endif
    if (blockIdx.x == 0 && tid == 0) { ((unsigned*)(P.ws() + OFF_CTR))[l] = 0u; ((unsigned*)(P.ws() + OFF_CTR))[2 + l] = 0u; }
}
__device__ __forceinline__ void phaseG(const KP& P, int l, unsigned char* smem) { norm_rows(P, l, 1); }

template <int MTW  > __device__ __forceinline__ void rwkv_prep_tile(const KP& P, int l, unsigned char* smem, int tile) {
    const int tid = otid(), lane = tid & 63, wave = tid >> 6, fr = lane & 15, fq = lane >> 4;
    const int r0 = tile * (32 * MTW);
    const bf16_t* PROJ = (const bf16_t*)(P.ws() + OFF_PROJ);
    bf16_t* MIXED = (bf16_t*)(P.ws() + OFF_MIXED);
    bf16_t* Aop = (bf16_t*)smem;
    const float* mu = P.in(22) + l * 1024;
    const float* shs = P.in(6) + (size_t)l * 128 * 1024;
    __syncthreads();
#pragma unroll 2
    for (int i = 0; i < 2 * MTW; ++i) {
        const int item = tid + 512 * i, tok = item >> 5, j0 = (item & 31) * 8, r = r0 + tok;
        int b, t; bool pr; row_info(r, b, t, pr);
        float p[8], q[8], o[8];
        unpack8(*(const u32x4*)(PROJ + (size_t)r * 2560 + 2048 + j0), p);
        if (t > 0) unpack8(*(const u32x4*)(PROJ + (size_t)(r - 1) * 2560 + 2048 + j0), q);
        else if (!pr) { const float* s = shs + (size_t)b * 1024 + 768 + j0;
#pragma unroll
            for (int e = 0; e < 8; ++e) q[e] = s[e]; }
        else {
#pragma unroll
            for (int e = 0; e < 8; ++e) q[e] = 0.f; }
#pragma unroll
        for (int e = 0; e < 8; ++e) { const float xs = p[e] + (q[e] - p[e]) * mu[768 + j0 + e]; o[e] = j0 < 64 ? tanh_(xs) : (j0 < 128 ? xs : sigm(xs)); }
        u32x4 w; w.x = cvt_pk_bf16(o[0], o[1]); w.y = cvt_pk_bf16(o[2], o[3]); w.z = cvt_pk_bf16(o[4], o[5]); w.w = cvt_pk_bf16(o[6], o[7]);
        *(u32x4*)(Aop + tok * 264 + j0) = w;
    }
    bf16_t* XS = (bf16_t*)(smem + 34816);
#pragma unroll 2
    for (int i = 0; i < 6 * MTW; ++i) {
        const int item = tid + 512 * i, tok = item / 96, j0 = (item - tok * 96) * 8, r = r0 + tok;
        int b, t; bool pr; row_info(r, b, t, pr);
        float p[8], q[8], o[8];
        unpack8(*(const u32x4*)(PROJ + (size_t)r * 2560 + 1280 + j0), p);
        if (t > 0) unpack8(*(const u32x4*)(PROJ + (size_t)(r - 1) * 2560 + 1280 + j0), q);
        else if (!pr) { const float* sp = shs + (size_t)b * 1024 + j0;
#pragma unroll
            for (int e = 0; e < 8; ++e) q[e] = sp[e]; }
        else {
#pragma unroll
            for (int e = 0; e < 8; ++e) q[e] = 0.f; }
#pragma unroll
        for (int e = 0; e < 8; ++e) o[e] = p[e] + (q[e] - p[e]) * mu[j0 + e];
        u32x4 w; w.x = cvt_pk_bf16(o[0], o[1]); w.y = cvt_pk_bf16(o[2], o[3]); w.z = cvt_pk_bf16(o[4], o[5]); w.w = cvt_pk_bf16(o[6], o[7]);
        *(u32x4*)(XS + tok * 776 + j0) = w;
    }
#pragma unroll 1
    for (int tok = 0; tok < 32 * MTW; ++tok) { const int r = r0 + tok; int b, t; bool pr; row_info(r, b, t, pr);
        if (pr ? (t == 2047) : (t == 3)) { float* dst = P.out() + (pr ? O_PSH + (size_t)(l * 8 + b) * 1024 : O_SSH + (size_t)(l * 128 + b) * 1024);
            for (int idx = tid; idx < 1024; idx += 512) dst[idx] = bf2f(PROJ[(size_t)r * 2560 + 1280 + idx]); } }
    __syncthreads();
    const int hd = wave & 3, th = wave >> 2;
    const bf16_t* W2T = (const bf16_t*)(P.ws() + OFF_W2T + l * CSTRIDE); const bf16_t* A2T = (const bf16_t*)(P.ws() + OFF_A2T + l * CSTRIDE); const bf16_t* G2T = (const bf16_t*)(P.ws() + OFF_G2T + l * CSTRIDE);
    f32x4 accw[4][MTW], acca[4][MTW], accg[4][MTW];
#pragma unroll
    for (int nt = 0; nt < 4; ++nt)
#pragma unroll
        for (int mt = 0; mt < MTW; ++mt) { accw[nt][mt] = (f32x4){0.f, 0.f, 0.f, 0.f}; acca[nt][mt] = accw[nt][mt]; accg[nt][mt] = accw[nt][mt]; }
#pragma unroll
    for (int nt = 0; nt < 4; ++nt) { const int n = hd * 64 + nt * 16 + fr;
#pragma unroll
        for (int ks = 0; ks < 2; ++ks) {
            const bf16x8 wf = *(const bf16x8*)(W2T + n * 64 + ks * 32 + fq * 8), af = *(const bf16x8*)(A2T + n * 64 + ks * 32 + fq * 8);
#pragma unroll
            for (int mt = 0; mt < MTW; ++mt) { const bf16_t* xr = Aop + (th * 16 * MTW + mt * 16 + fr) * 264 + ks * 32 + fq * 8;
                accw[nt][mt] = MFMA16(wf, *(const bf16x8*)xr, accw[nt][mt]); acca[nt][mt] = MFMA16(af, *(const bf16x8*)(xr + 64), acca[nt][mt]); } }
#pragma unroll
        for (int ks = 0; ks < 4; ++ks) { const bf16x8 gf = *(const bf16x8*)(G2T + n * 128 + ks * 32 + fq * 8);
#pragma unroll
            for (int mt = 0; mt < MTW; ++mt) accg[nt][mt] = MFMA16(gf, *(const bf16x8*)(Aop + (th * 16 * MTW + mt * 16 + fr) * 264 + 128 + ks * 32 + fq * 8), accg[nt][mt]); } }
    float* RW = (float*)(P.ws() + OFF_RW);
    float* C12 = (float*)(P.ws() + OFF_C12);
    const float* w0 = P.in(23) + l * 256; const float* a0 = P.in(25) + l * 256; const float* kkw = P.in(28) + l * 256; const float* kaw = P.in(29) + l * 256; const float* rkw = P.in(30) + l * 256;
#pragma unroll
    for (int mt = 0; mt < MTW; ++mt) {
        const int r = r0 + th * 16 * MTW + mt * 16 + fr; int b, t; bool pr; row_info(r, b, t, pr);
        float kkr[4][4], av[4][4], xrr[4][4]; float ss = 0.f, bs = 0.f, c2 = 0.f;
#pragma unroll
        for (int nt = 0; nt < 4; ++nt) {
            const int c0 = hd * 64 + nt * 16 + fq * 4;
            float xr4[4], xk4[4], xv4[4];
            { const bf16_t* xrow = XS + (th * 16 * MTW + mt * 16 + fr) * 776 + c0; unpack4(*(const u32x2*)(xrow), xr4); unpack4(*(const u32x2*)(xrow + 256), xk4); unpack4(*(const u32x2*)(xrow + 512), xv4); }
            f32x4 owr, ow, ok, ov; float gg[4];
#pragma unroll
            for (int j = 0; j < 4; ++j) { const int c = c0 + j;
                const float xr = xr4[j], xk = xk4[j], xv = xv4[j];
                const float wp = w0[c] + accw[nt][mt][j];
                const float nx = -wp;
                const float sp = fmaxf(nx, 0.f) + __logf(1.f + __expf(-fabsf(nx)));
                const float wv = -sp - 0.5f;
                const float dec = __expf(-__expf(wv));
                const float a = sigm(a0[c] + acca[nt][mt][j]);
                const float kr = xk * kkw[c]; ss += kr * kr;
                const float k = xk * (1.f + (a - 1.f) * kaw[c]);
                bs += xr * k * rkw[c]; c2 += xr * k;
                kkr[nt][j] = kr; av[nt][j] = a; xrr[nt][j] = xr;
                owr[j] = dec * xr; ow[j] = dec; ok[j] = k; ov[j] = xv; gg[j] = accg[nt][mt][j]; }
            const size_t o = (size_t)r * 256 + c0;
            *(f32x4*)(RW + 1 * RWSZ + o) = owr; *(f32x4*)(RW + 2 * RWSZ + o) = ow; *(f32x4*)(RW + 4 * RWSZ + o) = ok; *(f32x4*)(RW + 5 * RWSZ + o) = ov;
            *(u32x2*)(MIXED + (size_t)r * 1024 + 512 + c0) = pack4(gg);
        }
        ss += shx(ss, lane, 16); ss += shx(ss, lane, 32); bs += shx(bs, lane, 16); bs += shx(bs, lane, 32); c2 += shx(c2, lane, 16); c2 += shx(c2, lane, 32);
        const float inv = __builtin_amdgcn_rsqf(fmaxf(ss, 1e-24f)); float c1 = 0.f;
#pragma unroll
        for (int nt = 0; nt < 4; ++nt) { const int c0 = hd * 64 + nt * 16 + fq * 4; f32x4 okk, okka;
#pragma unroll
            for (int j = 0; j < 4; ++j) { const float kk = kkr[nt][j] * inv, kka = kk * av[nt][j]; okk[j] = kk; okka[j] = kka; c1 += kka * xrr[nt][j]; }
            const size_t o = (size_t)r * 256 + c0; *(f32x4*)(RW + 0 * RWSZ + o) = okk; *(f32x4*)(RW + 3 * RWSZ + o) = okka; }
        c1 += shx(c1, lane, 16); c1 += shx(c1, lane, 32);
        if (fq == 0) *(f32x4*)(C12 + (size_t)r * 16 + hd * 4) = (f32x4){c1, c2, bs, 0.f};
    }
}

__device__ __forceinline__ void pool_tile(const KP& P, int l, unsigned char* smem, int tile) {
    const int tid = otid(), lane = tid & 63, wave = tid >> 6, fr = lane & 15, fq = lane >> 4;
    const int r0 = tile * 64;
    const bf16_t* PROJ = (const bf16_t*)(P.ws() + OFF_PROJ);
    bf16_t* MIXED = (bf16_t*)(P.ws() + OFF_MIXED);
    bf16_t* Pop = (bf16_t*)smem;
    const float* pst = P.in(7) + (size_t)l * 128 * 15 * 256;
    __syncthreads();
#pragma unroll 2
    for (int i = 0; i < 4; ++i) {
        const int item = tid + 512 * i, tok = item >> 5, ch0 = (item & 31) * 8, r = r0 + tok, win = 2 << (ch0 >> 6);
        int b, t; bool pr; row_info(r, b, t, pr);
        float s[8], u[8];
#pragma unroll
        for (int e = 0; e < 8; ++e) { s[e] = 0.f; u[e] = 0.f; }
        if (pr) {
            u32x4 xv[16];
#pragma unroll
            for (int j = 0; j < 16; ++j) { xv[j] = (u32x4){0u, 0u, 0u, 0u}; if (j < win && t - j >= 0) xv[j] = *(const u32x4*)(PROJ + (size_t)(r - j) * 2560 + 2304 + ch0); }
#pragma unroll
            for (int j = 0; j < 16; ++j) { float x[8]; unpack8(xv[j], x);
#pragma unroll
                for (int e = 0; e < 8; ++e) { s[e] += x[e]; if (j == 0) u[e] = x[e]; } }
        } else {
            for (int j = 0; j < win; ++j) { const int tt = t - j; float x[8];
                if (tt >= 0) unpack8(*(const u32x4*)(PROJ + (size_t)(r - j) * 2560 + 2304 + ch0), x);
                else { const float* bp = pst + ((size_t)b * 15 + 15 + tt) * 256 + ch0;
#pragma unroll
                    for (int e = 0; e < 8; ++e) x[e] = bp[e]; }
                if (j == 0) {
#pragma unroll
                    for (int e = 0; e < 8; ++e) u[e] = x[e]; }
#pragma unroll
                for (int e = 0; e < 8; ++e) s[e] += x[e]; }
        }
        const float cnt = pr ? (float)min(t + 1, win) : (float)win, ic = 1.f / cnt; float o[8];
#pragma unroll
        for (int e = 0; e < 8; ++e) o[e] = s[e] * ic - u[e];
        u32x4 w; w.x = cvt_pk_bf16(o[0], o[1]); w.y = cvt_pk_bf16(o[2], o[3]); w.z = cvt_pk_bf16(o[4], o[5]); w.w = cvt_pk_bf16(o[6], o[7]);
        *(u32x4*)(Pop + tok * 264 + ch0) = w;
    }
    if (r0 < MP) { if ((r0 & 2047) == 1984) { const int b = r0 >> 11; float* dst = P.out() + O_PPOOL + (size_t)(l * 8 + b) * 3840;
            for (int idx = tid; idx < 3840; idx += 512) { const int j = idx >> 8, ch = idx & 255; dst[idx] = bf2f(PROJ[(size_t)(b * 2048 + 2033 + j) * 2560 + 2304 + ch]); } } }
    else { const int b0 = (r0 - MP) >> 2;
        for (int idx = tid; idx < 16 * 3840; idx += 512) { const int bb = idx / 3840, rem = idx - bb * 3840, j = rem >> 8, ch = rem & 255, b = b0 + bb;
            const float v = j < 11 ? pst[((size_t)b * 15 + j + 4) * 256 + ch] : bf2f(PROJ[(size_t)(MP + b * 4 + j - 11) * 2560 + 2304 + ch]);
            P.out()[O_SPOOL + (size_t)(l * 128 + b) * 3840 + rem] = v; } }
    __syncthreads();
    const bf16_t* PWT = (const bf16_t*)(P.ws() + OFF_PWT + l * CSTRIDE);
    const float* scale = P.in(34) + l * 256;
    f32x4 acc[2][4];
#pragma unroll
    for (int nt = 0; nt < 2; ++nt)
#pragma unroll
        for (int mt = 0; mt < 4; ++mt) acc[nt][mt] = (f32x4){0.f, 0.f, 0.f, 0.f};
#pragma unroll
    for (int nt = 0; nt < 2; ++nt) { const int n0 = wave * 32 + nt * 16, gi = n0 >> 6;
#pragma unroll
        for (int ks = 0; ks < 2; ++ks) { const bf16x8 wf = *(const bf16x8*)(PWT + (n0 + fr) * 64 + ks * 32 + fq * 8);
#pragma unroll
            for (int mt = 0; mt < 4; ++mt) acc[nt][mt] = MFMA16(wf, *(const bf16x8*)(Pop + (mt * 16 + fr) * 264 + gi * 64 + ks * 32 + fq * 8), acc[nt][mt]); } }
#pragma unroll
    for (int nt = 0; nt < 2; ++nt)
#pragma unroll
        for (int mt = 0; mt < 4; ++mt) { const int r = r0 + mt * 16 + fr, ch = wave * 32 + nt * 16 + fq * 4; float o[4];
#pragma unroll
            for (int j = 0; j < 4; ++j) o[j] = acc[nt][mt][j] * scale[ch + j];
            *(u32x2*)(MIXED + (size_t)r * 1024 + 768 + ch) = pack4(o); }
}

__device__ __forceinline__ void s5_task(const KP& P, int l, unsigned char* smem, int mode, int tile) {
    const int tid = otid(), lane = tid & 63, wave = tid >> 6, fr = lane & 15, fq = lane >> 4;
    const bool prompt = tile < 256;
    const int b = tile >> 5, c = tile & 31, st8 = tile - 256;
    const int r0 = prompt ? b * 2048 + c * 64 : MP + st8 * 64, b0 = st8 * 16;
    const bf16_t* PROJ = (const bf16_t*)(P.ws() + OFF_PROJ);
    bf16_t* MIXED = (bf16_t*)(P.ws() + OFF_MIXED);
    bf16_t* U = (bf16_t*)smem;
    bf16_t* Zb = (bf16_t*)(smem + 32768);
    float* BU = (float*)(smem + 32768 + 33792 + wave * 8448);
    __syncthreads();
#pragma unroll
    for (int i = 0; i < 4; ++i) { const int item = tid + 512 * i, tok = item >> 5, j0 = (item & 31) * 8;
        *(u32x4*)(U + tok * 256 + j0) = *(const u32x4*)(PROJ + (size_t)(r0 + tok) * 2560 + j0); }
    __syncthreads();
    const float* S5C = (const float*)(P.ws() + OFF_S5C + l * CSTRIDE);
    const bf16_t* CMT = (const bf16_t*)(P.ws() + OFF_CMT + l * CSTRIDE);
    const bf16_t* BBT = (const bf16_t*)(P.ws() + OFF_BBT + l * CSTRIDE);
    float* S5E = (float*)(P.ws() + OFF_S5E);
    const float* dsk = P.in(17) + l * 256;
#pragma unroll 1
    for (int gg = 0; gg < 2; ++gg) {
        const int g = 2 * wave + gg, gp = g * 64 + lane;
        const float ar = S5C[gp], ai = S5C[1024 + gp];
        float hr = 0.f, hi = 0.f;
        if (prompt && mode == 1) { const float alr = S5C[2048 + gp], ali = S5C[3072 + gp];
#pragma unroll 1
            for (int j0 = 0; j0 < c; j0 += 8) { f32x2v e[8];
#pragma unroll
                for (int jj = 0; jj < 8; ++jj) e[jj] = (j0 + jj < c) ? *(const f32x2v*)(S5E + ((size_t)((b * 32 + j0 + jj) * 16 + g) * 64 + lane) * 2) : (f32x2v){0.f, 0.f};
#pragma unroll
                for (int jj = 0; jj < 8; ++jj) if (j0 + jj < c) { const float nr = alr * hr - ali * hi + e[jj].x, ni = alr * hi + ali * hr + e[jj].y; hr = nr; hi = ni; } } }
        bf16x8 bfr[8], cfr[4];
#pragma unroll
        for (int pt = 0; pt < 8; ++pt) bfr[pt] = *(const bf16x8*)(BBT + (g * 128 + pt * 16 + fr) * 32 + fq * 8);
        if (mode == 1) {
#pragma unroll
            for (int ks = 0; ks < 4; ++ks) cfr[ks] = *(const bf16x8*)(CMT + (g * 16 + fr) * 128 + ks * 32 + fq * 8); }
        const f32x4 dsk4 = *(const f32x4*)(dsk + g * 16 + fq * 4);
#pragma unroll 1
        for (int st = 0; st < 4; ++st) {
            { bf16x8 uf = (bf16x8){0, 0, 0, 0, 0, 0, 0, 0};
              if (fq < 2) uf = *(const bf16x8*)(U + (st * 16 + fr) * 256 + g * 16 + fq * 8);
#pragma unroll
              for (int pt = 0; pt < 8; ++pt) { const f32x4 d = MFMA16(bfr[pt], uf, ((f32x4){0.f, 0.f, 0.f, 0.f})); *(f32x4*)(BU + fr * 132 + pt * 16 + fq * 4) = d; } }
            if (prompt) {
                float bur = BU[lane], bui = BU[64 + lane];
#pragma unroll
                for (int tt = 0; tt < 16; ++tt) {
                    const float nbr = BU[((tt + 1) & 15) * 132 + lane], nbi = BU[((tt + 1) & 15) * 132 + 64 + lane];
                    const float nr = ar * hr - ai * hi + bur, ni = ar * hi + ai * hr + bui; hr = nr; hi = ni; bur = nbr; bui = nbi;
                    if (mode == 1) { bf16_t* hb = (bf16_t*)(BU + tt * 132); hb[lane] = f2bf(hr); hb[64 + lane] = f2bf(hi); } }
            } else {
#pragma unroll 4
                for (int tt = 0; tt < 16; ++tt) { const int t = st * 16 + tt;
                    if ((t & 3) == 0) { const size_t so = ((size_t)(l * 128 + b0 + (t >> 2)) * 16 + g) * 64 + lane; hr = P.in(2)[so]; hi = P.in(3)[so]; }
                    const float bur = BU[tt * 132 + lane], bui = BU[tt * 132 + 64 + lane];
                    const float nr = ar * hr - ai * hi + bur, ni = ar * hi + ai * hr + bui; hr = nr; hi = ni;
                    bf16_t* hb = (bf16_t*)(BU + tt * 132); hb[lane] = f2bf(hr); hb[64 + lane] = f2bf(hi);
                    if ((t & 3) == 3) { const size_t so = ((size_t)(l * 128 + b0 + (t >> 2)) * 16 + g) * 64 + lane; P.out()[O_SSRE + so] = hr; P.out()[O_SSIM + so] = hi; } }
            }
            if (mode == 1) {
                f32x4 acc = (f32x4){0.f, 0.f, 0.f, 0.f};
#pragma unroll
                for (int ks = 0; ks < 4; ++ks) acc = MFMA16(cfr[ks], *(const bf16x8*)((const bf16_t*)(BU + fr * 132) + ks * 32 + fq * 8), acc);
                const int t = st * 16 + fr, ch = g * 16 + fq * 4; float u4[4], z[4];
                unpack4(*(const u32x2*)(U + t * 256 + ch), u4);
#pragma unroll
                for (int j = 0; j < 4; ++j) z[j] = gelu_t(acc[j] + dsk4[j] * u4[j]);
                *(u32x2*)(Zb + t * 264 + ch) = pack4(z);
            }
        }
        if (prompt && mode == 1 && c == 31) { const size_t so = ((size_t)(l * 8 + b) * 16 + g) * 64 + lane; P.out()[O_PSRE + so] = hr; P.out()[O_PSIM + so] = hi; }
        if (mode == 0) *(f32x2v*)(S5E + ((size_t)((b * 32 + c) * 16 + g) * 64 + lane) * 2) = (f32x2v){hr, hi};
    }
    if (mode == 1) {
        __syncthreads();
        const bf16_t* GLUT = (const bf16_t*)(P.ws() + OFF_GLUT + l * CSTRIDE);
        const float* gb = P.in(19) + l * 256;
        f32x4 acc[2][4];
#pragma unroll
        for (int nt = 0; nt < 2; ++nt)
#pragma unroll
            for (int mt = 0; mt < 4; ++mt) acc[nt][mt] = (f32x4){0.f, 0.f, 0.f, 0.f};
#pragma unroll
        for (int ks = 0; ks < 8; ++ks)
#pragma unroll
            for (int nt = 0; nt < 2; ++nt) { const bf16x8 wf = *(const bf16x8*)(GLUT + (wave * 32 + nt * 16 + fr) * 256 + ks * 32 + fq * 8);
#pragma unroll
                for (int mt = 0; mt < 4; ++mt) acc[nt][mt] = MFMA16(wf, *(const bf16x8*)(Zb + (mt * 16 + fr) * 264 + ks * 32 + fq * 8), acc[nt][mt]); }
#pragma unroll
        for (int nt = 0; nt < 2; ++nt)
#pragma unroll
            for (int mt = 0; mt < 4; ++mt) { const int tok = mt * 16 + fr, ch = wave * 32 + nt * 16 + fq * 4; float z4[4], o[4];
                unpack4(*(const u32x2*)(Zb + tok * 264 + ch), z4);
#pragma unroll
                for (int j = 0; j < 4; ++j) o[j] = z4[j] * sigm(acc[nt][mt][j] + gb[ch + j]);
                *(u32x2*)(MIXED + (size_t)(r0 + tok) * 1024 + ch) = pack4(o); }
    }
}

__device__ __forceinline__ void hgrn_task(const KP& P, int l, unsigned char* smem, int mode, int b, int hd, int sc) {
    const int tid = otid(), lane = tid & 63, wave = tid >> 6, fr = lane & 15, fq = lane >> 4;
    const bf16_t* PROJ = (const bf16_t*)(P.ws() + OFF_PROJ);
    bf16_t* MIXED = (bf16_t*)(P.ws() + OFF_MIXED);
    bf16_t* Qp = (bf16_t*)smem;
    bf16_t* Kn = Qp + 32 * 72;
    bf16_t* Kdt = Kn + 32 * 72;
    bf16_t* Vt = Kdt + 64 * 40;
    bf16_t* Att = Vt + 64 * 40;
    bf16_t* St = Att + 32 * 40;
    float* TOT = (float*)(St + 64 * 72);
    float* EB = TOT + 512;
    float* HST = (float*)(P.ws() + OFF_HST); float* HD = (float*)(P.ws() + OFF_HD);
    const int k = tid & 63, sg = tid >> 6, kt = wave >> 1, vt0 = (wave & 1) * 2;
    const float lbv = ((const float*)(P.ws() + OFF_LB + l * CSTRIDE))[hd * 64 + k];
    f32x4 accS[2] = {(f32x4){0.f, 0.f, 0.f, 0.f}, (f32x4){0.f, 0.f, 0.f, 0.f}};
    if (mode == 1) {
#pragma unroll 1
        for (int j0 = 0; j0 < sc; j0 += 4) { float dd[4][4], xx[4][2][4];
#pragma unroll
            for (int u = 0; u < 4; ++u) { const size_t bi = (size_t)((b * 4 + hd) * 16 + min(j0 + u, sc - 1));
#pragma unroll
                for (int jj = 0; jj < 4; ++jj) { const int kk = kt * 16 + fq * 4 + jj; dd[u][jj] = HD[bi * 64 + kk];
#pragma unroll
                    for (int i = 0; i < 2; ++i) xx[u][i][jj] = HST[(bi * 64 + kk) * 64 + (vt0 + i) * 16 + fr]; } }
#pragma unroll
            for (int u = 0; u < 4; ++u) if (j0 + u < sc) {
#pragma unroll
                for (int jj = 0; jj < 4; ++jj)
#pragma unroll
                    for (int i = 0; i < 2; ++i) accS[i][jj] = dd[u][jj] * accS[i][jj] + xx[u][i][jj]; } }
    } else if (mode == 2) { const float* sp = P.in(4) + ((size_t)(l * 128 + b) * 4 + hd) * 4096;
#pragma unroll
        for (int jj = 0; jj < 4; ++jj)
#pragma unroll
            for (int i = 0; i < 2; ++i) accS[i][jj] = sp[(kt * 16 + fq * 4 + jj) * 64 + (vt0 + i) * 16 + fr]; }
    __syncthreads();
    if (mode != 0) {
#pragma unroll
        for (int i = 0; i < 2; ++i) { float t4[4] = {accS[i][0], accS[i][1], accS[i][2], accS[i][3]}; *(u32x2*)(St + ((vt0 + i) * 16 + fr) * 72 + kt * 16 + fq * 4) = pack4(t4); } }
    float dsum = 0.f;
    const int nch = mode == 2 ? 1 : 4, L = mode == 2 ? 4 : 32;
    const int rbase = mode == 2 ? MP + b * 4 : b * 2048 + sc * 128;
    bf16_t rz[4], rq[4], rv[4];
#pragma unroll
    for (int e = 0; e < 4; ++e) { const int s = 4 * sg + e; rz[e] = 0; rq[e] = 0; rv[e] = 0;
        if (s < L) { const bf16_t* row = PROJ + (size_t)(rbase + s) * 2560 + hd * 64 + k; rz[e] = row[512]; rq[e] = row[256]; rv[e] = row[768]; } }
    f32x4 ngv[4];
#pragma unroll
    for (int vt = 0; vt < 4; ++vt) ngv[vt] = *(const f32x4*)(P.in(21) + l * 256 + hd * 64 + vt * 16 + fq * 4);
#pragma unroll 1
    for (int ch = 0; ch < nch; ++ch) {
        const int r0 = rbase + ch * 32;
        bf16_t nz[4], nq[4], nv[4];
#pragma unroll
        for (int e = 0; e < 4; ++e) { nz[e] = 0; nq[e] = 0; nv[e] = 0;
            if (ch + 1 < nch) { const bf16_t* row = PROJ + (size_t)(r0 + 32 + 4 * sg + e) * 2560 + hd * 64 + k; nz[e] = row[512]; nq[e] = row[256]; nv[e] = row[768]; } }
        u32x2 pgv[4];
#pragma unroll
        for (int vt = 0; vt < 4; ++vt) { pgv[vt] = (u32x2){0u, 0u}; if (mode != 0 && wave < 2 && wave * 16 + fr < L) pgv[vt] = *(const u32x2*)(PROJ + (size_t)(r0 + wave * 16 + fr) * 2560 + 1024 + hd * 64 + vt * 16 + fq * 4); }
        float lf[4], kv[4], q[4], vv[4], cs[4];
#pragma unroll
        for (int e = 0; e < 4; ++e) { const int s = 4 * sg + e; lf[e] = 0.f; kv[e] = 0.f; q[e] = 0.f; vv[e] = 0.f;
            if (s < L) { const float z = bf2f(rz[e]); const float f = lbv + (1.f - lbv) * sigm(z); lf[e] = __logf(f); kv[e] = 1.f - f;
                if (mode != 0) { const float pq = bf2f(rq[e]); q[e] = pq * sigm(pq); }
                vv[e] = bf2f(rv[e]); } }
#pragma unroll
        for (int e = 0; e < 4; ++e) { rz[e] = nz[e]; rq[e] = nq[e]; rv[e] = nv[e]; }
        cs[0] = lf[0]; cs[1] = cs[0] + lf[1]; cs[2] = cs[1] + lf[2]; cs[3] = cs[2] + lf[3];
        TOT[sg * 64 + k] = cs[3];
        __syncthreads();
        float off = 0.f, blast = 0.f;
#pragma unroll
        for (int j = 0; j < 8; ++j) { const float tj = TOT[j * 64 + k]; if (j < sg) off += tj; blast += tj; }
        { float kd4[4];
#pragma unroll
            for (int e = 0; e < 4; ++e) { const int s = 4 * sg + e; const float bsv = off + cs[e];
                Qp[s * 72 + k] = f2bf(q[e] * __expf(bsv)); Kn[s * 72 + k] = f2bf(kv[e] * __expf(-bsv)); kd4[e] = kv[e] * __expf(blast - bsv); }
            *(u32x2*)(Kdt + k * 40 + 4 * sg) = pack4(kd4); *(u32x2*)(Vt + k * 40 + 4 * sg) = pack4(vv); }
        if (sg == 0) { EB[k] = __expf(blast); dsum += blast; }
        __syncthreads();
        { const f32x4 eb = *(const f32x4*)(EB + kt * 16 + fq * 4); const bf16x8 af = *(const bf16x8*)(Kdt + (kt * 16 + fr) * 40 + fq * 8);
#pragma unroll
            for (int i = 0; i < 2; ++i) { accS[i] = accS[i] * eb; accS[i] = MFMA16(af, *(const bf16x8*)(Vt + ((vt0 + i) * 16 + fr) * 40 + fq * 8), accS[i]); } }
        if (mode != 0) {
            if (wave < 4) { const int tt = wave >> 1, st = wave & 1; f32x4 a = (f32x4){0.f, 0.f, 0.f, 0.f};
                if (st <= tt) {
#pragma unroll
                    for (int ks = 0; ks < 2; ++ks) a = MFMA16(*(const bf16x8*)(Kn + (st * 16 + fr) * 72 + ks * 32 + fq * 8), *(const bf16x8*)(Qp + (tt * 16 + fr) * 72 + ks * 32 + fq * 8), a);
                    float m4[4];
#pragma unroll
                    for (int j = 0; j < 4; ++j) m4[j] = (st * 16 + fq * 4 + j <= tt * 16 + fr) ? a[j] : 0.f;
                    *(u32x2*)(Att + (tt * 16 + fr) * 40 + st * 16 + fq * 4) = pack4(m4);
                } else { *(u32x2*)(Att + (tt * 16 + fr) * 40 + st * 16 + fq * 4) = (u32x2){0u, 0u}; } }
            __syncthreads();
            if (wave < 2) { const int tt = wave; f32x4 o[4]; float ss = 0.f;
                const bf16x8 attf = *(const bf16x8*)(Att + (tt * 16 + fr) * 40 + fq * 8), q0 = *(const bf16x8*)(Qp + (tt * 16 + fr) * 72 + fq * 8), q1 = *(const bf16x8*)(Qp + (tt * 16 + fr) * 72 + 32 + fq * 8);
#pragma unroll
                for (int vt = 0; vt < 4; ++vt) { f32x4 a = MFMA16(*(const bf16x8*)(Vt + (vt * 16 + fr) * 40 + fq * 8), attf, ((f32x4){0.f, 0.f, 0.f, 0.f}));
                    a = MFMA16(*(const bf16x8*)(St + (vt * 16 + fr) * 72 + fq * 8), q0, a); a = MFMA16(*(const bf16x8*)(St + (vt * 16 + fr) * 72 + 32 + fq * 8), q1, a);
                    o[vt] = a; ss += a.x * a.x + a.y * a.y + a.z * a.z + a.w * a.w; }
                ss += shx(ss, lane, 16); ss += shx(ss, lane, 32);
                const float rn = rsqrtf(ss * (1.f / 64.f) + 1e-5f); const int t = tt * 16 + fr;
                if (t < L) { const int r = r0 + t;
#pragma unroll
                    for (int vt = 0; vt < 4; ++vt) { const int ci = hd * 64 + vt * 16 + fq * 4; const f32x4 ng = ngv[vt]; float pg[4], ov[4];
                        unpack4(pgv[vt], pg);
#pragma unroll
                        for (int j = 0; j < 4; ++j) ov[j] = o[vt][j] * rn * ng[j] * (pg[j] * sigm(pg[j]));
                        *(u32x2*)(MIXED + (size_t)r * 1024 + 256 + ci) = pack4(ov); } } }
            __syncthreads();
#pragma unroll
            for (int i = 0; i < 2; ++i) { float t4[4] = {accS[i][0], accS[i][1], accS[i][2], accS[i][3]}; *(u32x2*)(St + ((vt0 + i) * 16 + fr) * 72 + kt * 16 + fq * 4) = pack4(t4); }
        }
    }
    float* dst = nullptr;
    if (mode == 0) { const size_t bi = (size_t)((b * 4 + hd) * 16 + sc); dst = HST + bi * 4096; if (sg == 0) HD[bi * 64 + k] = __expf(dsum); }
    else if (mode == 1) { if (sc == 15) dst = P.out() + O_PHG + ((size_t)(l * 8 + b) * 4 + hd) * 4096; }
    else dst = P.out() + O_SHG + ((size_t)(l * 128 + b) * 4 + hd) * 4096;
    if (dst) {
#pragma unroll
        for (int jj = 0; jj < 4; ++jj)
#pragma unroll
            for (int i = 0; i < 2; ++i) dst[(kt * 16 + fq * 4 + jj) * 64 + (vt0 + i) * 16 + fr] = accS[i][jj]; }
    __syncthreads();
}

template <int CTRL> __device__ __forceinline__ float dpp_add(float x) { return x + __int_as_float(__builtin_amdgcn_update_dpp(0, __float_as_int(x), CTRL, 0xF, 0xF, false)); }
__device__ __forceinline__ float row16_sum(float x) { x = dpp_add<0xB1>(x); x = dpp_add<0x4E>(x); x = dpp_add<0x141>(x); x = dpp_add<0x140>(x); return x; }
#ifndef SCAN_EVEN
#define SCAN_EVEN 0
#endif
#if SCAN_EVEN
#define SCAN_LOADER(w) (((w) & 1) != 0)
#define SCAN_IDX(w) ((w) >> 1)
#else
#define SCAN_LOADER(w) ((w) >= 4)
#define SCAN_IDX(w) ((w) & 3)
#endif
__device__ __forceinline__ void rwkv_scan_task(const KP& P, int l, unsigned char* smem, bool prompt, int b, int hd, int rq) {
    const int tid = otid(), lane = tid & 63, wave = tid >> 6;
    const int T = prompt ? 2048 : 4, row0 = prompt ? b * 2048 : MP + b * 4;
    const float* RW = (const float*)(P.ws() + OFF_RW);
    const float* C12 = (const float*)(P.ws() + OFF_C12);
    unsigned char* Yb = P.ws() + OFF_PROJ + 2560;
    constexpr int BUFF = 32 * 340;
    float* buf = (float*)smem;
    const bool loader = SCAN_LOADER(wave);
    const int sw = SCAN_IDX(wave), ltid = sw * 64 + lane;
    const int rr = lane >> 4, i4 = (lane & 15) * 4, srow = rq * 16 + sw * 4 + rr;
    f32x4 S = (f32x4){0.f, 0.f, 0.f, 0.f};
    if (!loader && !prompt) S = *(const f32x4*)(P.in(5) + (((size_t)(l * 128 + b) * 4 + hd) * 64 + srow) * 64 + i4);
    const int nchunks = (T + 31) >> 5;
    __syncthreads();
#pragma unroll 1
    for (int c = -1; c < nchunks; ++c) {
        if (loader) {
            if (c + 1 < nchunks) { const int t0 = (c + 1) * 32, n = min(32, T - t0); float* bw = buf + ((c + 1) & 1) * BUFF;
                f32x4 x[5][2]; float vx[2]; float cx = 0.f;
#pragma unroll
                for (int i = 0; i < 2; ++i) { const int idx = ltid + 256 * i, stp = idx >> 4, q = idx & 15; const size_t o = (size_t)(row0 + t0 + stp) * 256 + hd * 64 + q * 4;
#pragma unroll
                    for (int vct = 0; vct < 5; ++vct) x[vct][i] = (stp < n) ? *(const f32x4*)(RW + vct * RWSZ + o) : (f32x4){0.f, 0.f, 0.f, 0.f};
                    vx[i] = (stp < n) ? RW[5 * RWSZ + (size_t)(row0 + t0 + stp) * 256 + hd * 64 + rq * 16 + q] : 0.f; }
                if (ltid < 64) { const int stp = ltid >> 1; if (stp < n) cx = C12[(size_t)(row0 + t0 + stp) * 16 + hd * 4 + (ltid & 1)]; }
#pragma unroll
                for (int i = 0; i < 2; ++i) { const int idx = ltid + 256 * i, stp = idx >> 4, q = idx & 15;
#pragma unroll
                    for (int vct = 0; vct < 5; ++vct) *(f32x4*)(bw + vct * 2048 + stp * 64 + q * 4) = x[vct][i];
                    bw[10240 + stp * 16 + q] = vx[i]; }
                if (ltid < 64) bw[10752 + (ltid >> 1) * 4 + (ltid & 1)] = cx;
            }
        } else if (c >= 0) {
            __builtin_amdgcn_s_setprio(3);
            const int t0 = c * 32; const float* br = buf + (c & 1) * BUFF;
#define SCAN_LD(s_, kk_, wr_, w_, kka_, kv_, v_, cc_) do { kk_ = *(const f32x4*)(br + (s_) * 64 + i4); wr_ = *(const f32x4*)(br + 2048 + (s_) * 64 + i4); w_ = *(const f32x4*)(br + 4096 + (s_) * 64 + i4); \
                kka_ = *(const f32x4*)(br + 6144 + (s_) * 64 + i4); kv_ = *(const f32x4*)(br + 8192 + (s_) * 64 + i4); v_ = br[10240 + (s_) * 16 + sw * 4 + rr]; cc_ = *(const f32x2v*)(br + 10752 + (s_) * 4); } while (0)
            f32x4 kk, wr, w, kka, kv; float v; f32x2v cc;
            f32x4 kk1, wr1, w1, kka1, kv1; float v1; f32x2v cc1;
            SCAN_LD(0, kk, wr, w, kka, kv, v, cc); SCAN_LD(1, kk1, wr1, w1, kka1, kv1, v1, cc1);
#pragma unroll 1
            for (int sb = 0; sb < 32; sb += 16) {
                float ysel = 0.f;
#pragma unroll
                for (int s2 = 0; s2 < 16; ++s2) { const int s = sb + s2;
                    f32x4 kk2, wr2, w2, kka2, kv2; float v2; f32x2v cc2;
                    SCAN_LD(s + 2, kk2, wr2, w2, kka2, kv2, v2, cc2);
                    asm volatile("" ::: "memory");
                    const f32x2v S01 = (f32x2v){S.x, S.y}, S23 = (f32x2v){S.z, S.w};
                    f32x2v d1 = S01 * (f32x2v){kk.x, kk.y}; d1 = __builtin_elementwise_fma(S23, (f32x2v){kk.z, kk.w}, d1);
                    f32x2v d2 = S01 * (f32x2v){wr.x, wr.y}; d2 = __builtin_elementwise_fma(S23, (f32x2v){wr.z, wr.w}, d2);
                    float p1 = d1.x + d1.y, p2 = d2.x + d2.y;
                    p1 = row16_sum(p1); p2 = row16_sum(p2);
                    const float sa = -p1, y = p2 + sa * cc.x + v * cc.y;
                    S = S * w + sa * kka + v * kv;
                    ysel = ((lane & 15) == s2) ? y : ysel;
                    kk = kk1; wr = wr1; w = w1; kka = kka1; kv = kv1; v = v1; cc = cc1;
                    kk1 = kk2; wr1 = wr2; w1 = w2; kka1 = kka2; kv1 = kv2; v1 = v2; cc1 = cc2; }
                ((float*)(Yb + (size_t)(row0 + t0 + sb + (lane & 15)) * 5120))[hd * 64 + srow] = ysel;
            }
#undef SCAN_LD
            __builtin_amdgcn_s_setprio(0);
        }
        __syncthreads();
    }
    if (!loader) { float* dst = P.out() + (prompt ? O_PWKV + (((size_t)(l * 8 + b) * 4 + hd) * 64 + srow) * 64 : O_SWKV + (((size_t)(l * 128 + b) * 4 + hd) * 64 + srow) * 64) + i4; *(f32x4*)dst = S; }
}

__device__ __forceinline__ void rwkv_sample_wave(const KP& P, int l, unsigned char* smem, int b, int hd, int half) {
    const int tid = otid(), lane = tid & 63, wave = tid >> 6;
    const float* RW = (const float*)(P.ws() + OFF_RW); const float* C12 = (const float*)(P.ws() + OFF_C12); unsigned char* Yb = P.ws() + OFF_PROJ + 2560;
    float* wl = (float*)smem + wave * 1600;
    const int srow = half * 32 + (lane >> 1), kh = (lane & 1) * 32;
    float S[32];
    { const float* sp = P.in(5) + (((size_t)(l * 128 + b) * 4 + hd) * 64 + srow) * 64 + kh;
#pragma unroll
        for (int q = 0; q < 8; ++q) { const f32x4 x = *(const f32x4*)(sp + 4 * q); S[4 * q] = x.x; S[4 * q + 1] = x.y; S[4 * q + 2] = x.z; S[4 * q + 3] = x.w; } }
#pragma unroll
    for (int st = 0; st < 4; ++st) { const size_t r = (size_t)(MP + b * 4 + st);
#pragma unroll
        for (int vct = 0; vct < 6; ++vct) wl[st * 400 + vct * 64 + lane] = RW[vct * RWSZ + r * 256 + hd * 64 + lane];
        if (lane < 2) wl[st * 400 + 384 + lane] = C12[r * 16 + hd * 4 + lane]; }
    LDSWAIT();
#pragma unroll 1
    for (int st = 0; st < 4; ++st) { const float* w5 = wl + st * 400; float p1 = 0.f, p2 = 0.f;
#pragma unroll
        for (int q = 0; q < 8; ++q) { const f32x4 kk = *(const f32x4*)(w5 + kh + 4 * q), wr = *(const f32x4*)(w5 + 64 + kh + 4 * q);
#pragma unroll
            for (int j = 0; j < 4; ++j) { p1 += S[4 * q + j] * kk[j]; p2 += S[4 * q + j] * wr[j]; } }
        p1 = dpp_add<0xB1>(p1); p2 = dpp_add<0xB1>(p2);
        const float sa = -p1, v = w5[320 + srow], c1 = w5[384], c2 = w5[385];
        if ((lane & 1) == 0) ((float*)(Yb + (size_t)(MP + b * 4 + st) * 5120))[hd * 64 + srow] = p2 + sa * c1 + v * c2;
#pragma unroll
        for (int q = 0; q < 8; ++q) { const f32x4 w = *(const f32x4*)(w5 + 128 + kh + 4 * q), kka = *(const f32x4*)(w5 + 192 + kh + 4 * q), kv = *(const f32x4*)(w5 + 256 + kh + 4 * q);
#pragma unroll
            for (int j = 0; j < 4; ++j) S[4 * q + j] = S[4 * q + j] * w[j] + sa * kka[j] + v * kv[j]; } }
    { float* dp = P.out() + O_SWKV + (((size_t)(l * 128 + b) * 4 + hd) * 64 + srow) * 64 + kh;
#pragma unroll
        for (int q = 0; q < 8; ++q) *(f32x4*)(dp + 4 * q) = (f32x4){S[4 * q], S[4 * q + 1], S[4 * q + 2], S[4 * q + 3]}; }
    LDSWAIT();
}

#ifndef PROBE_VAL
#define PROBE_VAL tacc
#endif
#ifndef PROBE_CMASK
#define PROBE_CMASK 15
#endif
#ifndef PROBE_DMASK
#define PROBE_DMASK 31
#endif
__device__ __forceinline__ void phaseC(const KP& P0, int l, unsigned char* smem) {
    { const KP P = get_kp(); float* z1 = (float*)(P.ws() + OFF_RSQ1); float* z2 = (float*)(P.ws() + OFF_RSQ2);
      for (int i = blockIdx.x * 512 + otid(); i < MP; i += gridDim.x * 512) { z1[i] = 0.f; z2[i] = 0.f; } }
    const int tid = otid();
    unsigned* ctr = (unsigned*)(P0.ws() + OFF_CTR) + 2 + l;
    volatile int* s_task = (volatile int*)(smem + LDS_TASK_OFF);
    for (;;) {
        __syncthreads();
        if (tid == 0) *s_task = (int)atomicAdd(ctr, 1u);
        __syncthreads();
        const int t = *s_task;
        if (t >= 1312) break;
        const KP P = get_kp();
#ifdef PROBE_SEL
        const unsigned long long c0_ = __builtin_amdgcn_s_memrealtime();
#endif
        const int pt = (t < 560 && !(t & 1)) ? (t >> 1) : -1, lt = (t < 560) ? ((t & 1) ? (t >> 1) : -1) : t - 280;
        if (pt >= 0) { if (pt < 248) rwkv_prep_tile<2>(P, l, smem, pt); else rwkv_prep_tile<1>(P, l, smem, 496 + (pt - 248)); }
        else if (lt < 256) s5_task(P, l, smem, 0, lt);
        else if (lt < 520) pool_tile(P, l, smem, lt - 256);
        else { const int u = lt - 520; hgrn_task(P, l, smem, 0, u >> 6, (u >> 4) & 3, u & 15); }
#ifdef PROBE_SEL
        if (l == 0 && tid == 0) { float* sl = (float*)(P.ws() + OFF_CTR) + 52 + (t < 280 ? 0 : (t < 536 ? 1 : (t < 800 ? 2 : 3))); *sl = (float)(__builtin_amdgcn_s_memrealtime() - c0_) * 0.01f; }
#endif
    }
}
__device__ __forceinline__ void phaseD(const KP& P0, int l, unsigned char* smem) {
    const int tid = otid();
#ifdef PROBE_SEL
    float ptt[5] = {0.f, 0.f, 0.f, 0.f, 0.f}, ptn[5] = {0.f, 0.f, 0.f, 0.f, 0.f}; unsigned long long pt0 = __builtin_amdgcn_s_memrealtime();
#endif
    if ((PROBE_DMASK & 1) && blockIdx.x < 128) rwkv_scan_task(P0, l, smem, true, blockIdx.x >> 4, (blockIdx.x >> 2) & 3, blockIdx.x & 3);
#ifdef PROBE_SEL
    ptt[0] = (float)(__builtin_amdgcn_s_memrealtime() - pt0) * 0.01f; ptn[0] = 1.f;
#endif
    unsigned* ctr = (unsigned*)(P0.ws() + OFF_CTR) + l;
    volatile int* s_task = (volatile int*)(smem + LDS_TASK_OFF);
    for (;;) {
        __syncthreads();
        if (tid == 0) *s_task = (int)atomicAdd(ctr, 1u);
        __syncthreads();
        const int t = *s_task;
        if (t >= 1416 + 576 + (l == 0 ? 160 : 0)) break;
        const KP P = get_kp();
#ifdef PROBE_SEL
        pt0 = __builtin_amdgcn_s_memrealtime();
#endif
        if (t < 512) { if (PROBE_DMASK & 2) hgrn_task(P, l, smem, 1, t >> 6, (t >> 4) & 3, t & 15); }
        else if (t < 776) { if (PROBE_DMASK & 4) s5_task(P, l, smem, 1, t - 512); }
        else if (t < 1288) { const int u = t - 776; if (PROBE_DMASK & 8) hgrn_task(P, l, smem, 2, u >> 2, u & 3, 0); }
        else if (t < 1416) { const int u = (t - 1288) * 8 + (tid >> 6); rwkv_sample_wave(P, l, smem, u >> 3, (u >> 1) & 3, u & 1); }
        else { const int it = (t - 1416) * 8 + (tid >> 6), lane = tid & 63; float* scr = (float*)smem + (tid >> 6) * (64 * 33);
            if (it < 512) transpose_item(P.in(35) + (size_t)l * 1024 * 1024, 1024, 1024, (bf16_t*)(P.ws() + OFF_WOUTT), scr, it, lane, nullptr);
            else if (it < 2560) transpose_item(P.in(37) + (size_t)l * 1024 * 4096, 1024, 4096, (bf16_t*)(P.ws() + OFF_UPT), scr, it - 512, lane, P.in(36) + l * 1024);
            else if (it < 4608) transpose_item(P.in(38) + (size_t)l * 4096 * 1024, 4096, 1024, (bf16_t*)(P.ws() + OFF_DOWNT), scr, it - 2560, lane, nullptr);
            else transpose_item(P.in(9) + (size_t)(l + 1) * 1024 * 2560, 1024, 2560, (bf16_t*)(P.ws() + OFF_WINT), scr, it - 4608, lane, P.in(8) + (l + 1) * 1024); }
#ifdef PROBE_SEL
        { const int ty = t < 512 ? 1 : (t < 776 ? 2 : (t < 1288 ? 3 : 4)); const float d = (float)(__builtin_amdgcn_s_memrealtime() - pt0) * 0.01f;
#pragma unroll
          for (int c = 1; c < 5; ++c) if (c == ty) { ptt[c] += d; ptn[c] += 1.f; } }
#endif
    }
#ifdef PROBE_SEL
    if (l == 0 && tid == 0 && (blockIdx.x == 0 || blockIdx.x == 200)) { float* sl = (float*)(P0.ws() + OFF_CTR) + (blockIdx.x == 0 ? 16 : 32);
#pragma unroll
        for (int c = 0; c < 5; ++c) { sl[c] = ptt[c]; sl[8 + c] = ptn[c]; } }
#endif
}
__device__ __forceinline__ void phaseE(const KP& P, int l) {
    const int tid = otid(), lane = tid & 63, wave = tid >> 6, gw = blockIdx.x * 8 + wave, NGW = gridDim.x * 8;
    const unsigned char* Yb = P.ws() + OFF_PROJ + 2560; const float* Vb = (const float*)(P.ws() + OFF_RW) + 5 * RWSZ; const float* C12 = (const float*)(P.ws() + OFF_C12);
    bf16_t* MIXED = (bf16_t*)(P.ws() + OFF_MIXED);
    const int c0 = lane * 4, hd = lane >> 4;
    const f32x4 lg = *(const f32x4*)(P.in(31) + l * 256 + c0), lbb = *(const f32x4*)(P.in(32) + l * 256 + c0);
#pragma unroll 1
    for (int rb = gw; rb < MT; rb += 8 * NGW) {
        f32x4 yv[8], vv[8]; u32x2 gv[8]; float bsv[8];
#pragma unroll
        for (int q = 0; q < 8; ++q) { const int r = min(rb + q * NGW, MT - 1);
            yv[q] = *(const f32x4*)((const float*)(Yb + (size_t)r * 5120) + c0); vv[q] = *(const f32x4*)(Vb + (size_t)r * 256 + c0);
            gv[q] = *(const u32x2*)(MIXED + (size_t)r * 1024 + 512 + c0); bsv[q] = C12[(size_t)r * 16 + hd * 4 + 2]; }
#pragma unroll
        for (int q = 0; q < 8; ++q) { const int r = rb + q * NGW; const f32x4 y = yv[q], v = vv[q];
            float s = y.x + y.y + y.z + y.w; s += shx(s, lane, 1); s += shx(s, lane, 2); s += shx(s, lane, 4); s += shx(s, lane, 8);
            const float mean = s * (1.f / 64.f); const f32x4 d = y - mean;
            float qq = d.x * d.x + d.y * d.y + d.z * d.z + d.w * d.w; qq += shx(qq, lane, 1); qq += shx(qq, lane, 2); qq += shx(qq, lane, 4); qq += shx(qq, lane, 8);
            const float rs = rsqrtf(qq * (1.f / 64.f) + 64e-5f); const float bs = bsv[q];
            float g[4], o[4]; unpack4(gv[q], g);
#pragma unroll
            for (int j = 0; j < 4; ++j) o[j] = (d[j] * rs * lg[j] + lbb[j] + bs * v[j]) * g[j];
            if (r < MT) *(u32x2*)(MIXED + (size_t)r * 1024 + 512 + c0) = pack4(o); }
    }
}

template <class Epi> __device__ __forceinline__ void run_gemm(unsigned char* smem, const bf16_t* A, const bf16_t* Bt, int M, int N, int K, const Epi& E) {
    pg8::Gemm g; g.A = A; g.Bt = Bt; g.M = M; g.N = N; g.K = K; g.ld = K;
    pg8::StaticOrder S; S.init(M, N, (int)gridDim.x, (int)blockIdx.x);
    __syncthreads();
    pg8::gemm_phase<Epi, pg8::StaticOrder, false>((PG8_LAS unsigned char*)smem, g, S, E, nullptr);
    __syncthreads();
}
struct ResidOrder {
    pg8::StaticOrder main; int S, kbytes, ntail, G, c;
    __device__ bool next(int i, pg8::Unit& u) const {
        if (main.next(i, u)) return true;
        const int L = i * G + c - main.nwg; if (L < 0 || L >= 8 * S) return false;
        const int t = L / S, ks = L - t * S; u.pm = 64 + (t >> 2); u.pn = t & 3; u.kb = ks * kbytes; u.nt = ntail; return true; }
    __device__ __forceinline__ void a_ready(const pg8::Unit&) const {}
    __device__ __forceinline__ void done(const pg8::Unit&) const {}
};
__device__ __forceinline__ void run_gemm_resid(unsigned char* smem, const bf16_t* A, const bf16_t* Bt, int K, int split, pg8::EpiResid& E) {
    pg8::Gemm g; g.A = A; g.Bt = Bt; g.M = MP; g.N = 1024; g.K = K; g.ld = K;
    ResidOrder S; S.main.init(MP, 1024, (int)gridDim.x, (int)blockIdx.x); S.S = split; S.kbytes = (K / split) * 2; S.ntail = (K / split) / 64; S.G = (int)gridDim.x; S.c = (int)blockIdx.x;
    E.kbytes = S.kbytes;
    __syncthreads();
    pg8::gemm_phase<pg8::EpiResid, ResidOrder, false>((PG8_LAS unsigned char*)smem, g, S, E, nullptr);
    __syncthreads();
}

#ifdef PROBE_SEL
#define PH_END(ID) do { grid.sync(); { const unsigned long long tn_ = __builtin_amdgcn_s_memrealtime(); const float d_ = (float)(tn_ - tprev) * 0.01f; tprev = tn_; const int ID_ = (ID); const int L_ = ID_ / 9, SUB_ = ID_ % 9; (void)L_; (void)SUB_; if (PROBE_SEL) tacc += d_; } } while (0)
#else
#define PH_END(ID) grid.sync()
#endif
__global__ void __launch_bounds__(512, 2) mega(Params Pk) {
    extern __shared__ __attribute__((aligned(16))) unsigned char smem[];
    cg::grid_group grid = cg::this_grid();
    unsigned long long tprev = 0ull; float tacc = 0.f;
#ifdef PROBE_SEL
    tprev = __builtin_amdgcn_s_memrealtime();
#endif
#pragma unroll 1
    for (int ph = 0; ph < 18; ++ph) {
        int L = ph / 9; const int sub = ph - L * 9; L = __builtin_amdgcn_readfirstlane(L);
        if (sub == 0) phaseA(get_kp(), L, smem);
        else if (sub == 1 || sub == 7) { const KP P = get_kp(); pg8::EpiBf E; E.ACT = sub == 7; E.O = (bf16_t*)(P.ws() + (sub == 1 ? OFF_PROJ : OFF_HIDDEN)); E.ldc = sub == 1 ? 2560 : 4096; E.rsq = (const float*)(P.ws() + (sub == 1 ? OFF_RSQ1 : OFF_RSQ2));
            run_gemm(smem, (const bf16_t*)(P.ws() + (sub == 1 ? OFF_HB1 : OFF_XN2)), (const bf16_t*)(P.ws() + (sub == 1 ? OFF_WINT : OFF_UPT)), MT, sub == 1 ? 2560 : 4096, 1024, E); }
        else if (sub == 2) phaseC(get_kp(), L, smem);
        else if (sub == 3) phaseD(get_kp(), L, smem);
        else if (sub == 4) phaseE(get_kp(), L);
        else if (sub == 5 || sub == 8) { const KP P = get_kp(); pg8::EpiResid E; E.H = P.out(); E.Hin = (L == 0 && sub == 5) ? P.in(0) : P.out(); E.ldc = 1024; E.HB = (bf16_t*)(P.ws() + (sub == 5 ? OFF_XN2 : OFF_HB1)); E.rsq = (float*)(P.ws() + (sub == 5 ? OFF_RSQ2 : OFF_RSQ1));
            const bf16_t* A = (const bf16_t*)(P.ws() + (sub == 5 ? OFF_MIXED : OFF_HIDDEN)); const bf16_t* Bt = (const bf16_t*)(P.ws() + (sub == 5 ? OFF_WOUTT : OFF_DOWNT)); const int K = sub == 5 ? 1024 : 4096;
            E.PART = (float*)(P.ws() + OFF_PART); run_gemm_resid(smem, A, Bt, K, sub == 5 ? 4 : 8, E); }
        else phaseG(get_kp(), L, smem);
        PH_END(ph);
    }
#ifdef PROBE_SEL
    if (threadIdx.x == 0) { const KP P = get_kp(); ((int*)(P.ws() + WS_END))[blockIdx.x] = (int)((unsigned)__builtin_amdgcn_s_getreg((3 << 11) | 20) & 0xFu); }
#endif
    norm_rows(get_kp(), 0, 2);
#ifdef PROBE_SEL
    PH_END(18);
    float xmis = 0.f; { const KP P = get_kp(); const int* xt = (const int*)(P.ws() + WS_END); for (int i = 0; i < 256; ++i) xmis += (xt[i] != xt[i & 7]) ? 1.f : 0.f; } (void)xmis;
    if (blockIdx.x == 0) { const KP P = get_kp(); const float* sl = (const float*)(P.ws() + OFF_CTR); (void)sl; const float sc = 1.f + sqrtf((PROBE_VAL) * 1e-5f); for (int i = threadIdx.x; i < 16384; i += 512) P.out()[O_PSRE + i] *= sc; }
#endif
}

extern "C" void kernel_launch(void* const* d_in, const int* in_sizes, int n_in, void* d_out, int out_size, void* d_ws, size_t ws_size, hipStream_t stream) {
    static int grid = 0;
    if (grid == 0) {
        if (n_in != 40 || ws_size < WS_END) { fprintf(stderr, "kernel_launch: unexpected n_in %d / ws %zu\n", n_in, ws_size); grid = -1; return; }
        int dev = 0, cus = 0, per_cu = 0;
        hipGetDevice(&dev); hipDeviceGetAttribute(&cus, hipDeviceAttributeMultiprocessorCount, dev);
        if (hipFuncSetAttribute((const void*)mega, hipFuncAttributeMaxDynamicSharedMemorySize, LDS_BYTES) != hipSuccess) { fprintf(stderr, "kernel_launch: hipFuncSetAttribute failed\n"); grid = -1; return; }
        if (hipOccupancyMaxActiveBlocksPerMultiprocessor(&per_cu, (const void*)mega, 512, LDS_BYTES) != hipSuccess || per_cu < 1) { fprintf(stderr, "kernel_launch: occupancy query says %d\n", per_cu); per_cu = 1; }
        (void)hipGetLastError();
        grid = cus;
    }
    if (grid < 0) return;
    Params p{};
    for (int i = 0; i < 40; ++i) p.in[i] = (const float*)d_in[i];
    p.out = (float*)d_out; p.ws = (unsigned char*)d_ws;
    void* args[] = {&p};
    hipError_t e = hipLaunchCooperativeKernel((const void*)mega, dim3(grid), dim3(512), args, LDS_BYTES, stream);
    if (e != hipSuccess) fprintf(stderr, "cooperative launch failed: %s (grid %d)\n", hipGetErrorString(e), grid);
}
```

```cpp
#include <hip/hip_runtime.h>
#include <hip/hip_cooperative_groups.h>
#include <cstdio>
#include <cstdint>
namespace cg = cooperative_groups;
__device__ __forceinline__ int otid() { int t = threadIdx.x; asm volatile("" : "+v"(t)); return t; }
namespace pg8 {
#define PG8_LAS __attribute__((address_space(3)))
typedef unsigned short bf16_t;
typedef short bf16x8 __attribute__((ext_vector_type(8)));
typedef float f32x4 __attribute__((ext_vector_type(4)));
typedef unsigned u32x4 __attribute__((ext_vector_type(4)));
constexpr int BM = 256, BK = 64, HALF = 128, HTB = HALF * BK * 2  , STAGE_BYTES = 8 * HTB, NXCD = 8, WGM = 8;

__host__ __device__ __forceinline__ int lds_byte(int r, int c) { const int st = (r >> 4) * 2 + (c >> 5), rr = r & 15, cc = c & 31, ob = rr * 64 + cc * 2; return st * 1024 + (ob ^ (((ob >> 9) & 1) << 5)); }
__host__ __device__ __forceinline__ void stage_rc(int b, int& R, int& C) { const int st = b / 1024, sb = b % 1024, swz = sb ^ (((sb >> 9) & 1) << 5); R = (st >> 1) * 16 + swz / 64; C = (st & 1) * 32 + (swz % 64) / 2; }
__host__ __device__ __forceinline__ int perm32(int rho) { const int n = rho >> 4, i = rho & 15; return 8 * (i >> 2) + 4 * n + (i & 3); }

struct Unit { int pm, pn, kb, nt; };
struct Gemm { const bf16_t* A; const bf16_t* Bt; int M, N, K, ld; };

struct StaticOrder {
    int nM, nN, nwg, G, c;
    __host__ __device__ void init(int M, int N, int G_, int c_) { nM = M / BM; nN = N / BM; nwg = nM * nN; G = G_; c = c_; }
    __host__ __device__ bool next(int i, Unit& u) const {
        const long L = (long)i * G + c; if (L >= nwg) return false;
        int wgid = (int)L; { const int q = nwg / NXCD, r = nwg % NXCD, xcd = wgid % NXCD, off = wgid / NXCD; wgid = (xcd < r ? xcd * (q + 1) : r * (q + 1) + (xcd - r) * q) + off; }
        const int nig = WGM * nN, gid = wgid / nig, fm = gid * WGM, gsz = (nM - fm) < WGM ? (nM - fm) : WGM;
        u.pm = fm + ((wgid % nig) % gsz); u.pn = (wgid % nig) / gsz; u.kb = 0; u.nt = 0; return true;
    }
    __device__ __forceinline__ void a_ready(const Unit&) const {}
    __device__ __forceinline__ void done(const Unit&) const {}
};
__device__ __forceinline__ unsigned cvt_pk_bf16(float lo, float hi) { unsigned r; asm volatile("v_cvt_pk_bf16_f32 %0, %1, %2" : "=v"(r) : "v"(lo), "v"(hi)); return r; }
struct EpiBf {
    static constexpr bool PERM = true, AFTER_DRAIN = false;
    bf16_t* O; int ldc; int ACT; const float* rsq;
    __device__ __forceinline__ void init(f32x4 (&acc)[2][2][4][2], const Unit&, int, int, int, int) const {
#pragma unroll
        for (int a = 0; a < 2; ++a)
#pragma unroll
            for (int b = 0; b < 2; ++b)
#pragma unroll
                for (int m = 0; m < 4; ++m)
#pragma unroll
                    for (int n = 0; n < 2; ++n) acc[a][b][m][n] = (f32x4){0.f, 0.f, 0.f, 0.f}; }
    __device__ __forceinline__ void operator()(const f32x4 (&acc)[2][2][4][2], const Unit& u, int wr, int wc, int fr, int fq) const {
        const int row0 = u.pm * BM + wr * 64 + fr; const int col0 = u.pn * BM + wc * 32 + 8 * fq;
#pragma unroll
        for (int ai = 0; ai < 2; ++ai)
#pragma unroll
            for (int m = 0; m < 4; ++m) { bf16_t* rowp = O + (size_t)(row0 + ai * HALF + m * 16) * ldc + col0; const float rstd = rsqrtf(rsq[row0 + ai * HALF + m * 16] * (1.f / 1024.f) + 1e-6f);
#pragma unroll
                for (int bj = 0; bj < 2; ++bj) { f32x4 v0 = acc[ai][bj][m][0] * rstd, v1 = acc[ai][bj][m][1] * rstd;
                    if (ACT) {
#pragma unroll
                        for (int j = 0; j < 4; ++j) { const float a = fmaxf(v0[j], 0.f), b = fmaxf(v1[j], 0.f); v0[j] = a * a; v1[j] = b * b; } }
                    u32x4 w; w.x = cvt_pk_bf16(v0[0], v0[1]); w.y = cvt_pk_bf16(v0[2], v0[3]); w.z = cvt_pk_bf16(v1[0], v1[1]); w.w = cvt_pk_bf16(v1[2], v1[3]);
                    *(u32x4*)(rowp + bj * HALF) = w; } }
    }
};
struct EpiResid {
    static constexpr bool PERM = false, AFTER_DRAIN = false;
    float* H; const float* Hin; int ldc; bf16_t* HB; float* rsq; float* PART; int kbytes;
    __device__ __forceinline__ void init(f32x4 (&acc)[2][2][4][2], const Unit& u, int wr, int wc, int fr, int fq) const {
        if (u.pm >= 64) {
#pragma unroll
        for (int a = 0; a < 2; ++a)
#pragma unroll
            for (int b = 0; b < 2; ++b)
#pragma unroll
                for (int m = 0; m < 4; ++m)
#pragma unroll
                    for (int n = 0; n < 2; ++n) acc[a][b][m][n] = (f32x4){0.f, 0.f, 0.f, 0.f};
            return; }
        const int row0 = u.pm * BM + wr * 64 + fr, col0 = u.pn * BM + wc * 32 + 4 * fq;
#pragma unroll
        for (int ai = 0; ai < 2; ++ai)
#pragma unroll
            for (int m = 0; m < 4; ++m) { const float* rowp = Hin + (size_t)(row0 + ai * HALF + m * 16) * ldc + col0;
#pragma unroll
                for (int bj = 0; bj < 2; ++bj)
#pragma unroll
                    for (int n = 0; n < 2; ++n) acc[ai][bj][m][n] = *(const f32x4*)(rowp + bj * HALF + n * 16); }
    }
    __device__ __forceinline__ void operator()(const f32x4 (&acc)[2][2][4][2], const Unit& u, int wr, int wc, int fr, int fq) const {
        if (u.pm >= 64) { const int ks = u.kb / kbytes, row0 = (u.pm - 64) * BM + wr * 64 + fr, col0 = u.pn * BM + wc * 32 + 4 * fq;
#pragma unroll
            for (int ai = 0; ai < 2; ++ai)
#pragma unroll
                for (int m = 0; m < 4; ++m) { float* rowp = PART + ((size_t)ks * 512 + row0 + ai * HALF + m * 16) * 1024 + col0;
#pragma unroll
                    for (int bj = 0; bj < 2; ++bj)
#pragma unroll
                        for (int n = 0; n < 2; ++n) *(f32x4*)(rowp + bj * HALF + n * 16) = acc[ai][bj][m][n]; }
            return; }
        const int row0 = u.pm * BM + wr * 64 + fr, col0 = u.pn * BM + wc * 32 + 4 * fq, lane = fq * 16 + fr;
#pragma unroll
        for (int ai = 0; ai < 2; ++ai)
#pragma unroll
            for (int m = 0; m < 4; ++m) { const int row = row0 + ai * HALF + m * 16; float* rowp = H + (size_t)row * ldc + col0; bf16_t* hbp = HB + (size_t)row * ldc + col0; float ss = 0.f;
#pragma unroll
                for (int bj = 0; bj < 2; ++bj)
#pragma unroll
                    for (int n = 0; n < 2; ++n) { const f32x4 v = acc[ai][bj][m][n]; *(f32x4*)(rowp + bj * HALF + n * 16) = v;
                        ss += v.x * v.x + v.y * v.y + v.z * v.z + v.w * v.w;
                        typedef unsigned u32x2_ __attribute__((ext_vector_type(2))); *(u32x2_*)(hbp + bj * HALF + n * 16) = (u32x2_){cvt_pk_bf16(v.x, v.y), cvt_pk_bf16(v.z, v.w)}; }
                ss += __int_as_float(__builtin_amdgcn_ds_bpermute((lane ^ 16) << 2, __float_as_int(ss))); ss += __int_as_float(__builtin_amdgcn_ds_bpermute((lane ^ 32) << 2, __float_as_int(ss)));
                if (fq == 0) unsafeAtomicAdd(rsq + row, ss); }
    }
};

template <class Epi, class Sched, bool STAMP = false>
__device__ __forceinline__ void gemm_phase(PG8_LAS unsigned char* lds, const Gemm g, const Sched& S, const Epi& E, unsigned long long* stamps) {
    const int tid = otid(), wid = __builtin_amdgcn_readfirstlane(tid >> 6), lane = tid & 63, wr = wid >> 2, wc = wid & 3, fr = lane & 15, fq = lane >> 4;
    const int K = g.ld, nt = g.K / BK;
    int ts_lo = 0, ts_hi = 0, nts = 0; const unsigned long long rt_entry = STAMP ? (unsigned long long)wall_clock64() : 0ull;
#define PG8_STAMP() do { if (STAMP && wid == 0 && nts < 64) { const unsigned long long _c = (unsigned long long)clock64(); \
        ts_lo = (lane == nts) ? (int)(unsigned)_c : ts_lo; ts_hi = (lane == nts) ? (int)(unsigned)(_c >> 32) : ts_hi; ++nts; } } while (0)
    PG8_STAMP();
    unsigned voffA[2], voffB[2];
#pragma unroll
    for (int i = 0; i < 2; ++i) { int R, C; stage_rc(tid * 16 + i * 8192, R, C); const int Rb = Epi::PERM ? ((R & ~31) + perm32(R & 31)) : R;
        voffA[i] = (unsigned)(R * K + C) * 2u; voffB[i] = (unsigned)(Rb * K + C) * 2u; }
    const size_t kstep = (size_t)(BK * 2);
    const size_t hstep = (size_t)HALF * K * 2;
    const size_t tstep = 2 * hstep;
    const unsigned ldsw = (unsigned)wid * 1024u;
    const int aoff = lds_byte(wr * 64 + fr, fq * 8), boff = lds_byte(wc * 32 + fr, fq * 8);
#define PG8_SA(b, h) (((b) * 2 + (h)) * HTB)
#define PG8_SB(b, h) ((4 + (b) * 2 + (h)) * HTB)
#define PG8_STAGE(bufoff, gbase, voff) do { _Pragma("unroll") for (int _i = 0; _i < 2; ++_i) \
        __builtin_amdgcn_global_load_lds((const unsigned*)((const char*)(gbase) + (voff)[_i]), (PG8_LAS unsigned*)(lds + (bufoff) + ldsw + _i * 8192), 16, 0, 0); } while (0)
#define PG8_LDA(dst, b, h) do { _Pragma("unroll") for (int m = 0; m < 4; ++m) _Pragma("unroll") for (int k = 0; k < 2; ++k) dst[m][k] = *(const PG8_LAS bf16x8*)(lds + PG8_SA(b, h) + aoff + m * 2048 + k * 1024); } while (0)
#define PG8_LDB(dst, b, h) do { _Pragma("unroll") for (int n = 0; n < 2; ++n) _Pragma("unroll") for (int k = 0; k < 2; ++k) dst[n][k] = *(const PG8_LAS bf16x8*)(lds + PG8_SB(b, h) + boff + n * 2048 + k * 1024); } while (0)
#define PG8_MMA(ai, bj, At, Bt) do { __builtin_amdgcn_s_setprio(1); _Pragma("unroll") for (int m = 0; m < 4; ++m) _Pragma("unroll") for (int n = 0; n < 2; ++n) _Pragma("unroll") for (int k = 0; k < 2; ++k) \
        acc[ai][bj][m][n] = __builtin_amdgcn_mfma_f32_16x16x32_bf16(Bt[n][k], At[m][k], acc[ai][bj][m][n], 0, 0, 0); __builtin_amdgcn_s_setprio(0); } while (0)
#define PG8_WAIT_V(n) asm volatile("s_waitcnt vmcnt(" #n ")" ::: "memory")
#define PG8_WAIT_L(n) asm volatile("s_waitcnt lgkmcnt(" #n ")" ::: "memory")
#define PG8_BAR __builtin_amdgcn_s_barrier()
#define PG8_SCHED __builtin_amdgcn_sched_barrier(0)
    Unit cur, nxt; int ui = 0;
    if (!S.next(0, cur)) return;
    f32x4 acc[2][2][4][2];
    bf16x8 At[4][2], B0[2][2], B1[2][2];
    const char* cA = (const char*)g.A + (size_t)cur.pm * tstep + cur.kb; const char* cB = (const char*)g.Bt + (size_t)cur.pn * tstep + cur.kb;
    S.a_ready(cur);
    E.init(acc, cur, wr, wc, fr, fq);
    PG8_STAGE(PG8_SB(0, 0), cB, voffB); PG8_STAGE(PG8_SA(0, 0), cA, voffA); PG8_STAGE(PG8_SB(0, 1), cB + hstep, voffB); PG8_STAGE(PG8_SA(0, 1), cA + hstep, voffA);
    if (wr == 1) PG8_BAR;
    PG8_WAIT_V(4); PG8_BAR;
    PG8_STAGE(PG8_SB(1, 0), cB + kstep, voffB); PG8_STAGE(PG8_SA(1, 0), cA + kstep, voffA); PG8_STAGE(PG8_SB(1, 1), cB + hstep + kstep, voffB);
    PG8_WAIT_V(6); PG8_BAR;
    PG8_STAMP();
    for (;;) {
        const bool has_next = S.next(ui + 1, nxt);
        const char* nA = has_next ? (const char*)g.A + (size_t)nxt.pm * tstep + nxt.kb : cA; const char* nB = has_next ? (const char*)g.Bt + (size_t)nxt.pn * tstep + nxt.kb : cB;
        const int unt = cur.nt > 0 ? cur.nt : nt;
        for (int t = 0; t < unt; t += 2) {
            const bool last = (t == unt - 2);
            const char* a1 = cA + (size_t)(t + 1) * kstep;
            const char* a2 = last ? nA : cA + (size_t)(t + 2) * kstep; const char* b2 = last ? nB : cB + (size_t)(t + 2) * kstep;
            const char* a3 = a2 + kstep; const char* b3 = b2 + kstep;
            if (last && has_next) S.a_ready(nxt);
            PG8_LDB(B0, 0, 0); PG8_SCHED; PG8_LDA(At, 0, 0); PG8_STAGE(PG8_SA(1, 1), a1 + hstep, voffA);
            PG8_WAIT_L(8); PG8_BAR; PG8_WAIT_L(0); PG8_MMA(0, 0, At, B0); PG8_BAR; PG8_SCHED;
            PG8_LDB(B1, 0, 1); PG8_STAGE(PG8_SB(0, 0), b2, voffB);
            PG8_BAR; PG8_WAIT_L(0); PG8_MMA(0, 1, At, B1); PG8_BAR;
            PG8_LDA(At, 0, 1); PG8_STAGE(PG8_SA(0, 0), a2, voffA);
            PG8_BAR; PG8_WAIT_L(0); PG8_MMA(1, 0, At, B0); PG8_BAR; PG8_SCHED;
            PG8_STAGE(PG8_SB(0, 1), b2 + hstep, voffB);
            PG8_WAIT_V(6); PG8_BAR; PG8_MMA(1, 1, At, B1); PG8_BAR;
            PG8_LDB(B0, 1, 0); PG8_SCHED; PG8_LDA(At, 1, 0); PG8_STAGE(PG8_SA(0, 1), a2 + hstep, voffA);
            PG8_WAIT_L(8); PG8_BAR; PG8_WAIT_L(0); PG8_MMA(0, 0, At, B0); PG8_BAR; PG8_SCHED;
            PG8_LDB(B1, 1, 1); PG8_STAGE(PG8_SB(1, 0), b3, voffB);
            PG8_BAR; PG8_WAIT_L(0); PG8_MMA(0, 1, At, B1); PG8_BAR;
            PG8_LDA(At, 1, 1); PG8_STAGE(PG8_SA(1, 0), a3, voffA);
            PG8_BAR; PG8_WAIT_L(0); PG8_MMA(1, 0, At, B0); PG8_BAR; PG8_SCHED;
            PG8_STAGE(PG8_SB(1, 1), b3 + hstep, voffB);
            PG8_WAIT_V(6); PG8_BAR; PG8_MMA(1, 1, At, B1); PG8_BAR;
        }
        PG8_STAMP();
        if constexpr (!Epi::AFTER_DRAIN) { E(acc, cur, wr, wc, fr, fq); S.done(cur); }
        PG8_STAMP();
        if (!has_next) break;
    E.init(acc, nxt, wr, wc, fr, fq);
        cur = nxt; cA = nA; cB = nB; ++ui;
    }
    PG8_WAIT_V(0);
    if (wr == 0) PG8_BAR;
    PG8_BAR;
    if constexpr (Epi::AFTER_DRAIN) { E.fused(acc, cur, wr, wc, fr, fq, lds, wid, lane); S.done(cur); }
    PG8_STAMP();
    if (STAMP && wid == 0) { stamps[lane] = lane < nts ? (((unsigned long long)(unsigned)ts_hi << 32) | (unsigned)ts_lo) : 0ull;
        if (lane == 62) stamps[62] = rt_entry; if (lane == 63) stamps[63] = (unsigned long long)wall_clock64(); }
#undef PG8_STAMP
#undef PG8_SA
#undef PG8_SB
#undef PG8_STAGE
#undef PG8_LDA
#undef PG8_LDB
#undef PG8_MMA
#undef PG8_WAIT_V
#undef PG8_WAIT_L
#undef PG8_BAR
#undef PG8_SCHED
}
}
using pg8::bf16_t; using pg8::bf16x8; using pg8::f32x4; using pg8::u32x4; using pg8::cvt_pk_bf16;
typedef unsigned u32x2 __attribute__((ext_vector_type(2)));
typedef float f32x2v __attribute__((ext_vector_type(2)));

constexpr int MT = 16896, MP = 16384;
constexpr size_t OFF_PROJ = 0;
constexpr size_t OFF_MIXED = 86507520;
constexpr size_t OFF_RW = 121110528;
constexpr size_t RWSZ = (size_t)MT * 256;
constexpr size_t OFF_Y = 224919552;
constexpr size_t OFF_UPT = OFF_Y, OFF_DOWNT = OFF_Y + 8388608;
constexpr size_t OFF_WINT = 242221056;
constexpr size_t OFF_WOUTT = 247463936;
constexpr size_t OFF_HST = 249561088;
constexpr size_t OFF_HD = 257949696;
constexpr size_t OFF_S5E = 258080768;
constexpr size_t OFF_C12 = 260177920;
constexpr size_t OFF_S5C = 261259264;
constexpr size_t OFF_CMT = OFF_S5C + 147456;
constexpr size_t OFF_GLUT = OFF_CMT + 65536;
constexpr size_t OFF_W2T = OFF_GLUT + 131072;
constexpr size_t OFF_A2T = OFF_W2T + 32768;
constexpr size_t OFF_G2T = OFF_A2T + 32768;
constexpr size_t OFF_PWT = OFF_G2T + 65536;
constexpr size_t OFF_LB = OFF_PWT + 32768;
constexpr size_t OFF_CTR = OFF_LB + 1024;
constexpr size_t OFF_HIDDEN = 0;
constexpr size_t OFF_XN2 = 138412032;
constexpr size_t OFF_BBT = OFF_CTR + 256;
constexpr size_t OFF_RSQ1 = OFF_BBT + 131072;
constexpr size_t OFF_RSQ2 = OFF_RSQ1 + 67584;
constexpr size_t OFF_HB1 = 173015040;
constexpr size_t CSTRIDE = 1048576;
constexpr size_t OFF_PART = 207618048;
constexpr size_t WS_END = OFF_RSQ2 + 67584;
constexpr size_t O_PSRE = 17301504, O_PSIM = O_PSRE + 16384, O_PHG = O_PSIM + 16384, O_PWKV = O_PHG + 262144, O_PSH = O_PWKV + 262144, O_PPOOL = O_PSH + 16384,
    O_SSRE = O_PPOOL + 61440, O_SSIM = O_SSRE + 262144, O_SHG = O_SSIM + 262144, O_SWKV = O_SHG + 4194304, O_SSH = O_SWKV + 4194304, O_SPOOL = O_SSH + 262144;
constexpr int LDS_BYTES = 147456;
constexpr int LDS_TASK_OFF = 146432;

struct Params { const float* in[40]; float* out; unsigned char* ws; };
#define AS4 __attribute__((address_space(4)))
struct KP { const AS4 char* k;
    __device__ __forceinline__ const float* in(int i) const { return *(const float* const AS4*)(k + 8 * i); }
    __device__ __forceinline__ float* out() const { return *(float* const AS4*)(k + 320); }
    __device__ __forceinline__ unsigned char* ws() const { return *(unsigned char* const AS4*)(k + 328); } };
__device__ __forceinline__ KP get_kp() { int z = 0; asm volatile("" : "+s"(z)); z = __builtin_amdgcn_readfirstlane(z); KP p; p.k = (const AS4 char*)__builtin_amdgcn_kernarg_segment_ptr() + z; return p; }

__device__ __forceinline__ float bf2f(bf16_t v) { return __uint_as_float(((unsigned)v) << 16); }
__device__ __forceinline__ float bflo(unsigned w) { return __uint_as_float(w << 16); }
__device__ __forceinline__ float bfhi(unsigned w) { return __uint_as_float(w & 0xffff0000u); }
__device__ __forceinline__ bf16_t f2bf(float f) { return (bf16_t)(cvt_pk_bf16(f, 0.f) & 0xffffu); }
__device__ __forceinline__ void unpack8(const u32x4 v, float* o) { o[0] = bflo(v.x); o[1] = bfhi(v.x); o[2] = bflo(v.y); o[3] = bfhi(v.y); o[4] = bflo(v.z); o[5] = bfhi(v.z); o[6] = bflo(v.w); o[7] = bfhi(v.w); }
__device__ __forceinline__ void unpack4(const u32x2 v, float* o) { o[0] = bflo(v.x); o[1] = bfhi(v.x); o[2] = bflo(v.y); o[3] = bfhi(v.y); }
__device__ __forceinline__ u32x2 pack4(const float* o) { u32x2 r; r.x = cvt_pk_bf16(o[0], o[1]); r.y = cvt_pk_bf16(o[2], o[3]); return r; }
__device__ __forceinline__ float sigm(float x) { return __builtin_amdgcn_rcpf(1.f + __expf(-x)); }
__device__ __forceinline__ float tanh_(float x) { return 1.f - 2.f * __builtin_amdgcn_rcpf(1.f + __expf(2.f * x)); }
__device__ __forceinline__ float gelu_t(float x) { return 0.5f * x * (1.f + tanh_(0.7978845608f * (x + 0.044715f * x * x * x))); }
__device__ __forceinline__ float shx(float v, int lane, int m) { return __int_as_float(__builtin_amdgcn_ds_bpermute((lane ^ m) << 2, __float_as_int(v))); }
__device__ __forceinline__ float wave_sum(float v, int lane) {
#pragma unroll
    for (int o = 1; o < 64; o <<= 1) v += shx(v, lane, o);
    return v; }
__device__ __forceinline__ void row_info(int r, int& b, int& t, bool& pr) { pr = r < MP; if (pr) { b = r >> 11; t = r & 2047; } else { b = (r - MP) >> 2; t = (r - MP) & 3; } }
#define MFMA16(a, b, c) __builtin_amdgcn_mfma_f32_16x16x32_bf16((a), (b), (c), 0, 0, 0)
#define LDSWAIT() asm volatile("s_waitcnt lgkmcnt(0)" ::: "memory")

__device__ __forceinline__ void transpose_item(const float* W, int K, int N, bf16_t* WT, float* scr, int item, int lane, const float* gk) {
    const int nblk = N >> 5, kb = item / nblk, nb = item - kb * nblk, k0 = kb << 6, n0 = nb << 5;
    float tv[32];
#pragma unroll
    for (int i = 0; i < 32; ++i) { const int kk = 2 * i + (lane >> 5); tv[i] = W[(size_t)(k0 + kk) * N + n0 + (lane & 31)]; }
    if (gk) {
#pragma unroll
        for (int i = 0; i < 32; ++i) tv[i] *= gk[k0 + 2 * i + (lane >> 5)]; }
#pragma unroll
    for (int i = 0; i < 32; ++i) { const int kk = 2 * i + (lane >> 5); scr[kk * 33 + (lane & 31)] = tv[i]; }
    LDSWAIT();
    const int c = lane & 7;
#pragma unroll
    for (int j = 0; j < 4; ++j) { const int n = (lane >> 3) + 8 * j; const float* s = scr + (8 * c) * 33 + n;
        u32x4 o; o.x = cvt_pk_bf16(s[0], s[33]); o.y = cvt_pk_bf16(s[66], s[99]); o.z = cvt_pk_bf16(s[132], s[165]); o.w = cvt_pk_bf16(s[198], s[231]);
        *(u32x4*)(WT + (size_t)(n0 + n) * K + k0 + 8 * c) = o; }
    LDSWAIT();
}
__device__ __forceinline__ void norm_rows(const KP& P, int l, int which) {
    const int tid = otid(), lane = tid & 63, wave = tid >> 6, gw = blockIdx.x * 8 + wave, NGW = gridDim.x * 8;
    const bool all = (which == 2) || (which == 0 && l == 0);
    const int nsplit = which == 1 ? 4 : ((which == 0 && l == 0) ? 0 : 8);
    const int rlo = all ? 0 : MP;
    bf16_t* HB = (bf16_t*)(P.ws() + (which == 0 ? OFF_HB1 : OFF_XN2));
    float* RSQ = (float*)(P.ws() + (which == 0 ? OFF_RSQ1 : OFF_RSQ2));
    f32x4 gg[4];
#pragma unroll
    for (int j = 0; j < 4; ++j) gg[j] = ((const f32x4*)P.in(39))[lane + 64 * j];
#pragma unroll 1
    for (int rb = rlo + gw; rb < MT; rb += 4 * NGW) {
        f32x4 v[4][4];
#pragma unroll
        for (int q = 0; q < 4; ++q) { const int r = rb + q * NGW;
            if (r < MT) { const float* src = P.out() + (size_t)r * 1024;
                if (l == 0 && which != 2 && !(which == 1 && false)) { if (which == 0 || which == 1) src = (r < MP) ? P.in(0) + (size_t)r * 1024 : P.in(1) + (size_t)(r - MP) * 1024; }
#pragma unroll
                for (int j = 0; j < 4; ++j) v[q][j] = ((const f32x4*)src)[lane + 64 * j];
                if (nsplit > 0 && r >= MP) { const float* pp = (const float*)(P.ws() + OFF_PART) + (size_t)(r - MP) * 1024;
#pragma unroll 1
                    for (int k0 = 0; k0 < nsplit; k0 += 4) { f32x4 pv[4][4];
#pragma unroll
                        for (int ks = 0; ks < 4; ++ks)
#pragma unroll
                            for (int j = 0; j < 4; ++j) pv[ks][j] = ((const f32x4*)(pp + (size_t)(k0 + ks) * 512 * 1024))[lane + 64 * j];
#pragma unroll
                        for (int ks = 0; ks < 4; ++ks)
#pragma unroll
                            for (int j = 0; j < 4; ++j) v[q][j] += pv[ks][j]; } } }
            else {
#pragma unroll
                for (int j = 0; j < 4; ++j) v[q][j] = (f32x4){0.f, 0.f, 0.f, 0.f}; } }
#pragma unroll
        for (int q = 0; q < 4; ++q) { const int r = rb + q * NGW; float s = 0.f;
#pragma unroll
            for (int j = 0; j < 4; ++j) s += v[q][j].x * v[q][j].x + v[q][j].y * v[q][j].y + v[q][j].z * v[q][j].z + v[q][j].w * v[q][j].w;
            s = wave_sum(s, lane);
            if (r < MT) { float* hrow = P.out() + (size_t)r * 1024;
                if (which == 2) { const float rstd = rsqrtf(s * (1.f / 1024.f) + 1e-6f);
#pragma unroll
                    for (int j = 0; j < 4; ++j) ((f32x4*)hrow)[lane + 64 * j] = v[q][j] * rstd * gg[j]; }
                else { if (lane == 0) RSQ[r] = s;
#pragma unroll
                    for (int j = 0; j < 4; ++j) { if (r >= MP && !(which == 0 && l == 0)) ((f32x4*)hrow)[lane + 64 * j] = v[q][j];
                        u32x2 w; w.x = cvt_pk_bf16(v[q][j].x, v[q][j].y); w.y = cvt_pk_bf16(v[q][j].z, v[q][j].w); *(u32x2*)(HB + (size_t)r * 1024 + (lane + 64 * j) * 4) = w; } } }
        }
    }
}
__device__ __forceinline__ void phaseA(const KP& P, int l0, unsigned char* smem) {
    const int l = l0;
    const int tid = otid(), lane = tid & 63, wave = tid >> 6, gw = blockIdx.x * 8 + wave, NGW = gridDim.x * 8;
#ifdef PROBE_SEL
    const unsigned long long a0_ = __builtin_amdgcn_s_memrealtime();
#endif
    norm_rows(P, l, 0);
#ifdef PROBE_SEL
    const unsigned long long a1_ = __builtin_amdgcn_s_memrealtime();
#endif
    float* scr = (float*)smem + wave * (64 * 33);
    if (l == 0) for (int it = gw; it < 1280; it += NGW) transpose_item(P.in(9), 1024, 2560, (bf16_t*)(P.ws() + OFF_WINT), scr, it, lane, P.in(8));
#ifdef PROBE_SEL
    const unsigned long long a2_ = __builtin_amdgcn_s_memrealtime();
#endif
    {
    const int gt = blockIdx.x * 512 + tid, NT = gridDim.x * 512;
    float* S5C = (float*)(P.ws() + OFF_S5C + l * CSTRIDE);
    for (int e = gt; e < 16384; e += NT) {
        const int idx = e >> 4, h = e & 15, g = idx >> 6, pp = idx & 63;
        const float lr = P.in(10)[l * 1024 + idx], li = P.in(11)[l * 1024 + idx], dt = expf(P.in(12)[l * 16 + g]);
        const float mag = expf(lr * dt); float sn, cs; sincosf(li * dt, &sn, &cs);
        const float abr = mag * cs, abi = mag * sn;
        if (h == 0) { const float magL = expf(64.f * lr * dt); float snL, csL; sincosf(64.f * li * dt, &snL, &csL);
            S5C[idx] = abr; S5C[1024 + idx] = abi; S5C[2048 + idx] = magL * csL; S5C[3072 + idx] = magL * snL; }
        const float den = lr * lr + li * li, zr = abr - 1.f, zi = abi;
        const float cr = (zr * lr + zi * li) / den, ci = (zi * lr - zr * li) / den;
        const float br = P.in(13)[((size_t)l * 1024 + idx) * 16 + h], bi = P.in(14)[((size_t)l * 1024 + idx) * 16 + h];
        bf16_t* BBT = (bf16_t*)(P.ws() + OFF_BBT + l * CSTRIDE);
        BBT[(g * 128 + pp) * 32 + h] = f2bf(cr * br - ci * bi); BBT[(g * 128 + 64 + pp) * 32 + h] = f2bf(cr * bi + ci * br); BBT[(g * 128 + pp) * 32 + 16 + h] = 0; BBT[(g * 128 + 64 + pp) * 32 + 16 + h] = 0;
    }
    bf16_t* CMT = (bf16_t*)(P.ws() + OFF_CMT + l * CSTRIDE);
    for (int idx = gt; idx < 32768; idx += NT) { const int gh = idx >> 7, pp = idx & 127;
        const float v = pp < 64 ? P.in(15)[((size_t)l * 256 + gh) * 64 + pp] : -P.in(16)[((size_t)l * 256 + gh) * 64 + pp - 64]; CMT[idx] = f2bf(v); }
    bf16_t* GLUT = (bf16_t*)(P.ws() + OFF_GLUT + l * CSTRIDE);
    for (int idx = gt; idx < 65536; idx += NT) { const int n = idx >> 8, k = idx & 255; GLUT[idx] = f2bf(P.in(18)[(size_t)l * 65536 + k * 256 + n]); }
    bf16_t* W2T = (bf16_t*)(P.ws() + OFF_W2T + l * CSTRIDE); bf16_t* A2T = (bf16_t*)(P.ws() + OFF_A2T + l * CSTRIDE); bf16_t* G2T = (bf16_t*)(P.ws() + OFF_G2T + l * CSTRIDE); bf16_t* PWT = (bf16_t*)(P.ws() + OFF_PWT + l * CSTRIDE);
    for (int idx = gt; idx < 16384; idx += NT) { const int c = idx >> 6, j = idx & 63;
        W2T[idx] = f2bf(P.in(24)[(size_t)l * 16384 + j * 256 + c]); A2T[idx] = f2bf(P.in(26)[(size_t)l * 16384 + j * 256 + c]);
        const int gi = idx >> 12, d = (idx >> 6) & 63, cc = idx & 63; PWT[idx] = f2bf(P.in(33)[(size_t)l * 16384 + gi * 4096 + cc * 64 + d]); }
    for (int idx = gt; idx < 32768; idx += NT) { const int c = idx >> 7, j = idx & 127; G2T[idx] = f2bf(P.in(27)[(size_t)l * 32768 + j * 256 + c]); }
    float* LB = (float*)(P.ws() + OFF_LB + l * CSTRIDE);
    for (int idx = gt; idx < 256; idx += NT) LB[idx] = (l == 0) ? 0.f : sigm(P.in(20)[256 + idx] - P.in(20)[idx]);
    }
#ifdef PROBE_SEL
    if (l == 0 && tid == 0 && (blockIdx.x == 0 || blockIdx.x == 100)) { float* sl = (float*)(P.ws() + OFF_CTR) + (blockIdx.x == 0 ? 56 : 60); const unsigned long long a3_ = __builtin_amdgcn_s_memrealtime();
        sl[0] = (float)(a1_ - a0_) * 0.01f; sl[1] = (float)(a2_ - a1_) * 0.01f; sl[2] = (float)(a3_ - a2_) * 0.01f; }
#endif
    if (blockIdx.x == 0 && tid == 0) { ((unsigned*)(P.ws() + OFF_CTR))[l] = 0u; ((unsigned*)(P.ws() + OFF_CTR))[2 + l] = 0u; }
}
__device__ __forceinline__ void phaseG(const KP& P, int l, unsigned char* smem) { norm_rows(P, l, 1); }

template <int MTW  > __device__ __forceinline__ void rwkv_prep_tile(const KP& P, int l, unsigned char* smem, int tile) {
    const int tid = otid(), lane = tid & 63, wave = tid >> 6, fr = lane & 15, fq = lane >> 4;
    const int r0 = tile * (32 * MTW);
    const bf16_t* PROJ = (const bf16_t*)(P.ws() + OFF_PROJ);
    bf16_t* MIXED = (bf16_t*)(P.ws() + OFF_MIXED);
    bf16_t* Aop = (bf16_t*)smem;
    const float* mu = P.in(22) + l * 1024;
    const float* shs = P.in(6) + (size_t)l * 128 * 1024;
    __syncthreads();
#pragma unroll 2
    for (int i = 0; i < 2 * MTW; ++i) {
        const int item = tid + 512 * i, tok = item >> 5, j0 = (item & 31) * 8, r = r0 + tok;
        int b, t; bool pr; row_info(r, b, t, pr);
        float p[8], q[8], o[8];
        unpack8(*(const u32x4*)(PROJ + (size_t)r * 2560 + 2048 + j0), p);
        if (t > 0) unpack8(*(const u32x4*)(PROJ + (size_t)(r - 1) * 2560 + 2048 + j0), q);
        else if (!pr) { const float* s = shs + (size_t)b * 1024 + 768 + j0;
#pragma unroll
            for (int e = 0; e < 8; ++e) q[e] = s[e]; }
        else {
#pragma unroll
            for (int e = 0; e < 8; ++e) q[e] = 0.f; }
#pragma unroll
        for (int e = 0; e < 8; ++e) { const float xs = p[e] + (q[e] - p[e]) * mu[768 + j0 + e]; o[e] = j0 < 64 ? tanh_(xs) : (j0 < 128 ? xs : sigm(xs)); }
        u32x4 w; w.x = cvt_pk_bf16(o[0], o[1]); w.y = cvt_pk_bf16(o[2], o[3]); w.z = cvt_pk_bf16(o[4], o[5]); w.w = cvt_pk_bf16(o[6], o[7]);
        *(u32x4*)(Aop + tok * 264 + j0) = w;
    }
    bf16_t* XS = (bf16_t*)(smem + 34816);
#pragma unroll 2
    for (int i = 0; i < 6 * MTW; ++i) {
        const int item = tid + 512 * i, tok = item / 96, j0 = (item - tok * 96) * 8, r = r0 + tok;
        int b, t; bool pr; row_info(r, b, t, pr);
        float p[8], q[8], o[8];
        unpack8(*(const u32x4*)(PROJ + (size_t)r * 2560 + 1280 + j0), p);
        if (t > 0) unpack8(*(const u32x4*)(PROJ + (size_t)(r - 1) * 2560 + 1280 + j0), q);
        else if (!pr) { const float* sp = shs + (size_t)b * 1024 + j0;
#pragma unroll
            for (int e = 0; e < 8; ++e) q[e] = sp[e]; }
        else {
#pragma unroll
            for (int e = 0; e < 8; ++e) q[e] = 0.f; }
#pragma unroll
        for (int e = 0; e < 8; ++e) o[e] = p[e] + (q[e] - p[e]) * mu[j0 + e];
        u32x4 w; w.x = cvt_pk_bf16(o[0], o[1]); w.y = cvt_pk_bf16(o[2], o[3]); w.z = cvt_pk_bf16(o[4], o[5]); w.w = cvt_pk_bf16(o[6], o[7]);
        *(u32x4*)(XS + tok * 776 + j0) = w;
    }
#pragma unroll 1
    for (int tok = 0; tok < 32 * MTW; ++tok) { const int r = r0 + tok; int b, t; bool pr; row_info(r, b, t, pr);
        if (pr ? (t == 2047) : (t == 3)) { float* dst = P.out() + (pr ? O_PSH + (size_t)(l * 8 + b) * 1024 : O_SSH + (size_t)(l * 128 + b) * 1024);
            for (int idx = tid; idx < 1024; idx += 512) dst[idx] = bf2f(PROJ[(size_t)r * 2560 + 1280 + idx]); } }
    __syncthreads();
    const int hd = wave & 3, th = wave >> 2;
    const bf16_t* W2T = (const bf16_t*)(P.ws() + OFF_W2T + l * CSTRIDE); const bf16_t* A2T = (const bf16_t*)(P.ws() + OFF_A2T + l * CSTRIDE); const bf16_t* G2T = (const bf16_t*)(P.ws() + OFF_G2T + l * CSTRIDE);
    f32x4 accw[4][MTW], acca[4][MTW], accg[4][MTW];
#pragma unroll
    for (int nt = 0; nt < 4; ++nt)
#pragma unroll
        for (int mt = 0; mt < MTW; ++mt) { accw[nt][mt] = (f32x4){0.f, 0.f, 0.f, 0.f}; acca[nt][mt] = accw[nt][mt]; accg[nt][mt] = accw[nt][mt]; }
#pragma unroll
    for (int nt = 0; nt < 4; ++nt) { const int n = hd * 64 + nt * 16 + fr;
#pragma unroll
        for (int ks = 0; ks < 2; ++ks) {
            const bf16x8 wf = *(const bf16x8*)(W2T + n * 64 + ks * 32 + fq * 8), af = *(const bf16x8*)(A2T + n * 64 + ks * 32 + fq * 8);
#pragma unroll
            for (int mt = 0; mt < MTW; ++mt) { const bf16_t* xr = Aop + (th * 16 * MTW + mt * 16 + fr) * 264 + ks * 32 + fq * 8;
                accw[nt][mt] = MFMA16(wf, *(const bf16x8*)xr, accw[nt][mt]); acca[nt][mt] = MFMA16(af, *(const bf16x8*)(xr + 64), acca[nt][mt]); } }
#pragma unroll
        for (int ks = 0; ks < 4; ++ks) { const bf16x8 gf = *(const bf16x8*)(G2T + n * 128 + ks * 32 + fq * 8);
#pragma unroll
            for (int mt = 0; mt < MTW; ++mt) accg[nt][mt] = MFMA16(gf, *(const bf16x8*)(Aop + (th * 16 * MTW + mt * 16 + fr) * 264 + 128 + ks * 32 + fq * 8), accg[nt][mt]); } }
    float* RW = (float*)(P.ws() + OFF_RW);
    float* C12 = (float*)(P.ws() + OFF_C12);
    const float* w0 = P.in(23) + l * 256; const float* a0 = P.in(25) + l * 256; const float* kkw = P.in(28) + l * 256; const float* kaw = P.in(29) + l * 256; const float* rkw = P.in(30) + l * 256;
#pragma unroll
    for (int mt = 0; mt < MTW; ++mt) {
        const int r = r0 + th * 16 * MTW + mt * 16 + fr; int b, t; bool pr; row_info(r, b, t, pr);
        float kkr[4][4], av[4][4], xrr[4][4]; float ss = 0.f, bs = 0.f, c2 = 0.f;
#pragma unroll
        for (int nt = 0; nt < 4; ++nt) {
            const int c0 = hd * 64 + nt * 16 + fq * 4;
            float xr4[4], xk4[4], xv4[4];
            { const bf16_t* xrow = XS + (th * 16 * MTW + mt * 16 + fr) * 776 + c0; unpack4(*(const u32x2*)(xrow), xr4); unpack4(*(const u32x2*)(xrow + 256), xk4); unpack4(*(const u32x2*)(xrow + 512), xv4); }
            f32x4 owr, ow, ok, ov; float gg[4];
#pragma unroll
            for (int j = 0; j < 4; ++j) { const int c = c0 + j;
                const float xr = xr4[j], xk = xk4[j], xv = xv4[j];
                const float wp = w0[c] + accw[nt][mt][j];
                const float nx = -wp;
                const float sp = fmaxf(nx, 0.f) + __logf(1.f + __expf(-fabsf(nx)));
                const float wv = -sp - 0.5f;
                const float dec = __expf(-__expf(wv));
                const float a = sigm(a0[c] + acca[nt][mt][j]);
                const float kr = xk * kkw[c]; ss += kr * kr;
                const float k = xk * (1.f + (a - 1.f) * kaw[c]);
                bs += xr * k * rkw[c]; c2 += xr * k;
                kkr[nt][j] = kr; av[nt][j] = a; xrr[nt][j] = xr;
                owr[j] = dec * xr; ow[j] = dec; ok[j] = k; ov[j] = xv; gg[j] = accg[nt][mt][j]; }
            const size_t o = (size_t)r * 256 + c0;
            *(f32x4*)(RW + 1 * RWSZ + o) = owr; *(f32x4*)(RW + 2 * RWSZ + o) = ow; *(f32x4*)(RW + 4 * RWSZ + o) = ok; *(f32x4*)(RW + 5 * RWSZ + o) = ov;
            *(u32x2*)(MIXED + (size_t)r * 1024 + 512 + c0) = pack4(gg);
        }
        ss += shx(ss, lane, 16); ss += shx(ss, lane, 32); bs += shx(bs, lane, 16); bs += shx(bs, lane, 32); c2 += shx(c2, lane, 16); c2 += shx(c2, lane, 32);
        const float inv = __builtin_amdgcn_rsqf(fmaxf(ss, 1e-24f)); float c1 = 0.f;
#pragma unroll
        for (int nt = 0; nt < 4; ++nt) { const int c0 = hd * 64 + nt * 16 + fq * 4; f32x4 okk, okka;
#pragma unroll
            for (int j = 0; j < 4; ++j) { const float kk = kkr[nt][j] * inv, kka = kk * av[nt][j]; okk[j] = kk; okka[j] = kka; c1 += kka * xrr[nt][j]; }
            const size_t o = (size_t)r * 256 + c0; *(f32x4*)(RW + 0 * RWSZ + o) = okk; *(f32x4*)(RW + 3 * RWSZ + o) = okka; }
        c1 += shx(c1, lane, 16); c1 += shx(c1, lane, 32);
        if (fq == 0) *(f32x4*)(C12 + (size_t)r * 16 + hd * 4) = (f32x4){c1, c2, bs, 0.f};
    }
}

__device__ __forceinline__ void pool_tile(const KP& P, int l, unsigned char* smem, int tile) {
    const int tid = otid(), lane = tid & 63, wave = tid >> 6, fr = lane & 15, fq = lane >> 4;
    const int r0 = tile * 64;
    const bf16_t* PROJ = (const bf16_t*)(P.ws() + OFF_PROJ);
    bf16_t* MIXED = (bf16_t*)(P.ws() + OFF_MIXED);
    bf16_t* Pop = (bf16_t*)smem;
    const float* pst = P.in(7) + (size_t)l * 128 * 15 * 256;
    __syncthreads();
#pragma unroll 2
    for (int i = 0; i < 4; ++i) {
        const int item = tid + 512 * i, tok = item >> 5, ch0 = (item & 31) * 8, r = r0 + tok, win = 2 << (ch0 >> 6);
        int b, t; bool pr; row_info(r, b, t, pr);
        float s[8], u[8];
#pragma unroll
        for (int e = 0; e < 8; ++e) { s[e] = 0.f; u[e] = 0.f; }
        if (pr) {
            u32x4 xv[16];
#pragma unroll
            for (int j = 0; j < 16; ++j) { xv[j] = (u32x4){0u, 0u, 0u, 0u}; if (j < win && t - j >= 0) xv[j] = *(const u32x4*)(PROJ + (size_t)(r - j) * 2560 + 2304 + ch0); }
#pragma unroll
            for (int j = 0; j < 16; ++j) { float x[8]; unpack8(xv[j], x);
#pragma unroll
                for (int e = 0; e < 8; ++e) { s[e] += x[e]; if (j == 0) u[e] = x[e]; } }
        } else {
            for (int j = 0; j < win; ++j) { const int tt = t - j; float x[8];
                if (tt >= 0) unpack8(*(const u32x4*)(PROJ + (size_t)(r - j) * 2560 + 2304 + ch0), x);
                else { const float* bp = pst + ((size_t)b * 15 + 15 + tt) * 256 + ch0;
#pragma unroll
                    for (int e = 0; e < 8; ++e) x[e] = bp[e]; }
                if (j == 0) {
#pragma unroll
                    for (int e = 0; e < 8; ++e) u[e] = x[e]; }
#pragma unroll
                for (int e = 0; e < 8; ++e) s[e] += x[e]; }
        }
        const float cnt = pr ? (float)min(t + 1, win) : (float)win, ic = 1.f / cnt; float o[8];
#pragma unroll
        for (int e = 0; e < 8; ++e) o[e] = s[e] * ic - u[e];
        u32x4 w; w.x = cvt_pk_bf16(o[0], o[1]); w.y = cvt_pk_bf16(o[2], o[3]); w.z = cvt_pk_bf16(o[4], o[5]); w.w = cvt_pk_bf16(o[6], o[7]);
        *(u32x4*)(Pop + tok * 264 + ch0) = w;
    }
    if (r0 < MP) { if ((r0 & 2047) == 1984) { const int b = r0 >> 11; float* dst = P.out() + O_PPOOL + (size_t)(l * 8 + b) * 3840;
            for (int idx = tid; idx < 3840; idx += 512) { const int j = idx >> 8, ch = idx & 255; dst[idx] = bf2f(PROJ[(size_t)(b * 2048 + 2033 + j) * 2560 + 2304 + ch]); } } }
    else { const int b0 = (r0 - MP) >> 2;
        for (int idx = tid; idx < 16 * 3840; idx += 512) { const int bb = idx / 3840, rem = idx - bb * 3840, j = rem >> 8, ch = rem & 255, b = b0 + bb;
            const float v = j < 11 ? pst[((size_t)b * 15 + j + 4) * 256 + ch] : bf2f(PROJ[(size_t)(MP + b * 4 + j - 11) * 2560 + 2304 + ch]);
            P.out()[O_SPOOL + (size_t)(l * 128 + b) * 3840 + rem] = v; } }
    __syncthreads();
    const bf16_t* PWT = (const bf16_t*)(P.ws() + OFF_PWT + l * CSTRIDE);
    const float* scale = P.in(34) + l * 256;
    f32x4 acc[2][4];
#pragma unroll
    for (int nt = 0; nt < 2; ++nt)
#pragma unroll
        for (int mt = 0; mt < 4; ++mt) acc[nt][mt] = (f32x4){0.f, 0.f, 0.f, 0.f};
#pragma unroll
    for (int nt = 0; nt < 2; ++nt) { const int n0 = wave * 32 + nt * 16, gi = n0 >> 6;
#pragma unroll
        for (int ks = 0; ks < 2; ++ks) { const bf16x8 wf = *(const bf16x8*)(PWT + (n0 + fr) * 64 + ks * 32 + fq * 8);
#pragma unroll
            for (int mt = 0; mt < 4; ++mt) acc[nt][mt] = MFMA16(wf, *(const bf16x8*)(Pop + (mt * 16 + fr) * 264 + gi * 64 + ks * 32 + fq * 8), acc[nt][mt]); } }
#pragma unroll
    for (int nt = 0; nt < 2; ++nt)
#pragma unroll
        for (int mt = 0; mt < 4; ++mt) { const int r = r0 + mt * 16 + fr, ch = wave * 32 + nt * 16 + fq * 4; float o[4];
#pragma unroll
            for (int j = 0; j < 4; ++j) o[j] = acc[nt][mt][j] * scale[ch + j];
            *(u32x2*)(MIXED + (size_t)r * 1024 + 768 + ch) = pack4(o); }
}

__device__ __forceinline__ void s5_task(const KP& P, int l, unsigned char* smem, int mode, int tile) {
    const int tid = otid(), lane = tid & 63, wave = tid >> 6, fr = lane & 15, fq = lane >> 4;
    const bool prompt = tile < 256;
    const int b = tile >> 5, c = tile & 31, st8 = tile - 256;
    const int r0 = prompt ? b * 2048 + c * 64 : MP + st8 * 64, b0 = st8 * 16;
    const bf16_t* PROJ = (const bf16_t*)(P.ws() + OFF_PROJ);
    bf16_t* MIXED = (bf16_t*)(P.ws() + OFF_MIXED);
    bf16_t* U = (bf16_t*)smem;
    bf16_t* Zb = (bf16_t*)(smem + 32768);
    float* BU = (float*)(smem + 32768 + 33792 + wave * 8448);
    __syncthreads();
#pragma unroll
    for (int i = 0; i < 4; ++i) { const int item = tid + 512 * i, tok = item >> 5, j0 = (item & 31) * 8;
        *(u32x4*)(U + tok * 256 + j0) = *(const u32x4*)(PROJ + (size_t)(r0 + tok) * 2560 + j0); }
    __syncthreads();
    const float* S5C = (const float*)(P.ws() + OFF_S5C + l * CSTRIDE);
    const bf16_t* CMT = (const bf16_t*)(P.ws() + OFF_CMT + l * CSTRIDE);
    const bf16_t* BBT = (const bf16_t*)(P.ws() + OFF_BBT + l * CSTRIDE);
    float* S5E = (float*)(P.ws() + OFF_S5E);
    const float* dsk = P.in(17) + l * 256;
#pragma unroll 1
    for (int gg = 0; gg < 2; ++gg) {
        const int g = 2 * wave + gg, gp = g * 64 + lane;
        const float ar = S5C[gp], ai = S5C[1024 + gp];
        float hr = 0.f, hi = 0.f;
        if (prompt && mode == 1) { const float alr = S5C[2048 + gp], ali = S5C[3072 + gp];
#pragma unroll 1
            for (int j0 = 0; j0 < c; j0 += 8) { f32x2v e[8];
#pragma unroll
                for (int jj = 0; jj < 8; ++jj) e[jj] = (j0 + jj < c) ? *(const f32x2v*)(S5E + ((size_t)((b * 32 + j0 + jj) * 16 + g) * 64 + lane) * 2) : (f32x2v){0.f, 0.f};
#pragma unroll
                for (int jj = 0; jj < 8; ++jj) if (j0 + jj < c) { const float nr = alr * hr - ali * hi + e[jj].x, ni = alr * hi + ali * hr + e[jj].y; hr = nr; hi = ni; } } }
        bf16x8 bfr[8], cfr[4];
#pragma unroll
        for (int pt = 0; pt < 8; ++pt) bfr[pt] = *(const bf16x8*)(BBT + (g * 128 + pt * 16 + fr) * 32 + fq * 8);
        if (mode == 1) {
#pragma unroll
            for (int ks = 0; ks < 4; ++ks) cfr[ks] = *(const bf16x8*)(CMT + (g * 16 + fr) * 128 + ks * 32 + fq * 8); }
        const f32x4 dsk4 = *(const f32x4*)(dsk + g * 16 + fq * 4);
#pragma unroll 1
        for (int st = 0; st < 4; ++st) {
            { bf16x8 uf = (bf16x8){0, 0, 0, 0, 0, 0, 0, 0};
              if (fq < 2) uf = *(const bf16x8*)(U + (st * 16 + fr) * 256 + g * 16 + fq * 8);
#pragma unroll
              for (int pt = 0; pt < 8; ++pt) { const f32x4 d = MFMA16(bfr[pt], uf, ((f32x4){0.f, 0.f, 0.f, 0.f})); *(f32x4*)(BU + fr * 132 + pt * 16 + fq * 4) = d; } }
            if (prompt) {
                float bur = BU[lane], bui = BU[64 + lane];
#pragma unroll
                for (int tt = 0; tt < 16; ++tt) {
                    const float nbr = BU[((tt + 1) & 15) * 132 + lane], nbi = BU[((tt + 1) & 15) * 132 + 64 + lane];
                    const float nr = ar * hr - ai * hi + bur, ni = ar * hi + ai * hr + bui; hr = nr; hi = ni; bur = nbr; bui = nbi;
                    if (mode == 1) { bf16_t* hb = (bf16_t*)(BU + tt * 132); hb[lane] = f2bf(hr); hb[64 + lane] = f2bf(hi); } }
            } else {
#pragma unroll 4
                for (int tt = 0; tt < 16; ++tt) { const int t = st * 16 + tt;
                    if ((t & 3) == 0) { const size_t so = ((size_t)(l * 128 + b0 + (t >> 2)) * 16 + g) * 64 + lane; hr = P.in(2)[so]; hi = P.in(3)[so]; }
                    const float bur = BU[tt * 132 + lane], bui = BU[tt * 132 + 64 + lane];
                    const float nr = ar * hr - ai * hi + bur, ni = ar * hi + ai * hr + bui; hr = nr; hi = ni;
                    bf16_t* hb = (bf16_t*)(BU + tt * 132); hb[lane] = f2bf(hr); hb[64 + lane] = f2bf(hi);
                    if ((t & 3) == 3) { const size_t so = ((size_t)(l * 128 + b0 + (t >> 2)) * 16 + g) * 64 + lane; P.out()[O_SSRE + so] = hr; P.out()[O_SSIM + so] = hi; } }
            }
            if (mode == 1) {
                f32x4 acc = (f32x4){0.f, 0.f, 0.f, 0.f};
#pragma unroll
                for (int ks = 0; ks < 4; ++ks) acc = MFMA16(cfr[ks], *(const bf16x8*)((const bf16_t*)(BU + fr * 132) + ks * 32 + fq * 8), acc);
                const int t = st * 16 + fr, ch = g * 16 + fq * 4; float u4[4], z[4];
                unpack4(*(const u32x2*)(U + t * 256 + ch), u4);
#pragma unroll
                for (int j = 0; j < 4; ++j) z[j] = gelu_t(acc[j] + dsk4[j] * u4[j]);
                *(u32x2*)(Zb + t * 264 + ch) = pack4(z);
            }
        }
        if (prompt && mode == 1 && c == 31) { const size_t so = ((size_t)(l * 8 + b) * 16 + g) * 64 + lane; P.out()[O_PSRE + so] = hr; P.out()[O_PSIM + so] = hi; }
        if (mode == 0) *(f32x2v*)(S5E + ((size_t)((b * 32 + c) * 16 + g) * 64 + lane) * 2) = (f32x2v){hr, hi};
    }
    if (mode == 1) {
        __syncthreads();
        const bf16_t* GLUT = (const bf16_t*)(P.ws() + OFF_GLUT + l * CSTRIDE);
        const float* gb = P.in(19) + l * 256;
        f32x4 acc[2][4];
#pragma unroll
        for (int nt = 0; nt < 2; ++nt)
#pragma unroll
            for (int mt = 0; mt < 4; ++mt) acc[nt][mt] = (f32x4){0.f, 0.f, 0.f, 0.f};
#pragma unroll
        for (int ks = 0; ks < 8; ++ks)
#pragma unroll
            for (int nt = 0; nt < 2; ++nt) { const bf16x8 wf = *(const bf16x8*)(GLUT + (wave * 32 + nt * 16 + fr) * 256 + ks * 32 + fq * 8);
#pragma unroll
                for (int mt = 0; mt < 4; ++mt) acc[nt][mt] = MFMA16(wf, *(const bf16x8*)(Zb + (mt * 16 + fr) * 264 + ks * 32 + fq * 8), acc[nt][mt]); }
#pragma unroll
        for (int nt = 0; nt < 2; ++nt)
#pragma unroll
            for (int mt = 0; mt < 4; ++mt) { const int tok = mt * 16 + fr, ch = wave * 32 + nt * 16 + fq * 4; float z4[4], o[4];
                unpack4(*(const u32x2*)(Zb + tok * 264 + ch), z4);
#pragma unroll
                for (int j = 0; j < 4; ++j) o[j] = z4[j] * sigm(acc[nt][mt][j] + gb[ch + j]);
                *(u32x2*)(MIXED + (size_t)(r0 + tok) * 1024 + ch) = pack4(o); }
    }
}

__device__ __forceinline__ void hgrn_task(const KP& P, int l, unsigned char* smem, int mode, int b, int hd, int sc) {
    const int tid = otid(), lane = tid & 63, wave = tid >> 6, fr = lane & 15, fq = lane >> 4;
    const bf16_t* PROJ = (const bf16_t*)(P.ws() + OFF_PROJ);
    bf16_t* MIXED = (bf16_t*)(P.ws() + OFF_MIXED);
    bf16_t* Qp = (bf16_t*)smem;
    bf16_t* Kn = Qp + 32 * 72;
    bf16_t* Kdt = Kn + 32 * 72;
    bf16_t* Vt = Kdt + 64 * 40;
    bf16_t* Att = Vt + 64 * 40;
    bf16_t* St = Att + 32 * 40;
    float* TOT = (float*)(St + 64 * 72);
    float* EB = TOT + 512;
    float* HST = (float*)(P.ws() + OFF_HST); float* HD = (float*)(P.ws() + OFF_HD);
    const int k = tid & 63, sg = tid >> 6, kt = wave >> 1, vt0 = (wave & 1) * 2;
    const float lbv = ((const float*)(P.ws() + OFF_LB + l * CSTRIDE))[hd * 64 + k];
    f32x4 accS[2] = {(f32x4){0.f, 0.f, 0.f, 0.f}, (f32x4){0.f, 0.f, 0.f, 0.f}};
    if (mode == 1) {
#pragma unroll 1
        for (int j0 = 0; j0 < sc; j0 += 4) { float dd[4][4], xx[4][2][4];
#pragma unroll
            for (int u = 0; u < 4; ++u) { const size_t bi = (size_t)((b * 4 + hd) * 16 + min(j0 + u, sc - 1));
#pragma unroll
                for (int jj = 0; jj < 4; ++jj) { const int kk = kt * 16 + fq * 4 + jj; dd[u][jj] = HD[bi * 64 + kk];
#pragma unroll
                    for (int i = 0; i < 2; ++i) xx[u][i][jj] = HST[(bi * 64 + kk) * 64 + (vt0 + i) * 16 + fr]; } }
#pragma unroll
            for (int u = 0; u < 4; ++u) if (j0 + u < sc) {
#pragma unroll
                for (int jj = 0; jj < 4; ++jj)
#pragma unroll
                    for (int i = 0; i < 2; ++i) accS[i][jj] = dd[u][jj] * accS[i][jj] + xx[u][i][jj]; } }
    } else if (mode == 2) { const float* sp = P.in(4) + ((size_t)(l * 128 + b) * 4 + hd) * 4096;
#pragma unroll
        for (int jj = 0; jj < 4; ++jj)
#pragma unroll
            for (int i = 0; i < 2; ++i) accS[i][jj] = sp[(kt * 16 + fq * 4 + jj) * 64 + (vt0 + i) * 16 + fr]; }
    __syncthreads();
    if (mode != 0) {
#pragma unroll
        for (int i = 0; i < 2; ++i) { float t4[4] = {accS[i][0], accS[i][1], accS[i][2], accS[i][3]}; *(u32x2*)(St + ((vt0 + i) * 16 + fr) * 72 + kt * 16 + fq * 4) = pack4(t4); } }
    float dsum = 0.f;
    const int nch = mode == 2 ? 1 : 4, L = mode == 2 ? 4 : 32;
    const int rbase = mode == 2 ? MP + b * 4 : b * 2048 + sc * 128;
    bf16_t rz[4], rq[4], rv[4];
#pragma unroll
    for (int e = 0; e < 4; ++e) { const int s = 4 * sg + e; rz[e] = 0; rq[e] = 0; rv[e] = 0;
        if (s < L) { const bf16_t* row = PROJ + (size_t)(rbase + s) * 2560 + hd * 64 + k; rz[e] = row[512]; rq[e] = row[256]; rv[e] = row[768]; } }
    f32x4 ngv[4];
#pragma unroll
    for (int vt = 0; vt < 4; ++vt) ngv[vt] = *(const f32x4*)(P.in(21) + l * 256 + hd * 64 + vt * 16 + fq * 4);
#pragma unroll 1
    for (int ch = 0; ch < nch; ++ch) {
        const int r0 = rbase + ch * 32;
        bf16_t nz[4], nq[4], nv[4];
#pragma unroll
        for (int e = 0; e < 4; ++e) { nz[e] = 0; nq[e] = 0; nv[e] = 0;
            if (ch + 1 < nch) { const bf16_t* row = PROJ + (size_t)(r0 + 32 + 4 * sg + e) * 2560 + hd * 64 + k; nz[e] = row[512]; nq[e] = row[256]; nv[e] = row[768]; } }
        u32x2 pgv[4];
#pragma unroll
        for (int vt = 0; vt < 4; ++vt) { pgv[vt] = (u32x2){0u, 0u}; if (mode != 0 && wave < 2 && wave * 16 + fr < L) pgv[vt] = *(const u32x2*)(PROJ + (size_t)(r0 + wave * 16 + fr) * 2560 + 1024 + hd * 64 + vt * 16 + fq * 4); }
        float lf[4], kv[4], q[4], vv[4], cs[4];
#pragma unroll
        for (int e = 0; e < 4; ++e) { const int s = 4 * sg + e; lf[e] = 0.f; kv[e] = 0.f; q[e] = 0.f; vv[e] = 0.f;
            if (s < L) { const float z = bf2f(rz[e]); const float f = lbv + (1.f - lbv) * sigm(z); lf[e] = __logf(f); kv[e] = 1.f - f;
                if (mode != 0) { const float pq = bf2f(rq[e]); q[e] = pq * sigm(pq); }
                vv[e] = bf2f(rv[e]); } }
#pragma unroll
        for (int e = 0; e < 4; ++e) { rz[e] = nz[e]; rq[e] = nq[e]; rv[e] = nv[e]; }
        cs[0] = lf[0]; cs[1] = cs[0] + lf[1]; cs[2] = cs[1] + lf[2]; cs[3] = cs[2] + lf[3];
        TOT[sg * 64 + k] = cs[3];
        __syncthreads();
        float off = 0.f, blast = 0.f;
#pragma unroll
        for (int j = 0; j < 8; ++j) { const float tj = TOT[j * 64 + k]; if (j < sg) off += tj; blast += tj; }
        { float kd4[4];
#pragma unroll
            for (int e = 0; e < 4; ++e) { const int s = 4 * sg + e; const float bsv = off + cs[e];
                Qp[s * 72 + k] = f2bf(q[e] * __expf(bsv)); Kn[s * 72 + k] = f2bf(kv[e] * __expf(-bsv)); kd4[e] = kv[e] * __expf(blast - bsv); }
            *(u32x2*)(Kdt + k * 40 + 4 * sg) = pack4(kd4); *(u32x2*)(Vt + k * 40 + 4 * sg) = pack4(vv); }
        if (sg == 0) { EB[k] = __expf(blast); dsum += blast; }
        __syncthreads();
        { const f32x4 eb = *(const f32x4*)(EB + kt * 16 + fq * 4); const bf16x8 af = *(const bf16x8*)(Kdt + (kt * 16 + fr) * 40 + fq * 8);
#pragma unroll
            for (int i = 0; i < 2; ++i) { accS[i] = accS[i] * eb; accS[i] = MFMA16(af, *(const bf16x8*)(Vt + ((vt0 + i) * 16 + fr) * 40 + fq * 8), accS[i]); } }
        if (mode != 0) {
            if (wave < 4) { const int tt = wave >> 1, st = wave & 1; f32x4 a = (f32x4){0.f, 0.f, 0.f, 0.f};
                if (st <= tt) {
#pragma unroll
                    for (int ks = 0; ks < 2; ++ks) a = MFMA16(*(const bf16x8*)(Kn + (st * 16 + fr) * 72 + ks * 32 + fq * 8), *(const bf16x8*)(Qp + (tt * 16 + fr) * 72 + ks * 32 + fq * 8), a);
                    float m4[4];
#pragma unroll
                    for (int j = 0; j < 4; ++j) m4[j] = (st * 16 + fq * 4 + j <= tt * 16 + fr) ? a[j] : 0.f;
                    *(u32x2*)(Att + (tt * 16 + fr) * 40 + st * 16 + fq * 4) = pack4(m4);
                } else { *(u32x2*)(Att + (tt * 16 + fr) * 40 + st * 16 + fq * 4) = (u32x2){0u, 0u}; } }
            __syncthreads();
            if (wave < 2) { const int tt = wave; f32x4 o[4]; float ss = 0.f;
                const bf16x8 attf = *(const bf16x8*)(Att + (tt * 16 + fr) * 40 + fq * 8), q0 = *(const bf16x8*)(Qp + (tt * 16 + fr) * 72 + fq * 8), q1 = *(const bf16x8*)(Qp + (tt * 16 + fr) * 72 + 32 + fq * 8);
#pragma unroll
                for (int vt = 0; vt < 4; ++vt) { f32x4 a = MFMA16(*(const bf16x8*)(Vt + (vt * 16 + fr) * 40 + fq * 8), attf, ((f32x4){0.f, 0.f, 0.f, 0.f}));
                    a = MFMA16(*(const bf16x8*)(St + (vt * 16 + fr) * 72 + fq * 8), q0, a); a = MFMA16(*(const bf16x8*)(St + (vt * 16 + fr) * 72 + 32 + fq * 8), q1, a);
                    o[vt] = a; ss += a.x * a.x + a.y * a.y + a.z * a.z + a.w * a.w; }
                ss += shx(ss, lane, 16); ss += shx(ss, lane, 32);
                const float rn = rsqrtf(ss * (1.f / 64.f) + 1e-5f); const int t = tt * 16 + fr;
                if (t < L) { const int r = r0 + t;
#pragma unroll
                    for (int vt = 0; vt < 4; ++vt) { const int ci = hd * 64 + vt * 16 + fq * 4; const f32x4 ng = ngv[vt]; float pg[4], ov[4];
                        unpack4(pgv[vt], pg);
#pragma unroll
                        for (int j = 0; j < 4; ++j) ov[j] = o[vt][j] * rn * ng[j] * (pg[j] * sigm(pg[j]));
                        *(u32x2*)(MIXED + (size_t)r * 1024 + 256 + ci) = pack4(ov); } } }
            __syncthreads();
#pragma unroll
            for (int i = 0; i < 2; ++i) { float t4[4] = {accS[i][0], accS[i][1], accS[i][2], accS[i][3]}; *(u32x2*)(St + ((vt0 + i) * 16 + fr) * 72 + kt * 16 + fq * 4) = pack4(t4); }
        }
    }
    float* dst = nullptr;
    if (mode == 0) { const size_t bi = (size_t)((b * 4 + hd) * 16 + sc); dst = HST + bi * 4096; if (sg == 0) HD[bi * 64 + k] = __expf(dsum); }
    else if (mode == 1) { if (sc == 15) dst = P.out() + O_PHG + ((size_t)(l * 8 + b) * 4 + hd) * 4096; }
    else dst = P.out() + O_SHG + ((size_t)(l * 128 + b) * 4 + hd) * 4096;
    if (dst) {
#pragma unroll
        for (int jj = 0; jj < 4; ++jj)
#pragma unroll
            for (int i = 0; i < 2; ++i) dst[(kt * 16 + fq * 4 + jj) * 64 + (vt0 + i) * 16 + fr] = accS[i][jj]; }
    __syncthreads();
}

template <int CTRL> __device__ __forceinline__ float dpp_add(float x) { return x + __int_as_float(__builtin_amdgcn_update_dpp(0, __float_as_int(x), CTRL, 0xF, 0xF, false)); }
__device__ __forceinline__ float row16_sum(float x) { x = dpp_add<0xB1>(x); x = dpp_add<0x4E>(x); x = dpp_add<0x141>(x); x = dpp_add<0x140>(x); return x; }
#ifndef SCAN_EVEN
#define SCAN_EVEN 0
#endif
#if SCAN_EVEN
#define SCAN_LOADER(w) (((w) & 1) != 0)
#define SCAN_IDX(w) ((w) >> 1)
#else
#define SCAN_LOADER(w) ((w) >= 4)
#define SCAN_IDX(w) ((w) & 3)
#endif
__device__ __forceinline__ void rwkv_scan_task(const KP& P, int l, unsigned char* smem, bool prompt, int b, int hd, int rq) {
    const int tid = otid(), lane = tid & 63, wave = tid >> 6;
    const int T = prompt ? 2048 : 4, row0 = prompt ? b * 2048 : MP + b * 4;
    const float* RW = (const float*)(P.ws() + OFF_RW);
    const float* C12 = (const float*)(P.ws() + OFF_C12);
    unsigned char* Yb = P.ws() + OFF_PROJ + 2560;
    constexpr int BUFF = 32 * 340;
    float* buf = (float*)smem;
    const bool loader = SCAN_LOADER(wave);
    const int sw = SCAN_IDX(wave), ltid = sw * 64 + lane;
    const int rr = lane >> 4, i4 = (lane & 15) * 4, srow = rq * 16 + sw * 4 + rr;
    f32x4 S = (f32x4){0.f, 0.f, 0.f, 0.f};
    if (!loader && !prompt) S = *(const f32x4*)(P.in(5) + (((size_t)(l * 128 + b) * 4 + hd) * 64 + srow) * 64 + i4);
    const int nchunks = (T + 31) >> 5;
    __syncthreads();
#pragma unroll 1
    for (int c = -1; c < nchunks; ++c) {
        if (loader) {
            if (c + 1 < nchunks) { const int t0 = (c + 1) * 32, n = min(32, T - t0); float* bw = buf + ((c + 1) & 1) * BUFF;
                f32x4 x[5][2]; float vx[2]; float cx = 0.f;
#pragma unroll
                for (int i = 0; i < 2; ++i) { const int idx = ltid + 256 * i, stp = idx >> 4, q = idx & 15; const size_t o = (size_t)(row0 + t0 + stp) * 256 + hd * 64 + q * 4;
#pragma unroll
                    for (int vct = 0; vct < 5; ++vct) x[vct][i] = (stp < n) ? *(const f32x4*)(RW + vct * RWSZ + o) : (f32x4){0.f, 0.f, 0.f, 0.f};
                    vx[i] = (stp < n) ? RW[5 * RWSZ + (size_t)(row0 + t0 + stp) * 256 + hd * 64 + rq * 16 + q] : 0.f; }
                if (ltid < 64) { const int stp = ltid >> 1; if (stp < n) cx = C12[(size_t)(row0 + t0 + stp) * 16 + hd * 4 + (ltid & 1)]; }
#pragma unroll
                for (int i = 0; i < 2; ++i) { const int idx = ltid + 256 * i, stp = idx >> 4, q = idx & 15;
#pragma unroll
                    for (int vct = 0; vct < 5; ++vct) *(f32x4*)(bw + vct * 2048 + stp * 64 + q * 4) = x[vct][i];
                    bw[10240 + stp * 16 + q] = vx[i]; }
                if (ltid < 64) bw[10752 + (ltid >> 1) * 4 + (ltid & 1)] = cx;
            }
        } else if (c >= 0) {
            __builtin_amdgcn_s_setprio(3);
            const int t0 = c * 32; const float* br = buf + (c & 1) * BUFF;
#define SCAN_LD(s_, kk_, wr_, w_, kka_, kv_, v_, cc_) do { kk_ = *(const f32x4*)(br + (s_) * 64 + i4); wr_ = *(const f32x4*)(br + 2048 + (s_) * 64 + i4); w_ = *(const f32x4*)(br + 4096 + (s_) * 64 + i4); \
                kka_ = *(const f32x4*)(br + 6144 + (s_) * 64 + i4); kv_ = *(const f32x4*)(br + 8192 + (s_) * 64 + i4); v_ = br[10240 + (s_) * 16 + sw * 4 + rr]; cc_ = *(const f32x2v*)(br + 10752 + (s_) * 4); } while (0)
            f32x4 kk, wr, w, kka, kv; float v; f32x2v cc;
            f32x4 kk1, wr1, w1, kka1, kv1; float v1; f32x2v cc1;
            SCAN_LD(0, kk, wr, w, kka, kv, v, cc); SCAN_LD(1, kk1, wr1, w1, kka1, kv1, v1, cc1);
#pragma unroll 1
            for (int sb = 0; sb < 32; sb += 16) {
                float ysel = 0.f;
#pragma unroll
                for (int s2 = 0; s2 < 16; ++s2) { const int s = sb + s2;
                    f32x4 kk2, wr2, w2, kka2, kv2; float v2; f32x2v cc2;
                    SCAN_LD(s + 2, kk2, wr2, w2, kka2, kv2, v2, cc2);
                    asm volatile("" ::: "memory");
                    const f32x2v S01 = (f32x2v){S.x, S.y}, S23 = (f32x2v){S.z, S.w};
                    f32x2v d1 = S01 * (f32x2v){kk.x, kk.y}; d1 = __builtin_elementwise_fma(S23, (f32x2v){kk.z, kk.w}, d1);
                    f32x2v d2 = S01 * (f32x2v){wr.x, wr.y}; d2 = __builtin_elementwise_fma(S23, (f32x2v){wr.z, wr.w}, d2);
                    float p1 = d1.x + d1.y, p2 = d2.x + d2.y;
                    p1 = row16_sum(p1); p2 = row16_sum(p2);
                    const float sa = -p1, y = p2 + sa * cc.x + v * cc.y;
                    S = S * w + sa * kka + v * kv;
                    ysel = ((lane & 15) == s2) ? y : ysel;
                    kk = kk1; wr = wr1; w = w1; kka = kka1; kv = kv1; v = v1; cc = cc1;
                    kk1 = kk2; wr1 = wr2; w1 = w2; kka1 = kka2; kv1 = kv2; v1 = v2; cc1 = cc2; }
                ((float*)(Yb + (size_t)(row0 + t0 + sb + (lane & 15)) * 5120))[hd * 64 + srow] = ysel;
            }
#undef SCAN_LD
            __builtin_amdgcn_s_setprio(0);
        }
        __syncthreads();
    }
    if (!loader) { float* dst = P.out() + (prompt ? O_PWKV + (((size_t)(l * 8 + b) * 4 + hd) * 64 + srow) * 64 : O_SWKV + (((size_t)(l * 128 + b) * 4 + hd) * 64 + srow) * 64) + i4; *(f32x4*)dst = S; }
}

__device__ __forceinline__ void rwkv_sample_wave(const KP& P, int l, unsigned char* smem, int b, int hd, int half) {
    const int tid = otid(), lane = tid & 63, wave = tid >> 6;
    const float* RW = (const float*)(P.ws() + OFF_RW); const float* C12 = (const float*)(P.ws() + OFF_C12); unsigned char* Yb = P.ws() + OFF_PROJ + 2560;
    float* wl = (float*)smem + wave * 1600;
    const int srow = half * 32 + (lane >> 1), kh = (lane & 1) * 32;
    float S[32];
    { const float* sp = P.in(5) + (((size_t)(l * 128 + b) * 4 + hd) * 64 + srow) * 64 + kh;
#pragma unroll
        for (int q = 0; q < 8; ++q) { const f32x4 x = *(const f32x4*)(sp + 4 * q); S[4 * q] = x.x; S[4 * q + 1] = x.y; S[4 * q + 2] = x.z; S[4 * q + 3] = x.w; } }
#pragma unroll
    for (int st = 0; st < 4; ++st) { const size_t r = (size_t)(MP + b * 4 + st);
#pragma unroll
        for (int vct = 0; vct < 6; ++vct) wl[st * 400 + vct * 64 + lane] = RW[vct * RWSZ + r * 256 + hd * 64 + lane];
        if (lane < 2) wl[st * 400 + 384 + lane] = C12[r * 16 + hd * 4 + lane]; }
    LDSWAIT();
#pragma unroll 1
    for (int st = 0; st < 4; ++st) { const float* w5 = wl + st * 400; float p1 = 0.f, p2 = 0.f;
#pragma unroll
        for (int q = 0; q < 8; ++q) { const f32x4 kk = *(const f32x4*)(w5 + kh + 4 * q), wr = *(const f32x4*)(w5 + 64 + kh + 4 * q);
#pragma unroll
            for (int j = 0; j < 4; ++j) { p1 += S[4 * q + j] * kk[j]; p2 += S[4 * q + j] * wr[j]; } }
        p1 = dpp_add<0xB1>(p1); p2 = dpp_add<0xB1>(p2);
        const float sa = -p1, v = w5[320 + srow], c1 = w5[384], c2 = w5[385];
        if ((lane & 1) == 0) ((float*)(Yb + (size_t)(MP + b * 4 + st) * 5120))[hd * 64 + srow] = p2 + sa * c1 + v * c2;
#pragma unroll
        for (int q = 0; q < 8; ++q) { const f32x4 w = *(const f32x4*)(w5 + 128 + kh + 4 * q), kka = *(const f32x4*)(w5 + 192 + kh + 4 * q), kv = *(const f32x4*)(w5 + 256 + kh + 4 * q);
#pragma unroll
            for (int j = 0; j < 4; ++j) S[4 * q + j] = S[4 * q + j] * w[j] + sa * kka[j] + v * kv[j]; } }
    { float* dp = P.out() + O_SWKV + (((size_t)(l * 128 + b) * 4 + hd) * 64 + srow) * 64 + kh;
#pragma unroll
        for (int q = 0; q < 8; ++q) *(f32x4*)(dp + 4 * q) = (f32x4){S[4 * q], S[4 * q + 1], S[4 * q + 2], S[4 * q + 3]}; }
    LDSWAIT();
}

#ifndef PROBE_VAL
#define PROBE_VAL tacc
#endif
#ifndef PROBE_CMASK
#define PROBE_CMASK 15
#endif
#ifndef PROBE_DMASK
#define PROBE_DMASK 31
#endif
__device__ __forceinline__ void phaseC(const KP& P0, int l, unsigned char* smem) {
    { const KP P = get_kp(); float* z1 = (float*)(P.ws() + OFF_RSQ1); float* z2 = (float*)(P.ws() + OFF_RSQ2);
      for (int i = blockIdx.x * 512 + otid(); i < MP; i += gridDim.x * 512) { z1[i] = 0.f; z2[i] = 0.f; } }
    const int tid = otid();
    unsigned* ctr = (unsigned*)(P0.ws() + OFF_CTR) + 2 + l;
    volatile int* s_task = (volatile int*)(smem + LDS_TASK_OFF);
    for (;;) {
        __syncthreads();
        if (tid == 0) *s_task = (int)atomicAdd(ctr, 1u);
        __syncthreads();
        const int t = *s_task;
        if (t >= 1312) break;
        const KP P = get_kp();
#ifdef PROBE_SEL
        const unsigned long long c0_ = __builtin_amdgcn_s_memrealtime();
#endif
        const int pt = (t < 560 && !(t & 1)) ? (t >> 1) : -1, lt = (t < 560) ? ((t & 1) ? (t >> 1) : -1) : t - 280;
        if (pt >= 0) { if (pt < 248) rwkv_prep_tile<2>(P, l, smem, pt); else rwkv_prep_tile<1>(P, l, smem, 496 + (pt - 248)); }
        else if (lt < 256) s5_task(P, l, smem, 0, lt);
        else if (lt < 520) pool_tile(P, l, smem, lt - 256);
        else { const int u = lt - 520; hgrn_task(P, l, smem, 0, u >> 6, (u >> 4) & 3, u & 15); }
#ifdef PROBE_SEL
        if (l == 0 && tid == 0) { float* sl = (float*)(P.ws() + OFF_CTR) + 52 + (t < 280 ? 0 : (t < 536 ? 1 : (t < 800 ? 2 : 3))); *sl = (float)(__builtin_amdgcn_s_memrealtime() - c0_) * 0.01f; }
#endif
    }
}
__device__ __forceinline__ void phaseD(const KP& P0, int l, unsigned char* smem) {
    const int tid = otid();
#ifdef PROBE_SEL
    float ptt[5] = {0.f, 0.f, 0.f, 0.f, 0.f}, ptn[5] = {0.f, 0.f, 0.f, 0.f, 0.f}; unsigned long long pt0 = __builtin_amdgcn_s_memrealtime();
#endif
    if ((PROBE_DMASK & 1) && blockIdx.x < 128) rwkv_scan_task(P0, l, smem, true, blockIdx.x >> 4, (blockIdx.x >> 2) & 3, blockIdx.x & 3);
#ifdef PROBE_SEL
    ptt[0] = (float)(__builtin_amdgcn_s_memrealtime() - pt0) * 0.01f; ptn[0] = 1.f;
#endif
    unsigned* ctr = (unsigned*)(P0.ws() + OFF_CTR) + l;
    volatile int* s_task = (volatile int*)(smem + LDS_TASK_OFF);
    for (;;) {
        __syncthreads();
        if (tid == 0) *s_task = (int)atomicAdd(ctr, 1u);
        __syncthreads();
        const int t = *s_task;
        if (t >= 1416 + 576 + (l == 0 ? 160 : 0)) break;
        const KP P = get_kp();
#ifdef PROBE_SEL
        pt0 = __builtin_amdgcn_s_memrealtime();
#endif
        if (t < 512) { if (PROBE_DMASK & 2) hgrn_task(P, l, smem, 1, t >> 6, (t >> 4) & 3, t & 15); }
        else if (t < 776) { if (PROBE_DMASK & 4) s5_task(P, l, smem, 1, t - 512); }
        else if (t < 1288) { const int u = t - 776; if (PROBE_DMASK & 8) hgrn_task(P, l, smem, 2, u >> 2, u & 3, 0); }
        else if (t < 1416) { const int u = (t - 1288) * 8 + (tid >> 6); rwkv_sample_wave(P, l, smem, u >> 3, (u >> 1) & 3, u & 1); }
        else { const int it = (t - 1416) * 8 + (tid >> 6), lane = tid & 63; float* scr = (float*)smem + (tid >> 6) * (64 * 33);
            if (it < 512) transpose_item(P.in(35) + (size_t)l * 1024 * 1024, 1024, 1024, (bf16_t*)(P.ws() + OFF_WOUTT), scr, it, lane, nullptr);
            else if (it < 2560) transpose_item(P.in(37) + (size_t)l * 1024 * 4096, 1024, 4096, (bf16_t*)(P.ws() + OFF_UPT), scr, it - 512, lane, P.in(36) + l * 1024);
            else if (it < 4608) transpose_item(P.in(38) + (size_t)l * 4096 * 1024, 4096, 1024, (bf16_t*)(P.ws() + OFF_DOWNT), scr, it - 2560, lane, nullptr);
            else transpose_item(P.in(9) + (size_t)(l + 1) * 1024 * 2560, 1024, 2560, (bf16_t*)(P.ws() + OFF_WINT), scr, it - 4608, lane, P.in(8) + (l + 1) * 1024); }
#ifdef PROBE_SEL
        { const int ty = t < 512 ? 1 : (t < 776 ? 2 : (t < 1288 ? 3 : 4)); const float d = (float)(__builtin_amdgcn_s_memrealtime() - pt0) * 0.01f;
#pragma unroll
          for (int c = 1; c < 5; ++c) if (c == ty) { ptt[c] += d; ptn[c] += 1.f; } }
#endif
    }
#ifdef PROBE_SEL
    if (l == 0 && tid == 0 && (blockIdx.x == 0 || blockIdx.x == 200)) { float* sl = (float*)(P0.ws() + OFF_CTR) + (blockIdx.x == 0 ? 16 : 32);
#pragma unroll
        for (int c = 0; c < 5; ++c) { sl[c] = ptt[c]; sl[8 + c] = ptn[c]; } }
#endif
}
__device__ __forceinline__ void phaseE(const KP& P, int l) {
    const int tid = otid(), lane = tid & 63, wave = tid >> 6, gw = blockIdx.x * 8 + wave, NGW = gridDim.x * 8;
    const unsigned char* Yb = P.ws() + OFF_PROJ + 2560; const float* Vb = (const float*)(P.ws() + OFF_RW) + 5 * RWSZ; const float* C12 = (const float*)(P.ws() + OFF_C12);
    bf16_t* MIXED = (bf16_t*)(P.ws() + OFF_MIXED);
    const int c0 = lane * 4, hd = lane >> 4;
    const f32x4 lg = *(const f32x4*)(P.in(31) + l * 256 + c0), lbb = *(const f32x4*)(P.in(32) + l * 256 + c0);
#pragma unroll 1
    for (int rb = gw; rb < MT; rb += 8 * NGW) {
        f32x4 yv[8], vv[8]; u32x2 gv[8]; float bsv[8];
#pragma unroll
        for (int q = 0; q < 8; ++q) { const int r = min(rb + q * NGW, MT - 1);
            yv[q] = *(const f32x4*)((const float*)(Yb + (size_t)r * 5120) + c0); vv[q] = *(const f32x4*)(Vb + (size_t)r * 256 + c0);
            gv[q] = *(const u32x2*)(MIXED + (size_t)r * 1024 + 512 + c0); bsv[q] = C12[(size_t)r * 16 + hd * 4 + 2]; }
#pragma unroll
        for (int q = 0; q < 8; ++q) { const int r = rb + q * NGW; const f32x4 y = yv[q], v = vv[q];
            float s = y.x + y.y + y.z + y.w; s += shx(s, lane, 1); s += shx(s, lane, 2); s += shx(s, lane, 4); s += shx(s, lane, 8);
            const float mean = s * (1.f / 64.f); const f32x4 d = y - mean;
            float qq = d.x * d.x + d.y * d.y + d.z * d.z + d.w * d.w; qq += shx(qq, lane, 1); qq += shx(qq, lane, 2); qq += shx(qq, lane, 4); qq += shx(qq, lane, 8);
            const float rs = rsqrtf(qq * (1.f / 64.f) + 64e-5f); const float bs = bsv[q];
            float g[4], o[4]; unpack4(gv[q], g);
#pragma unroll
            for (int j = 0; j < 4; ++j) o[j] = (d[j] * rs * lg[j] + lbb[j] + bs * v[j]) * g[j];
            if (r < MT) *(u32x2*)(MIXED + (size_t)r * 1024 + 512 + c0) = pack4(o); }
    }
}

template <class Epi> __device__ __forceinline__ void run_gemm(unsigned char* smem, const bf16_t* A, const bf16_t* Bt, int M, int N, int K, const Epi& E) {
    pg8::Gemm g; g.A = A; g.Bt = Bt; g.M = M; g.N = N; g.K = K; g.ld = K;
    pg8::StaticOrder S; S.init(M, N, (int)gridDim.x, (int)blockIdx.x);
    __syncthreads();
    pg8::gemm_phase<Epi, pg8::StaticOrder, false>((PG8_LAS unsigned char*)smem, g, S, E, nullptr);
    __syncthreads();
}
struct ResidOrder {
    pg8::StaticOrder main; int S, kbytes, ntail, G, c;
    __device__ bool next(int i, pg8::Unit& u) const {
        if (main.next(i, u)) return true;
        const int L = i * G + c - main.nwg; if (L < 0 || L >= 8 * S) return false;
        const int t = L / S, ks = L - t * S; u.pm = 64 + (t >> 2); u.pn = t & 3; u.kb = ks * kbytes; u.nt = ntail; return true; }
    __device__ __forceinline__ void a_ready(const pg8::Unit&) const {}
    __device__ __forceinline__ void done(const pg8::Unit&) const {}
};
__device__ __forceinline__ void run_gemm_resid(unsigned char* smem, const bf16_t* A, const bf16_t* Bt, int K, int split, pg8::EpiResid& E) {
    pg8::Gemm g; g.A = A; g.Bt = Bt; g.M = MP; g.N = 1024; g.K = K; g.ld = K;
    ResidOrder S; S.main.init(MP, 1024, (int)gridDim.x, (int)blockIdx.x); S.S = split; S.kbytes = (K / split) * 2; S.ntail = (K / split) / 64; S.G = (int)gridDim.x; S.c = (int)blockIdx.x;
    E.kbytes = S.kbytes;
    __syncthreads();
    pg8::gemm_phase<pg8::EpiResid, ResidOrder, false>((PG8_LAS unsigned char*)smem, g, S, E, nullptr);
    __syncthreads();
}

__device__ __forceinline__ void gbar(unsigned* bar, unsigned& target) {
    __syncthreads();
    if (threadIdx.x == 0) {
        target += gridDim.x;
        __threadfence();
        __hip_atomic_fetch_add(bar, 1u, __ATOMIC_RELAXED, __HIP_MEMORY_SCOPE_AGENT);
        while (__hip_atomic_load(bar, __ATOMIC_RELAXED, __HIP_MEMORY_SCOPE_AGENT) < target) __builtin_amdgcn_s_sleep(1);
        __threadfence();
    }
    __syncthreads();
}
#define SEAM(ID) do { if ((ID) == 0) grid.sync(); else gbar(bar, btarget); } while (0)
#ifdef PROBE_SEL
#define PH_END(ID) do { SEAM(ID); { const unsigned long long tn_ = __builtin_amdgcn_s_memrealtime(); const float d_ = (float)(tn_ - tprev) * 0.01f; tprev = tn_; const int ID_ = (ID); const int L_ = ID_ / 9, SUB_ = ID_ % 9; (void)L_; (void)SUB_; if (PROBE_SEL) tacc += d_; } } while (0)
#else
#define PH_END(ID) SEAM(ID)
#endif
__global__ void __launch_bounds__(512, 2) mega(Params Pk) {
    extern __shared__ __attribute__((aligned(16))) unsigned char smem[];
    cg::grid_group grid = cg::this_grid();
    unsigned long long tprev = 0ull; float tacc = 0.f;
    unsigned btarget = 0u; unsigned* bar = (unsigned*)(get_kp().ws() + OFF_CTR) + 8;
#ifdef PROBE_SEL
    tprev = __builtin_amdgcn_s_memrealtime();
#endif
#pragma unroll 1
    for (int ph = 0; ph < 18; ++ph) {
        int L = ph / 9; const int sub = ph - L * 9; L = __builtin_amdgcn_readfirstlane(L);
        if (sub == 0) phaseA(get_kp(), L, smem);
        else if (sub == 1 || sub == 7) { const KP P = get_kp(); pg8::EpiBf E; E.ACT = sub == 7; E.O = (bf16_t*)(P.ws() + (sub == 1 ? OFF_PROJ : OFF_HIDDEN)); E.ldc = sub == 1 ? 2560 : 4096; E.rsq = (const float*)(P.ws() + (sub == 1 ? OFF_RSQ1 : OFF_RSQ2));
            run_gemm(smem, (const bf16_t*)(P.ws() + (sub == 1 ? OFF_HB1 : OFF_XN2)), (const bf16_t*)(P.ws() + (sub == 1 ? OFF_WINT : OFF_UPT)), MT, sub == 1 ? 2560 : 4096, 1024, E); }
        else if (sub == 2) phaseC(get_kp(), L, smem);
        else if (sub == 3) phaseD(get_kp(), L, smem);
        else if (sub == 4) phaseE(get_kp(), L);
        else if (sub == 5 || sub == 8) { const KP P = get_kp(); pg8::EpiResid E; E.H = P.out(); E.Hin = (L == 0 && sub == 5) ? P.in(0) : P.out(); E.ldc = 1024; E.HB = (bf16_t*)(P.ws() + (sub == 5 ? OFF_XN2 : OFF_HB1)); E.rsq = (float*)(P.ws() + (sub == 5 ? OFF_RSQ2 : OFF_RSQ1));
            const bf16_t* A = (const bf16_t*)(P.ws() + (sub == 5 ? OFF_MIXED : OFF_HIDDEN)); const bf16_t* Bt = (const bf16_t*)(P.ws() + (sub == 5 ? OFF_WOUTT : OFF_DOWNT)); const int K = sub == 5 ? 1024 : 4096;
            E.PART = (float*)(P.ws() + OFF_PART); run_gemm_resid(smem, A, Bt, K, sub == 5 ? 4 : 8, E); }
        else phaseG(get_kp(), L, smem);
        PH_END(ph);
    }
#ifdef PROBE_SEL
    if (threadIdx.x == 0) { const KP P = get_kp(); ((int*)(P.ws() + WS_END))[blockIdx.x] = (int)((unsigned)__builtin_amdgcn_s_getreg((3 << 11) | 20) & 0xFu); }
#endif
    norm_rows(get_kp(), 0, 2);
#ifdef PROBE_SEL
    PH_END(18);
    float xmis = 0.f; { const KP P = get_kp(); const int* xt = (const int*)(P.ws() + WS_END); for (int i = 0; i < 256; ++i) xmis += (xt[i] != xt[i & 7]) ? 1.f : 0.f; } (void)xmis;
    if (blockIdx.x == 0) { const KP P = get_kp(); const float* sl = (const float*)(P.ws() + OFF_CTR); (void)sl; const float sc = 1.f + sqrtf((PROBE_VAL) * 1e-5f); for (int i = threadIdx.x; i < 16384; i += 512) P.out()[O_PSRE + i] *= sc; }
#endif
}

extern "C" void kernel_launch(void* const* d_in, const int* in_sizes, int n_in, void* d_out, int out_size, void* d_ws, size_t ws_size, hipStream_t stream) {
    static int grid = 0;
    if (grid == 0) {
        if (n_in != 40 || ws_size < WS_END) { fprintf(stderr, "kernel_launch: unexpected n_in %d / ws %zu\n", n_in, ws_size); grid = -1; return; }
        int dev = 0, cus = 0, per_cu = 0;
        hipGetDevice(&dev); hipDeviceGetAttribute(&cus, hipDeviceAttributeMultiprocessorCount, dev);
        if (hipFuncSetAttribute((const void*)mega, hipFuncAttributeMaxDynamicSharedMemorySize, LDS_BYTES) != hipSuccess) { fprintf(stderr, "kernel_launch: hipFuncSetAttribute failed\n"); grid = -1; return; }
        if (hipOccupancyMaxActiveBlocksPerMultiprocessor(&per_cu, (const void*)mega, 512, LDS_BYTES) != hipSuccess || per_cu < 1) { fprintf(stderr, "kernel_launch: occupancy query says %d\n", per_cu); per_cu = 1; }
        (void)hipGetLastError();
        grid = cus;
    }
    if (grid < 0) return;
    Params p{};
    for (int i = 0; i < 40; ++i) p.in[i] = (const float*)d_in[i];
    p.out = (float*)d_out; p.ws = (unsigned char*)d_ws;
    if (hipMemsetAsync((char*)d_ws + OFF_CTR + 32, 0, 4, stream) != hipSuccess) { fprintf(stderr, "kernel_launch: memset of the barrier word failed\n"); return; }
    void* args[] = {&p};
    hipError_t e = hipLaunchCooperativeKernel((const void*)mega, dim3(grid), dim3(512), args, LDS_BYTES, stream);
    if (e != hipSuccess) fprintf(stderr, "cooperative launch failed: %s (grid %d)\n", hipGetErrorString(e), grid);
}
```

```cpp
#include <hip/hip_runtime.h>
#include <hip/hip_cooperative_groups.h>
#include <cstdio>
#include <cstdint>
namespace cg = cooperative_groups;
__device__ __forceinline__ int otid() { int t = threadIdx.x; asm volatile("" : "+v"(t)); return t; }
namespace pg8 {
#define PG8_LAS __attribute__((address_space(3)))
typedef unsigned short bf16_t;
typedef short bf16x8 __attribute__((ext_vector_type(8)));
typedef float f32x4 __attribute__((ext_vector_type(4)));
typedef unsigned u32x4 __attribute__((ext_vector_type(4)));
constexpr int BM = 256, BK = 64, HALF = 128, HTB = HALF * BK * 2  , STAGE_BYTES = 8 * HTB, NXCD = 8, WGM = 8;

__host__ __device__ __forceinline__ int lds_byte(int r, int c) { const int st = (r >> 4) * 2 + (c >> 5), rr = r & 15, cc = c & 31, ob = rr * 64 + cc * 2; return st * 1024 + (ob ^ (((ob >> 9) & 1) << 5)); }
__host__ __device__ __forceinline__ void stage_rc(int b, int& R, int& C) { const int st = b / 1024, sb = b % 1024, swz = sb ^ (((sb >> 9) & 1) << 5); R = (st >> 1) * 16 + swz / 64; C = (st & 1) * 32 + (swz % 64) / 2; }
__host__ __device__ __forceinline__ int perm32(int rho) { const int n = rho >> 4, i = rho & 15; return 8 * (i >> 2) + 4 * n + (i & 3); }

struct Unit { int pm, pn, kb, nt; };
struct Gemm { const bf16_t* A; const bf16_t* Bt; int M, N, K, ld; };

struct StaticOrder {
    int nM, nN, nwg, G, c;
    __host__ __device__ void init(int M, int N, int G_, int c_) { nM = M / BM; nN = N / BM; nwg = nM * nN; G = G_; c = c_; }
    __host__ __device__ bool next(int i, Unit& u) const {
        const long L = (long)i * G + c; if (L >= nwg) return false;
        int wgid = (int)L; { const int q = nwg / NXCD, r = nwg % NXCD, xcd = wgid % NXCD, off = wgid / NXCD; wgid = (xcd < r ? xcd * (q + 1) : r * (q + 1) + (xcd - r) * q) + off; }
        const int nig = WGM * nN, gid = wgid / nig, fm = gid * WGM, gsz = (nM - fm) < WGM ? (nM - fm) : WGM;
        u.pm = fm + ((wgid % nig) % gsz); u.pn = (wgid % nig) / gsz; u.kb = 0; u.nt = 0; return true;
    }
    __device__ __forceinline__ void a_ready(const Unit&) const {}
    __device__ __forceinline__ void done(const Unit&) const {}
};
__device__ __forceinline__ unsigned cvt_pk_bf16(float lo, float hi) { unsigned r; asm volatile("v_cvt_pk_bf16_f32 %0, %1, %2" : "=v"(r) : "v"(lo), "v"(hi)); return r; }
struct EpiBf {
    static constexpr bool PERM = true, AFTER_DRAIN = false;
    bf16_t* O; int ldc; int ACT; const float* rsq;
    __device__ __forceinline__ void init(f32x4 (&acc)[2][2][4][2], const Unit&, int, int, int, int) const {
#pragma unroll
        for (int a = 0; a < 2; ++a)
#pragma unroll
            for (int b = 0; b < 2; ++b)
#pragma unroll
                for (int m = 0; m < 4; ++m)
#pragma unroll
                    for (int n = 0; n < 2; ++n) acc[a][b][m][n] = (f32x4){0.f, 0.f, 0.f, 0.f}; }
    __device__ __forceinline__ void operator()(const f32x4 (&acc)[2][2][4][2], const Unit& u, int wr, int wc, int fr, int fq) const {
        const int row0 = u.pm * BM + wr * 64 + fr; const int col0 = u.pn * BM + wc * 32 + 8 * fq;
#pragma unroll
        for (int ai = 0; ai < 2; ++ai)
#pragma unroll
            for (int m = 0; m < 4; ++m) { bf16_t* rowp = O + (size_t)(row0 + ai * HALF + m * 16) * ldc + col0; const float rstd = rsqrtf(rsq[row0 + ai * HALF + m * 16] * (1.f / 1024.f) + 1e-6f);
#pragma unroll
                for (int bj = 0; bj < 2; ++bj) { f32x4 v0 = acc[ai][bj][m][0] * rstd, v1 = acc[ai][bj][m][1] * rstd;
                    if (ACT) {
#pragma unroll
                        for (int j = 0; j < 4; ++j) { const float a = fmaxf(v0[j], 0.f), b = fmaxf(v1[j], 0.f); v0[j] = a * a; v1[j] = b * b; } }
                    u32x4 w; w.x = cvt_pk_bf16(v0[0], v0[1]); w.y = cvt_pk_bf16(v0[2], v0[3]); w.z = cvt_pk_bf16(v1[0], v1[1]); w.w = cvt_pk_bf16(v1[2], v1[3]);
                    *(u32x4*)(rowp + bj * HALF) = w; } }
    }
};
struct EpiResid {
    static constexpr bool PERM = false, AFTER_DRAIN = false;
    float* H; const float* Hin; int ldc; bf16_t* HB; float* rsq; float* PART; int kbytes;
    __device__ __forceinline__ void init(f32x4 (&acc)[2][2][4][2], const Unit& u, int wr, int wc, int fr, int fq) const {
        if (u.pm >= 64) {
#pragma unroll
        for (int a = 0; a < 2; ++a)
#pragma unroll
            for (int b = 0; b < 2; ++b)
#pragma unroll
                for (int m = 0; m < 4; ++m)
#pragma unroll
                    for (int n = 0; n < 2; ++n) acc[a][b][m][n] = (f32x4){0.f, 0.f, 0.f, 0.f};
            return; }
        const int row0 = u.pm * BM + wr * 64 + fr, col0 = u.pn * BM + wc * 32 + 4 * fq;
#pragma unroll
        for (int ai = 0; ai < 2; ++ai)
#pragma unroll
            for (int m = 0; m < 4; ++m) { const float* rowp = Hin + (size_t)(row0 + ai * HALF + m * 16) * ldc + col0;
#pragma unroll
                for (int bj = 0; bj < 2; ++bj)
#pragma unroll
                    for (int n = 0; n < 2; ++n) acc[ai][bj][m][n] = *(const f32x4*)(rowp + bj * HALF + n * 16); }
    }
    __device__ __forceinline__ void operator()(const f32x4 (&acc)[2][2][4][2], const Unit& u, int wr, int wc, int fr, int fq) const {
        if (u.pm >= 64) { const int ks = u.kb / kbytes, row0 = (u.pm - 64) * BM + wr * 64 + fr, col0 = u.pn * BM + wc * 32 + 4 * fq;
#pragma unroll
            for (int ai = 0; ai < 2; ++ai)
#pragma unroll
                for (int m = 0; m < 4; ++m) { float* rowp = PART + ((size_t)ks * 512 + row0 + ai * HALF + m * 16) * 1024 + col0;
#pragma unroll
                    for (int bj = 0; bj < 2; ++bj)
#pragma unroll
                        for (int n = 0; n < 2; ++n) *(f32x4*)(rowp + bj * HALF + n * 16) = acc[ai][bj][m][n]; }
            return; }
        const int row0 = u.pm * BM + wr * 64 + fr, col0 = u.pn * BM + wc * 32 + 4 * fq, lane = fq * 16 + fr;
#pragma unroll
        for (int ai = 0; ai < 2; ++ai)
#pragma unroll
            for (int m = 0; m < 4; ++m) { const int row = row0 + ai * HALF + m * 16; float* rowp = H + (size_t)row * ldc + col0; bf16_t* hbp = HB + (size_t)row * ldc + col0; float ss = 0.f;
#pragma unroll
                for (int bj = 0; bj < 2; ++bj)
#pragma unroll
                    for (int n = 0; n < 2; ++n) { const f32x4 v = acc[ai][bj][m][n]; *(f32x4*)(rowp + bj * HALF + n * 16) = v;
                        ss += v.x * v.x + v.y * v.y + v.z * v.z + v.w * v.w;
                        typedef unsigned u32x2_ __attribute__((ext_vector_type(2))); *(u32x2_*)(hbp + bj * HALF + n * 16) = (u32x2_){cvt_pk_bf16(v.x, v.y), cvt_pk_bf16(v.z, v.w)}; }
                ss += __int_as_float(__builtin_amdgcn_ds_bpermute((lane ^ 16) << 2, __float_as_int(ss))); ss += __int_as_float(__builtin_amdgcn_ds_bpermute((lane ^ 32) << 2, __float_as_int(ss)));
                if (fq == 0) unsafeAtomicAdd(rsq + row, ss); }
    }
};

template <class Epi, class Sched, bool STAMP = false>
__device__ __forceinline__ void gemm_phase(PG8_LAS unsigned char* lds, const Gemm g, const Sched& S, const Epi& E, unsigned long long* stamps) {
    const int tid = otid(), wid = __builtin_amdgcn_readfirstlane(tid >> 6), lane = tid & 63, wr = wid >> 2, wc = wid & 3, fr = lane & 15, fq = lane >> 4;
    const int K = g.ld, nt = g.K / BK;
    int ts_lo = 0, ts_hi = 0, nts = 0; const unsigned long long rt_entry = STAMP ? (unsigned long long)wall_clock64() : 0ull;
#define PG8_STAMP() do { if (STAMP && wid == 0 && nts < 64) { const unsigned long long _c = (unsigned long long)clock64(); \
        ts_lo = (lane == nts) ? (int)(unsigned)_c : ts_lo; ts_hi = (lane == nts) ? (int)(unsigned)(_c >> 32) : ts_hi; ++nts; } } while (0)
    PG8_STAMP();
    unsigned voffA[2], voffB[2];
#pragma unroll
    for (int i = 0; i < 2; ++i) { int R, C; stage_rc(tid * 16 + i * 8192, R, C); const int Rb = Epi::PERM ? ((R & ~31) + perm32(R & 31)) : R;
        voffA[i] = (unsigned)(R * K + C) * 2u; voffB[i] = (unsigned)(Rb * K + C) * 2u; }
    const size_t kstep = (size_t)(BK * 2);
    const size_t hstep = (size_t)HALF * K * 2;
    const size_t tstep = 2 * hstep;
    const unsigned ldsw = (unsigned)wid * 1024u;
    const int aoff = lds_byte(wr * 64 + fr, fq * 8), boff = lds_byte(wc * 32 + fr, fq * 8);
#define PG8_SA(b, h) (((b) * 2 + (h)) * HTB)
#define PG8_SB(b, h) ((4 + (b) * 2 + (h)) * HTB)
#define PG8_STAGE(bufoff, gbase, voff) do { _Pragma("unroll") for (int _i = 0; _i < 2; ++_i) \
        __builtin_amdgcn_global_load_lds((const unsigned*)((const char*)(gbase) + (voff)[_i]), (PG8_LAS unsigned*)(lds + (bufoff) + ldsw + _i * 8192), 16, 0, 0); } while (0)
#define PG8_LDA(dst, b, h) do { _Pragma("unroll") for (int m = 0; m < 4; ++m) _Pragma("unroll") for (int k = 0; k < 2; ++k) dst[m][k] = *(const PG8_LAS bf16x8*)(lds + PG8_SA(b, h) + aoff + m * 2048 + k * 1024); } while (0)
#define PG8_LDB(dst, b, h) do { _Pragma("unroll") for (int n = 0; n < 2; ++n) _Pragma("unroll") for (int k = 0; k < 2; ++k) dst[n][k] = *(const PG8_LAS bf16x8*)(lds + PG8_SB(b, h) + boff + n * 2048 + k * 1024); } while (0)
#define PG8_MMA(ai, bj, At, Bt) do { __builtin_amdgcn_s_setprio(1); _Pragma("unroll") for (int m = 0; m < 4; ++m) _Pragma("unroll") for (int n = 0; n < 2; ++n) _Pragma("unroll") for (int k = 0; k < 2; ++k) \
        acc[ai][bj][m][n] = __builtin_amdgcn_mfma_f32_16x16x32_bf16(Bt[n][k], At[m][k], acc[ai][bj][m][n], 0, 0, 0); __builtin_amdgcn_s_setprio(0); } while (0)
#define PG8_WAIT_V(n) asm volatile("s_waitcnt vmcnt(" #n ")" ::: "memory")
#define PG8_WAIT_L(n) asm volatile("s_waitcnt lgkmcnt(" #n ")" ::: "memory")
#define PG8_BAR __builtin_amdgcn_s_barrier()
#define PG8_SCHED __builtin_amdgcn_sched_barrier(0)
    Unit cur, nxt; int ui = 0;
    if (!S.next(0, cur)) return;
    f32x4 acc[2][2][4][2];
    bf16x8 At[4][2], B0[2][2], B1[2][2];
    const char* cA = (const char*)g.A + (size_t)cur.pm * tstep + cur.kb; const char* cB = (const char*)g.Bt + (size_t)cur.pn * tstep + cur.kb;
    S.a_ready(cur);
    E.init(acc, cur, wr, wc, fr, fq);
    PG8_STAGE(PG8_SB(0, 0), cB, voffB); PG8_STAGE(PG8_SA(0, 0), cA, voffA); PG8_STAGE(PG8_SB(0, 1), cB + hstep, voffB); PG8_STAGE(PG8_SA(0, 1), cA + hstep, voffA);
    if (wr == 1) PG8_BAR;
    PG8_WAIT_V(4); PG8_BAR;
    PG8_STAGE(PG8_SB(1, 0), cB + kstep, voffB); PG8_STAGE(PG8_SA(1, 0), cA + kstep, voffA); PG8_STAGE(PG8_SB(1, 1), cB + hstep + kstep, voffB);
    PG8_WAIT_V(6); PG8_BAR;
    PG8_STAMP();
    for (;;) {
        const bool has_next = S.next(ui + 1, nxt);
        const char* nA = has_next ? (const char*)g.A + (size_t)nxt.pm * tstep + nxt.kb : cA; const char* nB = has_next ? (const char*)g.Bt + (size_t)nxt.pn * tstep + nxt.kb : cB;
        const int unt = cur.nt > 0 ? cur.nt : nt;
        for (int t = 0; t < unt; t += 2) {
            const bool last = (t == unt - 2);
            const char* a1 = cA + (size_t)(t + 1) * kstep;
            const char* a2 = last ? nA : cA + (size_t)(t + 2) * kstep; const char* b2 = last ? nB : cB + (size_t)(t + 2) * kstep;
            const char* a3 = a2 + kstep; const char* b3 = b2 + kstep;
            if (last && has_next) S.a_ready(nxt);
            PG8_LDB(B0, 0, 0); PG8_SCHED; PG8_LDA(At, 0, 0); PG8_STAGE(PG8_SA(1, 1), a1 + hstep, voffA);
            PG8_WAIT_L(8); PG8_BAR; PG8_WAIT_L(0); PG8_MMA(0, 0, At, B0); PG8_BAR; PG8_SCHED;
            PG8_LDB(B1, 0, 1); PG8_STAGE(PG8_SB(0, 0), b2, voffB);
            PG8_BAR; PG8_WAIT_L(0); PG8_MMA(0, 1, At, B1); PG8_BAR;
            PG8_LDA(At, 0, 1); PG8_STAGE(PG8_SA(0, 0), a2, voffA);
            PG8_BAR; PG8_WAIT_L(0); PG8_MMA(1, 0, At, B0); PG8_BAR; PG8_SCHED;
            PG8_STAGE(PG8_SB(0, 1), b2 + hstep, voffB);
            PG8_WAIT_V(6); PG8_BAR; PG8_MMA(1, 1, At, B1); PG8_BAR;
            PG8_LDB(B0, 1, 0); PG8_SCHED; PG8_LDA(At, 1, 0); PG8_STAGE(PG8_SA(0, 1), a2 + hstep, voffA);
            PG8_WAIT_L(8); PG8_BAR; PG8_WAIT_L(0); PG8_MMA(0, 0, At, B0); PG8_BAR; PG8_SCHED;
            PG8_LDB(B1, 1, 1); PG8_STAGE(PG8_SB(1, 0), b3, voffB);
            PG8_BAR; PG8_WAIT_L(0); PG8_MMA(0, 1, At, B1); PG8_BAR;
            PG8_LDA(At, 1, 1); PG8_STAGE(PG8_SA(1, 0), a3, voffA);
            PG8_BAR; PG8_WAIT_L(0); PG8_MMA(1, 0, At, B0); PG8_BAR; PG8_SCHED;
            PG8_STAGE(PG8_SB(1, 1), b3 + hstep, voffB);
            PG8_WAIT_V(6); PG8_BAR; PG8_MMA(1, 1, At, B1); PG8_BAR;
        }
        PG8_STAMP();
        if constexpr (!Epi::AFTER_DRAIN) { E(acc, cur, wr, wc, fr, fq); S.done(cur); }
        PG8_STAMP();
        if (!has_next) break;
    E.init(acc, nxt, wr, wc, fr, fq);
        cur = nxt; cA = nA; cB = nB; ++ui;
    }
    PG8_WAIT_V(0);
    if (wr == 0) PG8_BAR;
    PG8_BAR;
    if constexpr (Epi::AFTER_DRAIN) { E.fused(acc, cur, wr, wc, fr, fq, lds, wid, lane); S.done(cur); }
    PG8_STAMP();
    if (STAMP && wid == 0) { stamps[lane] = lane < nts ? (((unsigned long long)(unsigned)ts_hi << 32) | (unsigned)ts_lo) : 0ull;
        if (lane == 62) stamps[62] = rt_entry; if (lane == 63) stamps[63] = (unsigned long long)wall_clock64(); }
#undef PG8_STAMP
#undef PG8_SA
#undef PG8_SB
#undef PG8_STAGE
#undef PG8_LDA
#undef PG8_LDB
#undef PG8_MMA
#undef PG8_WAIT_V
#undef PG8_WAIT_L
#undef PG8_BAR
#undef PG8_SCHED
}
}
using pg8::bf16_t; using pg8::bf16x8; using pg8::f32x4; using pg8::u32x4; using pg8::cvt_pk_bf16;
typedef unsigned u32x2 __attribute__((ext_vector_type(2)));
typedef float f32x2v __attribute__((ext_vector_type(2)));

constexpr int MT = 16896, MP = 16384;
constexpr size_t OFF_PROJ = 0;
constexpr size_t OFF_MIXED = 86507520;
constexpr size_t OFF_RW = 121110528;
constexpr size_t RWSZ = (size_t)MT * 256;
constexpr size_t OFF_Y = 224919552;
constexpr size_t OFF_UPT = OFF_Y, OFF_DOWNT = OFF_Y + 8388608;
constexpr size_t OFF_WINT = 242221056;
constexpr size_t OFF_WOUTT = 247463936;
constexpr size_t OFF_HST = 249561088;
constexpr size_t OFF_HD = 257949696;
constexpr size_t OFF_S5E = 258080768;
constexpr size_t OFF_C12 = 260177920;
constexpr size_t OFF_S5C = 261259264;
constexpr size_t OFF_CMT = OFF_S5C + 147456;
constexpr size_t OFF_GLUT = OFF_CMT + 65536;
constexpr size_t OFF_W2T = OFF_GLUT + 131072;
constexpr size_t OFF_A2T = OFF_W2T + 32768;
constexpr size_t OFF_G2T = OFF_A2T + 32768;
constexpr size_t OFF_PWT = OFF_G2T + 65536;
constexpr size_t OFF_LB = OFF_PWT + 32768;
constexpr size_t OFF_CTR = OFF_LB + 1024;
constexpr size_t OFF_HIDDEN = 0;
constexpr size_t OFF_XN2 = 138412032;
constexpr size_t OFF_BBT = OFF_CTR + 256;
constexpr size_t OFF_RSQ1 = OFF_BBT + 131072;
constexpr size_t OFF_RSQ2 = OFF_RSQ1 + 67584;
constexpr size_t OFF_HB1 = 173015040;
constexpr size_t CSTRIDE = 1048576;
constexpr size_t OFF_PART = 207618048;
constexpr size_t WS_END = OFF_RSQ2 + 67584;
constexpr size_t O_PSRE = 17301504, O_PSIM = O_PSRE + 16384, O_PHG = O_PSIM + 16384, O_PWKV = O_PHG + 262144, O_PSH = O_PWKV + 262144, O_PPOOL = O_PSH + 16384,
    O_SSRE = O_PPOOL + 61440, O_SSIM = O_SSRE + 262144, O_SHG = O_SSIM + 262144, O_SWKV = O_SHG + 4194304, O_SSH = O_SWKV + 4194304, O_SPOOL = O_SSH + 262144;
constexpr int LDS_BYTES = 147456;
constexpr int LDS_TASK_OFF = 146432;

struct Params { const float* in[40]; float* out; unsigned char* ws; };
#define AS4 __attribute__((address_space(4)))
struct KP { const AS4 char* k;
    __device__ __forceinline__ const float* in(int i) const { return *(const float* const AS4*)(k + 8 * i); }
    __device__ __forceinline__ float* out() const { return *(float* const AS4*)(k + 320); }
    __device__ __forceinline__ unsigned char* ws() const { return *(unsigned char* const AS4*)(k + 328); } };
__device__ __forceinline__ KP get_kp() { int z = 0; asm volatile("" : "+s"(z)); z = __builtin_amdgcn_readfirstlane(z); KP p; p.k = (const AS4 char*)__builtin_amdgcn_kernarg_segment_ptr() + z; return p; }

__device__ __forceinline__ float bf2f(bf16_t v) { return __uint_as_float(((unsigned)v) << 16); }
__device__ __forceinline__ float bflo(unsigned w) { return __uint_as_float(w << 16); }
__device__ __forceinline__ float bfhi(unsigned w) { return __uint_as_float(w & 0xffff0000u); }
__device__ __forceinline__ bf16_t f2bf(float f) { return (bf16_t)(cvt_pk_bf16(f, 0.f) & 0xffffu); }
__device__ __forceinline__ void unpack8(const u32x4 v, float* o) { o[0] = bflo(v.x); o[1] = bfhi(v.x); o[2] = bflo(v.y); o[3] = bfhi(v.y); o[4] = bflo(v.z); o[5] = bfhi(v.z); o[6] = bflo(v.w); o[7] = bfhi(v.w); }
__device__ __forceinline__ void unpack4(const u32x2 v, float* o) { o[0] = bflo(v.x); o[1] = bfhi(v.x); o[2] = bflo(v.y); o[3] = bfhi(v.y); }
__device__ __forceinline__ u32x2 pack4(const float* o) { u32x2 r; r.x = cvt_pk_bf16(o[0], o[1]); r.y = cvt_pk_bf16(o[2], o[3]); return r; }
__device__ __forceinline__ float sigm(float x) { return __builtin_amdgcn_rcpf(1.f + __expf(-x)); }
__device__ __forceinline__ float tanh_(float x) { return 1.f - 2.f * __builtin_amdgcn_rcpf(1.f + __expf(2.f * x)); }
__device__ __forceinline__ float gelu_t(float x) { return 0.5f * x * (1.f + tanh_(0.7978845608f * (x + 0.044715f * x * x * x))); }
__device__ __forceinline__ float shx(float v, int lane, int m) { return __int_as_float(__builtin_amdgcn_ds_bpermute((lane ^ m) << 2, __float_as_int(v))); }
__device__ __forceinline__ float wave_sum(float v, int lane) {
#pragma unroll
    for (int o = 1; o < 64; o <<= 1) v += shx(v, lane, o);
    return v; }
__device__ __forceinline__ void row_info(int r, int& b, int& t, bool& pr) { pr = r < MP; if (pr) { b = r >> 11; t = r & 2047; } else { b = (r - MP) >> 2; t = (r - MP) & 3; } }
#define MFMA16(a, b, c) __builtin_amdgcn_mfma_f32_16x16x32_bf16((a), (b), (c), 0, 0, 0)
#define LDSWAIT() asm volatile("s_waitcnt lgkmcnt(0)" ::: "memory")

__device__ __forceinline__ void transpose_item(const float* W, int K, int N, bf16_t* WT, float* scr, int item, int lane, const float* gk) {
    const int nblk = N >> 5, kb = item / nblk, nb = item - kb * nblk, k0 = kb << 6, n0 = nb << 5;
    float tv[32];
#pragma unroll
    for (int i = 0; i < 32; ++i) { const int kk = 2 * i + (lane >> 5); tv[i] = W[(size_t)(k0 + kk) * N + n0 + (lane & 31)]; }
    if (gk) {
#pragma unroll
        for (int i = 0; i < 32; ++i) tv[i] *= gk[k0 + 2 * i + (lane >> 5)]; }
#pragma unroll
    for (int i = 0; i < 32; ++i) { const int kk = 2 * i + (lane >> 5); scr[kk * 33 + (lane & 31)] = tv[i]; }
    LDSWAIT();
    const int c = lane & 7;
#pragma unroll
    for (int j = 0; j < 4; ++j) { const int n = (lane >> 3) + 8 * j; const float* s = scr + (8 * c) * 33 + n;
        u32x4 o; o.x = cvt_pk_bf16(s[0], s[33]); o.y = cvt_pk_bf16(s[66], s[99]); o.z = cvt_pk_bf16(s[132], s[165]); o.w = cvt_pk_bf16(s[198], s[231]);
        *(u32x4*)(WT + (size_t)(n0 + n) * K + k0 + 8 * c) = o; }
    LDSWAIT();
}
__device__ __forceinline__ void norm_rows(const KP& P, int l, int which) {
    const int tid = otid(), lane = tid & 63, wave = tid >> 6, gw = blockIdx.x * 8 + wave, NGW = gridDim.x * 8;
    const bool all = (which == 2) || (which == 0 && l == 0);
    const int nsplit = which == 1 ? 4 : ((which == 0 && l == 0) ? 0 : 8);
    const int rlo = all ? 0 : MP;
    bf16_t* HB = (bf16_t*)(P.ws() + (which == 0 ? OFF_HB1 : OFF_XN2));
    float* RSQ = (float*)(P.ws() + (which == 0 ? OFF_RSQ1 : OFF_RSQ2));
    f32x4 gg[4];
#pragma unroll
    for (int j = 0; j < 4; ++j) gg[j] = ((const f32x4*)P.in(39))[lane + 64 * j];
#pragma unroll 1
    for (int rb = rlo + gw; rb < MT; rb += 4 * NGW) {
        f32x4 v[4][4];
#pragma unroll
        for (int q = 0; q < 4; ++q) { const int r = rb + q * NGW;
            if (r < MT) { const float* src = P.out() + (size_t)r * 1024;
                if (l == 0 && which != 2 && !(which == 1 && false)) { if (which == 0 || which == 1) src = (r < MP) ? P.in(0) + (size_t)r * 1024 : P.in(1) + (size_t)(r - MP) * 1024; }
#pragma unroll
                for (int j = 0; j < 4; ++j) v[q][j] = ((const f32x4*)src)[lane + 64 * j];
                if (nsplit > 0 && r >= MP) { const float* pp = (const float*)(P.ws() + OFF_PART) + (size_t)(r - MP) * 1024;
#pragma unroll 1
                    for (int k0 = 0; k0 < nsplit; k0 += 4) { f32x4 pv[4][4];
#pragma unroll
                        for (int ks = 0; ks < 4; ++ks)
#pragma unroll
                            for (int j = 0; j < 4; ++j) pv[ks][j] = ((const f32x4*)(pp + (size_t)(k0 + ks) * 512 * 1024))[lane + 64 * j];
#pragma unroll
                        for (int ks = 0; ks < 4; ++ks)
#pragma unroll
                            for (int j = 0; j < 4; ++j) v[q][j] += pv[ks][j]; } } }
            else {
#pragma unroll
                for (int j = 0; j < 4; ++j) v[q][j] = (f32x4){0.f, 0.f, 0.f, 0.f}; } }
#pragma unroll
        for (int q = 0; q < 4; ++q) { const int r = rb + q * NGW; float s = 0.f;
#pragma unroll
            for (int j = 0; j < 4; ++j) s += v[q][j].x * v[q][j].x + v[q][j].y * v[q][j].y + v[q][j].z * v[q][j].z + v[q][j].w * v[q][j].w;
            s = wave_sum(s, lane);
            if (r < MT) { float* hrow = P.out() + (size_t)r * 1024;
                if (which == 2) { const float rstd = rsqrtf(s * (1.f / 1024.f) + 1e-6f);
#pragma unroll
                    for (int j = 0; j < 4; ++j) ((f32x4*)hrow)[lane + 64 * j] = v[q][j] * rstd * gg[j]; }
                else { if (lane == 0) RSQ[r] = s;
#pragma unroll
                    for (int j = 0; j < 4; ++j) { if (r >= MP && !(which == 0 && l == 0)) ((f32x4*)hrow)[lane + 64 * j] = v[q][j];
                        u32x2 w; w.x = cvt_pk_bf16(v[q][j].x, v[q][j].y); w.y = cvt_pk_bf16(v[q][j].z, v[q][j].w); *(u32x2*)(HB + (size_t)r * 1024 + (lane + 64 * j) * 4) = w; } } }
        }
    }
}
__device__ __forceinline__ void phaseA(const KP& P, int l0, unsigned char* smem) {
    const int l = l0;
    const int tid = otid(), lane = tid & 63, wave = tid >> 6, gw = blockIdx.x * 8 + wave, NGW = gridDim.x * 8;
#ifdef PROBE_SEL
    const unsigned long long a0_ = __builtin_amdgcn_s_memrealtime();
#endif
    norm_rows(P, l, 0);
#ifdef PROBE_SEL
    const unsigned long long a1_ = __builtin_amdgcn_s_memrealtime();
#endif
    float* scr = (float*)smem + wave * (64 * 33);
    if (l == 0) for (int it = gw; it < 1280; it += NGW) transpose_item(P.in(9), 1024, 2560, (bf16_t*)(P.ws() + OFF_WINT), scr, it, lane, P.in(8));
#ifdef PROBE_SEL
    const unsigned long long a2_ = __builtin_amdgcn_s_memrealtime();
#endif
    {
    const int gt = blockIdx.x * 512 + tid, NT = gridDim.x * 512;
    float* S5C = (float*)(P.ws() + OFF_S5C + l * CSTRIDE);
    for (int e = gt; e < 16384; e += NT) {
        const int idx = e >> 4, h = e & 15, g = idx >> 6, pp = idx & 63;
        const float lr = P.in(10)[l * 1024 + idx], li = P.in(11)[l * 1024 + idx], dt = expf(P.in(12)[l * 16 + g]);
        const float mag = expf(lr * dt); float sn, cs; sincosf(li * dt, &sn, &cs);
        const float abr = mag * cs, abi = mag * sn;
        if (h == 0) { const float magL = expf(64.f * lr * dt); float snL, csL; sincosf(64.f * li * dt, &snL, &csL);
            S5C[idx] = abr; S5C[1024 + idx] = abi; S5C[2048 + idx] = magL * csL; S5C[3072 + idx] = magL * snL; }
        const float den = lr * lr + li * li, zr = abr - 1.f, zi = abi;
        const float cr = (zr * lr + zi * li) / den, ci = (zi * lr - zr * li) / den;
        const float br = P.in(13)[((size_t)l * 1024 + idx) * 16 + h], bi = P.in(14)[((size_t)l * 1024 + idx) * 16 + h];
        bf16_t* BBT = (bf16_t*)(P.ws() + OFF_BBT + l * CSTRIDE);
        BBT[(g * 128 + pp) * 32 + h] = f2bf(cr * br - ci * bi); BBT[(g * 128 + 64 + pp) * 32 + h] = f2bf(cr * bi + ci * br); BBT[(g * 128 + pp) * 32 + 16 + h] = 0; BBT[(g * 128 + 64 + pp) * 32 + 16 + h] = 0;
    }
    bf16_t* CMT = (bf16_t*)(P.ws() + OFF_CMT + l * CSTRIDE);
    for (int idx = gt; idx < 32768; idx += NT) { const int gh = idx >> 7, pp = idx & 127;
        const float v = pp < 64 ? P.in(15)[((size_t)l * 256 + gh) * 64 + pp] : -P.in(16)[((size_t)l * 256 + gh) * 64 + pp - 64]; CMT[idx] = f2bf(v); }
    bf16_t* GLUT = (bf16_t*)(P.ws() + OFF_GLUT + l * CSTRIDE);
    for (int idx = gt; idx < 65536; idx += NT) { const int n = idx >> 8, k = idx & 255; GLUT[idx] = f2bf(P.in(18)[(size_t)l * 65536 + k * 256 + n]); }
    bf16_t* W2T = (bf16_t*)(P.ws() + OFF_W2T + l * CSTRIDE); bf16_t* A2T = (bf16_t*)(P.ws() + OFF_A2T + l * CSTRIDE); bf16_t* G2T = (bf16_t*)(P.ws() + OFF_G2T + l * CSTRIDE); bf16_t* PWT = (bf16_t*)(P.ws() + OFF_PWT + l * CSTRIDE);
    for (int idx = gt; idx < 16384; idx += NT) { const int c = idx >> 6, j = idx & 63;
        W2T[idx] = f2bf(P.in(24)[(size_t)l * 16384 + j * 256 + c]); A2T[idx] = f2bf(P.in(26)[(size_t)l * 16384 + j * 256 + c]);
        const int gi = idx >> 12, d = (idx >> 6) & 63, cc = idx & 63; PWT[idx] = f2bf(P.in(33)[(size_t)l * 16384 + gi * 4096 + cc * 64 + d]); }
    for (int idx = gt; idx < 32768; idx += NT) { const int c = idx >> 7, j = idx & 127; G2T[idx] = f2bf(P.in(27)[(size_t)l * 32768 + j * 256 + c]); }
    float* LB = (float*)(P.ws() + OFF_LB + l * CSTRIDE);
    for (int idx = gt; idx < 256; idx += NT) LB[idx] = (l == 0) ? 0.f : sigm(P.in(20)[256 + idx] - P.in(20)[idx]);
    }
#ifdef PROBE_SEL
    if (l == 0 && tid == 0 && (blockIdx.x == 0 || blockIdx.x == 100)) { float* sl = (float*)(P.ws() + OFF_CTR) + (blockIdx.x == 0 ? 56 : 60); const unsigned long long a3_ = __builtin_amdgcn_s_memrealtime();
        sl[0] = (float)(a1_ - a0_) * 0.01f; sl[1] = (float)(a2_ - a1_) * 0.01f; sl[2] = (float)(a3_ - a2_) * 0.01f; }
#endif
    if (blockIdx.x == 0 && tid == 0) { ((unsigned*)(P.ws() + OFF_CTR))[l] = 0u; ((unsigned*)(P.ws() + OFF_CTR))[2 + l] = 0u; }
}
__device__ __forceinline__ void phaseG(const KP& P, int l, unsigned char* smem) { norm_rows(P, l, 1); }

template <int MTW  > __device__ __forceinline__ void rwkv_prep_tile(const KP& P, int l, unsigned char* smem, int tile) {
    const int tid = otid(), lane = tid & 63, wave = tid >> 6, fr = lane & 15, fq = lane >> 4;
    const int r0 = tile * (32 * MTW);
    const bf16_t* PROJ = (const bf16_t*)(P.ws() + OFF_PROJ);
    bf16_t* MIXED = (bf16_t*)(P.ws() + OFF_MIXED);
    bf16_t* Aop = (bf16_t*)smem;
    const float* mu = P.in(22) + l * 1024;
    const float* shs = P.in(6) + (size_t)l * 128 * 1024;
    __syncthreads();
#pragma unroll 2
    for (int i = 0; i < 2 * MTW; ++i) {
        const int item = tid + 512 * i, tok = item >> 5, j0 = (item & 31) * 8, r = r0 + tok;
        int b, t; bool pr; row_info(r, b, t, pr);
        float p[8], q[8], o[8];
        unpack8(*(const u32x4*)(PROJ + (size_t)r * 2560 + 2048 + j0), p);
        if (t > 0) unpack8(*(const u32x4*)(PROJ + (size_t)(r - 1) * 2560 + 2048 + j0), q);
        else if (!pr) { const float* s = shs + (size_t)b * 1024 + 768 + j0;
#pragma unroll
            for (int e = 0; e < 8; ++e) q[e] = s[e]; }
        else {
#pragma unroll
            for (int e = 0; e < 8; ++e) q[e] = 0.f; }
#pragma unroll
        for (int e = 0; e < 8; ++e) { const float xs = p[e] + (q[e] - p[e]) * mu[768 + j0 + e]; o[e] = j0 < 64 ? tanh_(xs) : (j0 < 128 ? xs : sigm(xs)); }
        u32x4 w; w.x = cvt_pk_bf16(o[0], o[1]); w.y = cvt_pk_bf16(o[2], o[3]); w.z = cvt_pk_bf16(o[4], o[5]); w.w = cvt_pk_bf16(o[6], o[7]);
        *(u32x4*)(Aop + tok * 264 + j0) = w;
    }
    bf16_t* XS = (bf16_t*)(smem + 34816);
#pragma unroll 2
    for (int i = 0; i < 6 * MTW; ++i) {
        const int item = tid + 512 * i, tok = item / 96, j0 = (item - tok * 96) * 8, r = r0 + tok;
        int b, t; bool pr; row_info(r, b, t, pr);
        float p[8], q[8], o[8];
        unpack8(*(const u32x4*)(PROJ + (size_t)r * 2560 + 1280 + j0), p);
        if (t > 0) unpack8(*(const u32x4*)(PROJ + (size_t)(r - 1) * 2560 + 1280 + j0), q);
        else if (!pr) { const float* sp = shs + (size_t)b * 1024 + j0;
#pragma unroll
            for (int e = 0; e < 8; ++e) q[e] = sp[e]; }
        else {
#pragma unroll
            for (int e = 0; e < 8; ++e) q[e] = 0.f; }
#pragma unroll
        for (int e = 0; e < 8; ++e) o[e] = p[e] + (q[e] - p[e]) * mu[j0 + e];
        u32x4 w; w.x = cvt_pk_bf16(o[0], o[1]); w.y = cvt_pk_bf16(o[2], o[3]); w.z = cvt_pk_bf16(o[4], o[5]); w.w = cvt_pk_bf16(o[6], o[7]);
        *(u32x4*)(XS + tok * 776 + j0) = w;
    }
#pragma unroll 1
    for (int tok = 0; tok < 32 * MTW; ++tok) { const int r = r0 + tok; int b, t; bool pr; row_info(r, b, t, pr);
        if (pr ? (t == 2047) : (t == 3)) { float* dst = P.out() + (pr ? O_PSH + (size_t)(l * 8 + b) * 1024 : O_SSH + (size_t)(l * 128 + b) * 1024);
            for (int idx = tid; idx < 1024; idx += 512) dst[idx] = bf2f(PROJ[(size_t)r * 2560 + 1280 + idx]); } }
    __syncthreads();
    const int hd = wave & 3, th = wave >> 2;
    const bf16_t* W2T = (const bf16_t*)(P.ws() + OFF_W2T + l * CSTRIDE); const bf16_t* A2T = (const bf16_t*)(P.ws() + OFF_A2T + l * CSTRIDE); const bf16_t* G2T = (const bf16_t*)(P.ws() + OFF_G2T + l * CSTRIDE);
    f32x4 accw[4][MTW], acca[4][MTW], accg[4][MTW];
#pragma unroll
    for (int nt = 0; nt < 4; ++nt)
#pragma unroll
        for (int mt = 0; mt < MTW; ++mt) { accw[nt][mt] = (f32x4){0.f, 0.f, 0.f, 0.f}; acca[nt][mt] = accw[nt][mt]; accg[nt][mt] = accw[nt][mt]; }
#pragma unroll
    for (int nt = 0; nt < 4; ++nt) { const int n = hd * 64 + nt * 16 + fr;
#pragma unroll
        for (int ks = 0; ks < 2; ++ks) {
            const bf16x8 wf = *(const bf16x8*)(W2T + n * 64 + ks * 32 + fq * 8), af = *(const bf16x8*)(A2T + n * 64 + ks * 32 + fq * 8);
#pragma unroll
            for (int mt = 0; mt < MTW; ++mt) { const bf16_t* xr = Aop + (th * 16 * MTW + mt * 16 + fr) * 264 + ks * 32 + fq * 8;
                accw[nt][mt] = MFMA16(wf, *(const bf16x8*)xr, accw[nt][mt]); acca[nt][mt] = MFMA16(af, *(const bf16x8*)(xr + 64), acca[nt][mt]); } }
#pragma unroll
        for (int ks = 0; ks < 4; ++ks) { const bf16x8 gf = *(const bf16x8*)(G2T + n * 128 + ks * 32 + fq * 8);
#pragma unroll
            for (int mt = 0; mt < MTW; ++mt) accg[nt][mt] = MFMA16(gf, *(const bf16x8*)(Aop + (th * 16 * MTW + mt * 16 + fr) * 264 + 128 + ks * 32 + fq * 8), accg[nt][mt]); } }
    float* RW = (float*)(P.ws() + OFF_RW);
    float* C12 = (float*)(P.ws() + OFF_C12);
    const float* w0 = P.in(23) + l * 256; const float* a0 = P.in(25) + l * 256; const float* kkw = P.in(28) + l * 256; const float* kaw = P.in(29) + l * 256; const float* rkw = P.in(30) + l * 256;
#pragma unroll
    for (int mt = 0; mt < MTW; ++mt) {
        const int r = r0 + th * 16 * MTW + mt * 16 + fr; int b, t; bool pr; row_info(r, b, t, pr);
        float kkr[4][4], av[4][4], xrr[4][4]; float ss = 0.f, bs = 0.f, c2 = 0.f;
#pragma unroll
        for (int nt = 0; nt < 4; ++nt) {
            const int c0 = hd * 64 + nt * 16 + fq * 4;
            float xr4[4], xk4[4], xv4[4];
            { const bf16_t* xrow = XS + (th * 16 * MTW + mt * 16 + fr) * 776 + c0; unpack4(*(const u32x2*)(xrow), xr4); unpack4(*(const u32x2*)(xrow + 256), xk4); unpack4(*(const u32x2*)(xrow + 512), xv4); }
            f32x4 owr, ow, ok, ov; float gg[4];
#pragma unroll
            for (int j = 0; j < 4; ++j) { const int c = c0 + j;
                const float xr = xr4[j], xk = xk4[j], xv = xv4[j];
                const float wp = w0[c] + accw[nt][mt][j];
                const float nx = -wp;
                const float sp = fmaxf(nx, 0.f) + __logf(1.f + __expf(-fabsf(nx)));
                const float wv = -sp - 0.5f;
                const float dec = __expf(-__expf(wv));
                const float a = sigm(a0[c] + acca[nt][mt][j]);
                const float kr = xk * kkw[c]; ss += kr * kr;
                const float k = xk * (1.f + (a - 1.f) * kaw[c]);
                bs += xr * k * rkw[c]; c2 += xr * k;
                kkr[nt][j] = kr; av[nt][j] = a; xrr[nt][j] = xr;
                owr[j] = dec * xr; ow[j] = dec; ok[j] = k; ov[j] = xv; gg[j] = accg[nt][mt][j]; }
            const size_t o = (size_t)r * 256 + c0;
            *(f32x4*)(RW + 1 * RWSZ + o) = owr; *(f32x4*)(RW + 2 * RWSZ + o) = ow; *(f32x4*)(RW + 4 * RWSZ + o) = ok; *(f32x4*)(RW + 5 * RWSZ + o) = ov;
            *(u32x2*)(MIXED + (size_t)r * 1024 + 512 + c0) = pack4(gg);
        }
        ss += shx(ss, lane, 16); ss += shx(ss, lane, 32); bs += shx(bs, lane, 16); bs += shx(bs, lane, 32); c2 += shx(c2, lane, 16); c2 += shx(c2, lane, 32);
        const float inv = __builtin_amdgcn_rsqf(fmaxf(ss, 1e-24f)); float c1 = 0.f;
#pragma unroll
        for (int nt = 0; nt < 4; ++nt) { const int c0 = hd * 64 + nt * 16 + fq * 4; f32x4 okk, okka;
#pragma unroll
            for (int j = 0; j < 4; ++j) { const float kk = kkr[nt][j] * inv, kka = kk * av[nt][j]; okk[j] = kk; okka[j] = kka; c1 += kka * xrr[nt][j]; }
            const size_t o = (size_t)r * 256 + c0; *(f32x4*)(RW + 0 * RWSZ + o) = okk; *(f32x4*)(RW + 3 * RWSZ + o) = okka; }
        c1 += shx(c1, lane, 16); c1 += shx(c1, lane, 32);
        if (fq == 0) *(f32x4*)(C12 + (size_t)r * 16 + hd * 4) = (f32x4){c1, c2, bs, 0.f};
    }
}

__device__ __forceinline__ void pool_tile(const KP& P, int l, unsigned char* smem, int tile) {
    const int tid = otid(), lane = tid & 63, wave = tid >> 6, fr = lane & 15, fq = lane >> 4;
    const int r0 = tile * 64;
    const bf16_t* PROJ = (const bf16_t*)(P.ws() + OFF_PROJ);
    bf16_t* MIXED = (bf16_t*)(P.ws() + OFF_MIXED);
    bf16_t* Pop = (bf16_t*)smem;
    const float* pst = P.in(7) + (size_t)l * 128 * 15 * 256;
    __syncthreads();
#pragma unroll 2
    for (int i = 0; i < 4; ++i) {
        const int item = tid + 512 * i, tok = item >> 5, ch0 = (item & 31) * 8, r = r0 + tok, win = 2 << (ch0 >> 6);
        int b, t; bool pr; row_info(r, b, t, pr);
        float s[8], u[8];
#pragma unroll
        for (int e = 0; e < 8; ++e) { s[e] = 0.f; u[e] = 0.f; }
        if (pr) {
            u32x4 xv[16];
#pragma unroll
            for (int j = 0; j < 16; ++j) { xv[j] = (u32x4){0u, 0u, 0u, 0u}; if (j < win && t - j >= 0) xv[j] = *(const u32x4*)(PROJ + (size_t)(r - j) * 2560 + 2304 + ch0); }
#pragma unroll
            for (int j = 0; j < 16; ++j) { float x[8]; unpack8(xv[j], x);
#pragma unroll
                for (int e = 0; e < 8; ++e) { s[e] += x[e]; if (j == 0) u[e] = x[e]; } }
        } else {
            for (int j = 0; j < win; ++j) { const int tt = t - j; float x[8];
                if (tt >= 0) unpack8(*(const u32x4*)(PROJ + (size_t)(r - j) * 2560 + 2304 + ch0), x);
                else { const float* bp = pst + ((size_t)b * 15 + 15 + tt) * 256 + ch0;
#pragma unroll
                    for (int e = 0; e < 8; ++e) x[e] = bp[e]; }
                if (j == 0) {
#pragma unroll
                    for (int e = 0; e < 8; ++e) u[e] = x[e]; }
#pragma unroll
                for (int e = 0; e < 8; ++e) s[e] += x[e]; }
        }
        const float cnt = pr ? (float)min(t + 1, win) : (float)win, ic = 1.f / cnt; float o[8];
#pragma unroll
        for (int e = 0; e < 8; ++e) o[e] = s[e] * ic - u[e];
        u32x4 w; w.x = cvt_pk_bf16(o[0], o[1]); w.y = cvt_pk_bf16(o[2], o[3]); w.z = cvt_pk_bf16(o[4], o[5]); w.w = cvt_pk_bf16(o[6], o[7]);
        *(u32x4*)(Pop + tok * 264 + ch0) = w;
    }
    if (r0 < MP) { if ((r0 & 2047) == 1984) { const int b = r0 >> 11; float* dst = P.out() + O_PPOOL + (size_t)(l * 8 + b) * 3840;
            for (int idx = tid; idx < 3840; idx += 512) { const int j = idx >> 8, ch = idx & 255; dst[idx] = bf2f(PROJ[(size_t)(b * 2048 + 2033 + j) * 2560 + 2304 + ch]); } } }
    else { const int b0 = (r0 - MP) >> 2;
        for (int idx = tid; idx < 16 * 3840; idx += 512) { const int bb = idx / 3840, rem = idx - bb * 3840, j = rem >> 8, ch = rem & 255, b = b0 + bb;
            const float v = j < 11 ? pst[((size_t)b * 15 + j + 4) * 256 + ch] : bf2f(PROJ[(size_t)(MP + b * 4 + j - 11) * 2560 + 2304 + ch]);
            P.out()[O_SPOOL + (size_t)(l * 128 + b) * 3840 + rem] = v; } }
    __syncthreads();
    const bf16_t* PWT = (const bf16_t*)(P.ws() + OFF_PWT + l * CSTRIDE);
    const float* scale = P.in(34) + l * 256;
    f32x4 acc[2][4];
#pragma unroll
    for (int nt = 0; nt < 2; ++nt)
#pragma unroll
        for (int mt = 0; mt < 4; ++mt) acc[nt][mt] = (f32x4){0.f, 0.f, 0.f, 0.f};
#pragma unroll
    for (int nt = 0; nt < 2; ++nt) { const int n0 = wave * 32 + nt * 16, gi = n0 >> 6;
#pragma unroll
        for (int ks = 0; ks < 2; ++ks) { const bf16x8 wf = *(const bf16x8*)(PWT + (n0 + fr) * 64 + ks * 32 + fq * 8);
#pragma unroll
            for (int mt = 0; mt < 4; ++mt) acc[nt][mt] = MFMA16(wf, *(const bf16x8*)(Pop + (mt * 16 + fr) * 264 + gi * 64 + ks * 32 + fq * 8), acc[nt][mt]); } }
#pragma unroll
    for (int nt = 0; nt < 2; ++nt)
#pragma unroll
        for (int mt = 0; mt < 4; ++mt) { const int r = r0 + mt * 16 + fr, ch = wave * 32 + nt * 16 + fq * 4; float o[4];
#pragma unroll
            for (int j = 0; j < 4; ++j) o[j] = acc[nt][mt][j] * scale[ch + j];
            *(u32x2*)(MIXED + (size_t)r * 1024 + 768 + ch) = pack4(o); }
}

__device__ __forceinline__ void s5_task(const KP& P, int l, unsigned char* smem, int mode, int tile) {
    const int tid = otid(), lane = tid & 63, wave = tid >> 6, fr = lane & 15, fq = lane >> 4;
    const bool prompt = tile < 256;
    const int b = tile >> 5, c = tile & 31, st8 = tile - 256;
    const int r0 = prompt ? b * 2048 + c * 64 : MP + st8 * 64, b0 = st8 * 16;
    const bf16_t* PROJ = (const bf16_t*)(P.ws() + OFF_PROJ);
    bf16_t* MIXED = (bf16_t*)(P.ws() + OFF_MIXED);
    bf16_t* U = (bf16_t*)smem;
    bf16_t* Zb = (bf16_t*)(smem + 32768);
    float* BU = (float*)(smem + 32768 + 33792 + wave * 8448);
    __syncthreads();
#pragma unroll
    for (int i = 0; i < 4; ++i) { const int item = tid + 512 * i, tok = item >> 5, j0 = (item & 31) * 8;
        *(u32x4*)(U + tok * 256 + j0) = *(const u32x4*)(PROJ + (size_t)(r0 + tok) * 2560 + j0); }
    __syncthreads();
    const float* S5C = (const float*)(P.ws() + OFF_S5C + l * CSTRIDE);
    const bf16_t* CMT = (const bf16_t*)(P.ws() + OFF_CMT + l * CSTRIDE);
    const bf16_t* BBT = (const bf16_t*)(P.ws() + OFF_BBT + l * CSTRIDE);
    float* S5E = (float*)(P.ws() + OFF_S5E);
    const float* dsk = P.in(17) + l * 256;
#pragma unroll 1
    for (int gg = 0; gg < 2; ++gg) {
        const int g = 2 * wave + gg, gp = g * 64 + lane;
        const float ar = S5C[gp], ai = S5C[1024 + gp];
        float hr = 0.f, hi = 0.f;
        if (prompt && mode == 1) { const float alr = S5C[2048 + gp], ali = S5C[3072 + gp];
#pragma unroll 1
            for (int j0 = 0; j0 < c; j0 += 8) { f32x2v e[8];
#pragma unroll
                for (int jj = 0; jj < 8; ++jj) e[jj] = (j0 + jj < c) ? *(const f32x2v*)(S5E + ((size_t)((b * 32 + j0 + jj) * 16 + g) * 64 + lane) * 2) : (f32x2v){0.f, 0.f};
#pragma unroll
                for (int jj = 0; jj < 8; ++jj) if (j0 + jj < c) { const float nr = alr * hr - ali * hi + e[jj].x, ni = alr * hi + ali * hr + e[jj].y; hr = nr; hi = ni; } } }
        bf16x8 bfr[8], cfr[4];
#pragma unroll
        for (int pt = 0; pt < 8; ++pt) bfr[pt] = *(const bf16x8*)(BBT + (g * 128 + pt * 16 + fr) * 32 + fq * 8);
        if (mode == 1) {
#pragma unroll
            for (int ks = 0; ks < 4; ++ks) cfr[ks] = *(const bf16x8*)(CMT + (g * 16 + fr) * 128 + ks * 32 + fq * 8); }
        const f32x4 dsk4 = *(const f32x4*)(dsk + g * 16 + fq * 4);
#pragma unroll 1
        for (int st = 0; st < 4; ++st) {
            { bf16x8 uf = (bf16x8){0, 0, 0, 0, 0, 0, 0, 0};
              if (fq < 2) uf = *(const bf16x8*)(U + (st * 16 + fr) * 256 + g * 16 + fq * 8);
#pragma unroll
              for (int pt = 0; pt < 8; ++pt) { const f32x4 d = MFMA16(bfr[pt], uf, ((f32x4){0.f, 0.f, 0.f, 0.f})); *(f32x4*)(BU + fr * 132 + pt * 16 + fq * 4) = d; } }
            if (prompt) {
                float bur = BU[lane], bui = BU[64 + lane];
#pragma unroll
                for (int tt = 0; tt < 16; ++tt) {
                    const float nbr = BU[((tt + 1) & 15) * 132 + lane], nbi = BU[((tt + 1) & 15) * 132 + 64 + lane];
                    const float nr = ar * hr - ai * hi + bur, ni = ar * hi + ai * hr + bui; hr = nr; hi = ni; bur = nbr; bui = nbi;
                    if (mode == 1) { bf16_t* hb = (bf16_t*)(BU + tt * 132); hb[lane] = f2bf(hr); hb[64 + lane] = f2bf(hi); } }
            } else {
#pragma unroll 4
                for (int tt = 0; tt < 16; ++tt) { const int t = st * 16 + tt;
                    if ((t & 3) == 0) { const size_t so = ((size_t)(l * 128 + b0 + (t >> 2)) * 16 + g) * 64 + lane; hr = P.in(2)[so]; hi = P.in(3)[so]; }
                    const float bur = BU[tt * 132 + lane], bui = BU[tt * 132 + 64 + lane];
                    const float nr = ar * hr - ai * hi + bur, ni = ar * hi + ai * hr + bui; hr = nr; hi = ni;
                    bf16_t* hb = (bf16_t*)(BU + tt * 132); hb[lane] = f2bf(hr); hb[64 + lane] = f2bf(hi);
                    if ((t & 3) == 3) { const size_t so = ((size_t)(l * 128 + b0 + (t >> 2)) * 16 + g) * 64 + lane; P.out()[O_SSRE + so] = hr; P.out()[O_SSIM + so] = hi; } }
            }
            if (mode == 1) {
                f32x4 acc = (f32x4){0.f, 0.f, 0.f, 0.f};
#pragma unroll
                for (int ks = 0; ks < 4; ++ks) acc = MFMA16(cfr[ks], *(const bf16x8*)((const bf16_t*)(BU + fr * 132) + ks * 32 + fq * 8), acc);
                const int t = st * 16 + fr, ch = g * 16 + fq * 4; float u4[4], z[4];
                unpack4(*(const u32x2*)(U + t * 256 + ch), u4);
#pragma unroll
                for (int j = 0; j < 4; ++j) z[j] = gelu_t(acc[j] + dsk4[j] * u4[j]);
                *(u32x2*)(Zb + t * 264 + ch) = pack4(z);
            }
        }
        if (prompt && mode == 1 && c == 31) { const size_t so = ((size_t)(l * 8 + b) * 16 + g) * 64 + lane; P.out()[O_PSRE + so] = hr; P.out()[O_PSIM + so] = hi; }
        if (mode == 0) *(f32x2v*)(S5E + ((size_t)((b * 32 + c) * 16 + g) * 64 + lane) * 2) = (f32x2v){hr, hi};
    }
    if (mode == 1) {
        __syncthreads();
        const bf16_t* GLUT = (const bf16_t*)(P.ws() + OFF_GLUT + l * CSTRIDE);
        const float* gb = P.in(19) + l * 256;
        f32x4 acc[2][4];
#pragma unroll
        for (int nt = 0; nt < 2; ++nt)
#pragma unroll
            for (int mt = 0; mt < 4; ++mt) acc[nt][mt] = (f32x4){0.f, 0.f, 0.f, 0.f};
#pragma unroll
        for (int ks = 0; ks < 8; ++ks)
#pragma unroll
            for (int nt = 0; nt < 2; ++nt) { const bf16x8 wf = *(const bf16x8*)(GLUT + (wave * 32 + nt * 16 + fr) * 256 + ks * 32 + fq * 8);
#pragma unroll
                for (int mt = 0; mt < 4; ++mt) acc[nt][mt] = MFMA16(wf, *(const bf16x8*)(Zb + (mt * 16 + fr) * 264 + ks * 32 + fq * 8), acc[nt][mt]); }
#pragma unroll
        for (int nt = 0; nt < 2; ++nt)
#pragma unroll
            for (int mt = 0; mt < 4; ++mt) { const int tok = mt * 16 + fr, ch = wave * 32 + nt * 16 + fq * 4; float z4[4], o[4];
                unpack4(*(const u32x2*)(Zb + tok * 264 + ch), z4);
#pragma unroll
                for (int j = 0; j < 4; ++j) o[j] = z4[j] * sigm(acc[nt][mt][j] + gb[ch + j]);
                *(u32x2*)(MIXED + (size_t)(r0 + tok) * 1024 + ch) = pack4(o); }
    }
}

__device__ __forceinline__ void hgrn_task(const KP& P, int l, unsigned char* smem, int mode, int b, int hd, int sc) {
    const int tid = otid(), lane = tid & 63, wave = tid >> 6, fr = lane & 15, fq = lane >> 4;
    const bf16_t* PROJ = (const bf16_t*)(P.ws() + OFF_PROJ);
    bf16_t* MIXED = (bf16_t*)(P.ws() + OFF_MIXED);
    bf16_t* Qp = (bf16_t*)smem;
    bf16_t* Kn = Qp + 32 * 72;
    bf16_t* Kdt = Kn + 32 * 72;
    bf16_t* Vt = Kdt + 64 * 40;
    bf16_t* Att = Vt + 64 * 40;
    bf16_t* St = Att + 32 * 40;
    float* TOT = (float*)(St + 64 * 72);
    float* EB = TOT + 512;
    float* HST = (float*)(P.ws() + OFF_HST); float* HD = (float*)(P.ws() + OFF_HD);
    const int k = tid & 63, sg = tid >> 6, kt = wave >> 1, vt0 = (wave & 1) * 2;
    const float lbv = ((const float*)(P.ws() + OFF_LB + l * CSTRIDE))[hd * 64 + k];
    f32x4 accS[2] = {(f32x4){0.f, 0.f, 0.f, 0.f}, (f32x4){0.f, 0.f, 0.f, 0.f}};
    if (mode == 1) {
#pragma unroll 1
        for (int j0 = 0; j0 < sc; j0 += 4) { float dd[4][4], xx[4][2][4];
#pragma unroll
            for (int u = 0; u < 4; ++u) { const size_t bi = (size_t)((b * 4 + hd) * 16 + min(j0 + u, sc - 1));
#pragma unroll
                for (int jj = 0; jj < 4; ++jj) { const int kk = kt * 16 + fq * 4 + jj; dd[u][jj] = HD[bi * 64 + kk];
#pragma unroll
                    for (int i = 0; i < 2; ++i) xx[u][i][jj] = HST[(bi * 64 + kk) * 64 + (vt0 + i) * 16 + fr]; } }
#pragma unroll
            for (int u = 0; u < 4; ++u) if (j0 + u < sc) {
#pragma unroll
                for (int jj = 0; jj < 4; ++jj)
#pragma unroll
                    for (int i = 0; i < 2; ++i) accS[i][jj] = dd[u][jj] * accS[i][jj] + xx[u][i][jj]; } }
    } else if (mode == 2) { const float* sp = P.in(4) + ((size_t)(l * 128 + b) * 4 + hd) * 4096;
#pragma unroll
        for (int jj = 0; jj < 4; ++jj)
#pragma unroll
            for (int i = 0; i < 2; ++i) accS[i][jj] = sp[(kt * 16 + fq * 4 + jj) * 64 + (vt0 + i) * 16 + fr]; }
    __syncthreads();
    if (mode != 0) {
#pragma unroll
        for (int i = 0; i < 2; ++i) { float t4[4] = {accS[i][0], accS[i][1], accS[i][2], accS[i][3]}; *(u32x2*)(St + ((vt0 + i) * 16 + fr) * 72 + kt * 16 + fq * 4) = pack4(t4); } }
    float dsum = 0.f;
    const int nch = mode == 2 ? 1 : 4, L = mode == 2 ? 4 : 32;
    const int rbase = mode == 2 ? MP + b * 4 : b * 2048 + sc * 128;
    bf16_t rz[4], rq[4], rv[4];
#pragma unroll
    for (int e = 0; e < 4; ++e) { const int s = 4 * sg + e; rz[e] = 0; rq[e] = 0; rv[e] = 0;
        if (s < L) { const bf16_t* row = PROJ + (size_t)(rbase + s) * 2560 + hd * 64 + k; rz[e] = row[512]; rq[e] = row[256]; rv[e] = row[768]; } }
    f32x4 ngv[4];
#pragma unroll
    for (int vt = 0; vt < 4; ++vt) ngv[vt] = *(const f32x4*)(P.in(21) + l * 256 + hd * 64 + vt * 16 + fq * 4);
#pragma unroll 1
    for (int ch = 0; ch < nch; ++ch) {
        const int r0 = rbase + ch * 32;
        bf16_t nz[4], nq[4], nv[4];
#pragma unroll
        for (int e = 0; e < 4; ++e) { nz[e] = 0; nq[e] = 0; nv[e] = 0;
            if (ch + 1 < nch) { const bf16_t* row = PROJ + (size_t)(r0 + 32 + 4 * sg + e) * 2560 + hd * 64 + k; nz[e] = row[512]; nq[e] = row[256]; nv[e] = row[768]; } }
        u32x2 pgv[4];
#pragma unroll
        for (int vt = 0; vt < 4; ++vt) { pgv[vt] = (u32x2){0u, 0u}; if (mode != 0 && wave < 2 && wave * 16 + fr < L) pgv[vt] = *(const u32x2*)(PROJ + (size_t)(r0 + wave * 16 + fr) * 2560 + 1024 + hd * 64 + vt * 16 + fq * 4); }
        float lf[4], kv[4], q[4], vv[4], cs[4];
#pragma unroll
        for (int e = 0; e < 4; ++e) { const int s = 4 * sg + e; lf[e] = 0.f; kv[e] = 0.f; q[e] = 0.f; vv[e] = 0.f;
            if (s < L) { const float z = bf2f(rz[e]); const float f = lbv + (1.f - lbv) * sigm(z); lf[e] = __logf(f); kv[e] = 1.f - f;
                if (mode != 0) { const float pq = bf2f(rq[e]); q[e] = pq * sigm(pq); }
                vv[e] = bf2f(rv[e]); } }
#pragma unroll
        for (int e = 0; e < 4; ++e) { rz[e] = nz[e]; rq[e] = nq[e]; rv[e] = nv[e]; }
        cs[0] = lf[0]; cs[1] = cs[0] + lf[1]; cs[2] = cs[1] + lf[2]; cs[3] = cs[2] + lf[3];
        TOT[sg * 64 + k] = cs[3];
        __syncthreads();
        float off = 0.f, blast = 0.f;
#pragma unroll
        for (int j = 0; j < 8; ++j) { const float tj = TOT[j * 64 + k]; if (j < sg) off += tj; blast += tj; }
        { float kd4[4];
#pragma unroll
            for (int e = 0; e < 4; ++e) { const int s = 4 * sg + e; const float bsv = off + cs[e];
                Qp[s * 72 + k] = f2bf(q[e] * __expf(bsv)); Kn[s * 72 + k] = f2bf(kv[e] * __expf(-bsv)); kd4[e] = kv[e] * __expf(blast - bsv); }
            *(u32x2*)(Kdt + k * 40 + 4 * sg) = pack4(kd4); *(u32x2*)(Vt + k * 40 + 4 * sg) = pack4(vv); }
        if (sg == 0) { EB[k] = __expf(blast); dsum += blast; }
        __syncthreads();
        { const f32x4 eb = *(const f32x4*)(EB + kt * 16 + fq * 4); const bf16x8 af = *(const bf16x8*)(Kdt + (kt * 16 + fr) * 40 + fq * 8);
#pragma unroll
            for (int i = 0; i < 2; ++i) { accS[i] = accS[i] * eb; accS[i] = MFMA16(af, *(const bf16x8*)(Vt + ((vt0 + i) * 16 + fr) * 40 + fq * 8), accS[i]); } }
        if (mode != 0) {
            if (wave < 4) { const int tt = wave >> 1, st = wave & 1; f32x4 a = (f32x4){0.f, 0.f, 0.f, 0.f};
                if (st <= tt) {
#pragma unroll
                    for (int ks = 0; ks < 2; ++ks) a = MFMA16(*(const bf16x8*)(Kn + (st * 16 + fr) * 72 + ks * 32 + fq * 8), *(const bf16x8*)(Qp + (tt * 16 + fr) * 72 + ks * 32 + fq * 8), a);
                    float m4[4];
#pragma unroll
                    for (int j = 0; j < 4; ++j) m4[j] = (st * 16 + fq * 4 + j <= tt * 16 + fr) ? a[j] : 0.f;
                    *(u32x2*)(Att + (tt * 16 + fr) * 40 + st * 16 + fq * 4) = pack4(m4);
                } else { *(u32x2*)(Att + (tt * 16 + fr) * 40 + st * 16 + fq * 4) = (u32x2){0u, 0u}; } }
            __syncthreads();
            if (wave < 2) { const int tt = wave; f32x4 o[4]; float ss = 0.f;
                const bf16x8 attf = *(const bf16x8*)(Att + (tt * 16 + fr) * 40 + fq * 8), q0 = *(const bf16x8*)(Qp + (tt * 16 + fr) * 72 + fq * 8), q1 = *(const bf16x8*)(Qp + (tt * 16 + fr) * 72 + 32 + fq * 8);
#pragma unroll
                for (int vt = 0; vt < 4; ++vt) { f32x4 a = MFMA16(*(const bf16x8*)(Vt + (vt * 16 + fr) * 40 + fq * 8), attf, ((f32x4){0.f, 0.f, 0.f, 0.f}));
                    a = MFMA16(*(const bf16x8*)(St + (vt * 16 + fr) * 72 + fq * 8), q0, a); a = MFMA16(*(const bf16x8*)(St + (vt * 16 + fr) * 72 + 32 + fq * 8), q1, a);
                    o[vt] = a; ss += a.x * a.x + a.y * a.y + a.z * a.z + a.w * a.w; }
                ss += shx(ss, lane, 16); ss += shx(ss, lane, 32);
                const float rn = rsqrtf(ss * (1.f / 64.f) + 1e-5f); const int t = tt * 16 + fr;
                if (t < L) { const int r = r0 + t;
#pragma unroll
                    for (int vt = 0; vt < 4; ++vt) { const int ci = hd * 64 + vt * 16 + fq * 4; const f32x4 ng = ngv[vt]; float pg[4], ov[4];
                        unpack4(pgv[vt], pg);
#pragma unroll
                        for (int j = 0; j < 4; ++j) ov[j] = o[vt][j] * rn * ng[j] * (pg[j] * sigm(pg[j]));
                        *(u32x2*)(MIXED + (size_t)r * 1024 + 256 + ci) = pack4(ov); } } }
            __syncthreads();
#pragma unroll
            for (int i = 0; i < 2; ++i) { float t4[4] = {accS[i][0], accS[i][1], accS[i][2], accS[i][3]}; *(u32x2*)(St + ((vt0 + i) * 16 + fr) * 72 + kt * 16 + fq * 4) = pack4(t4); }
        }
    }
    float* dst = nullptr;
    if (mode == 0) { const size_t bi = (size_t)((b * 4 + hd) * 16 + sc); dst = HST + bi * 4096; if (sg == 0) HD[bi * 64 + k] = __expf(dsum); }
    else if (mode == 1) { if (sc == 15) dst = P.out() + O_PHG + ((size_t)(l * 8 + b) * 4 + hd) * 4096; }
    else dst = P.out() + O_SHG + ((size_t)(l * 128 + b) * 4 + hd) * 4096;
    if (dst) {
#pragma unroll
        for (int jj = 0; jj < 4; ++jj)
#pragma unroll
            for (int i = 0; i < 2; ++i) dst[(kt * 16 + fq * 4 + jj) * 64 + (vt0 + i) * 16 + fr] = accS[i][jj]; }
    __syncthreads();
}

template <int CTRL> __device__ __forceinline__ float dpp_add(float x) { return x + __int_as_float(__builtin_amdgcn_update_dpp(0, __float_as_int(x), CTRL, 0xF, 0xF, false)); }
__device__ __forceinline__ float row16_sum(float x) { x = dpp_add<0xB1>(x); x = dpp_add<0x4E>(x); x = dpp_add<0x141>(x); x = dpp_add<0x140>(x); return x; }
#ifndef SCAN_EVEN
#define SCAN_EVEN 0
#endif
#if SCAN_EVEN
#define SCAN_LOADER(w) (((w) & 1) != 0)
#define SCAN_IDX(w) ((w) >> 1)
#else
#define SCAN_LOADER(w) ((w) >= 4)
#define SCAN_IDX(w) ((w) & 3)
#endif
__device__ __forceinline__ void rwkv_scan_task(const KP& P, int l, unsigned char* smem, bool prompt, int b, int hd, int rq) {
    const int tid = otid(), lane = tid & 63, wave = tid >> 6;
    const int T = prompt ? 2048 : 4, row0 = prompt ? b * 2048 : MP + b * 4;
    const float* RW = (const float*)(P.ws() + OFF_RW);
    const float* C12 = (const float*)(P.ws() + OFF_C12);
    unsigned char* Yb = P.ws() + OFF_PROJ + 2560;
    constexpr int BUFF = 32 * 340;
    float* buf = (float*)smem;
    const bool loader = SCAN_LOADER(wave);
    const int sw = SCAN_IDX(wave), ltid = sw * 64 + lane;
    const int rr = lane >> 4, i4 = (lane & 15) * 4, srow = rq * 16 + sw * 4 + rr;
    f32x4 S = (f32x4){0.f, 0.f, 0.f, 0.f};
    if (!loader && !prompt) S = *(const f32x4*)(P.in(5) + (((size_t)(l * 128 + b) * 4 + hd) * 64 + srow) * 64 + i4);
    const int nchunks = (T + 31) >> 5;
    __syncthreads();
#pragma unroll 1
    for (int c = -1; c < nchunks; ++c) {
        if (loader) {
            if (c + 1 < nchunks) { const int t0 = (c + 1) * 32, n = min(32, T - t0); float* bw = buf + ((c + 1) & 1) * BUFF;
                f32x4 x[5][2]; float vx[2]; float cx = 0.f;
#pragma unroll
                for (int i = 0; i < 2; ++i) { const int idx = ltid + 256 * i, stp = idx >> 4, q = idx & 15; const size_t o = (size_t)(row0 + t0 + stp) * 256 + hd * 64 + q * 4;
#pragma unroll
                    for (int vct = 0; vct < 5; ++vct) x[vct][i] = (stp < n) ? *(const f32x4*)(RW + vct * RWSZ + o) : (f32x4){0.f, 0.f, 0.f, 0.f};
                    vx[i] = (stp < n) ? RW[5 * RWSZ + (size_t)(row0 + t0 + stp) * 256 + hd * 64 + rq * 16 + q] : 0.f; }
                if (ltid < 64) { const int stp = ltid >> 1; if (stp < n) cx = C12[(size_t)(row0 + t0 + stp) * 16 + hd * 4 + (ltid & 1)]; }
#pragma unroll
                for (int i = 0; i < 2; ++i) { const int idx = ltid + 256 * i, stp = idx >> 4, q = idx & 15;
#pragma unroll
                    for (int vct = 0; vct < 5; ++vct) *(f32x4*)(bw + vct * 2048 + stp * 64 + q * 4) = x[vct][i];
                    bw[10240 + stp * 16 + q] = vx[i]; }
                if (ltid < 64) bw[10752 + (ltid >> 1) * 4 + (ltid & 1)] = cx;
            }
        } else if (c >= 0) {
            __builtin_amdgcn_s_setprio(3);
            const int t0 = c * 32; const float* br = buf + (c & 1) * BUFF;
#define SCAN_LD(s_, kk_, wr_, w_, kka_, kv_, v_, cc_) do { kk_ = *(const f32x4*)(br + (s_) * 64 + i4); wr_ = *(const f32x4*)(br + 2048 + (s_) * 64 + i4); w_ = *(const f32x4*)(br + 4096 + (s_) * 64 + i4); \
                kka_ = *(const f32x4*)(br + 6144 + (s_) * 64 + i4); kv_ = *(const f32x4*)(br + 8192 + (s_) * 64 + i4); v_ = br[10240 + (s_) * 16 + sw * 4 + rr]; cc_ = *(const f32x2v*)(br + 10752 + (s_) * 4); } while (0)
            f32x4 kk, wr, w, kka, kv; float v; f32x2v cc;
            f32x4 kk1, wr1, w1, kka1, kv1; float v1; f32x2v cc1;
            SCAN_LD(0, kk, wr, w, kka, kv, v, cc); SCAN_LD(1, kk1, wr1, w1, kka1, kv1, v1, cc1);
#pragma unroll 1
            for (int sb = 0; sb < 32; sb += 16) {
                float ysel = 0.f;
#pragma unroll
                for (int s2 = 0; s2 < 16; ++s2) { const int s = sb + s2;
                    f32x4 kk2, wr2, w2, kka2, kv2; float v2; f32x2v cc2;
                    SCAN_LD(s + 2, kk2, wr2, w2, kka2, kv2, v2, cc2);
                    asm volatile("" ::: "memory");
                    const f32x2v S01 = (f32x2v){S.x, S.y}, S23 = (f32x2v){S.z, S.w};
                    f32x2v d1 = S01 * (f32x2v){kk.x, kk.y}; d1 = __builtin_elementwise_fma(S23, (f32x2v){kk.z, kk.w}, d1);
                    f32x2v d2 = S01 * (f32x2v){wr.x, wr.y}; d2 = __builtin_elementwise_fma(S23, (f32x2v){wr.z, wr.w}, d2);
                    float p1 = d1.x + d1.y, p2 = d2.x + d2.y;
                    p1 = row16_sum(p1); p2 = row16_sum(p2);
                    const float sa = -p1, y = p2 + sa * cc.x + v * cc.y;
                    S = S * w + sa * kka + v * kv;
                    ysel = ((lane & 15) == s2) ? y : ysel;
                    kk = kk1; wr = wr1; w = w1; kka = kka1; kv = kv1; v = v1; cc = cc1;
                    kk1 = kk2; wr1 = wr2; w1 = w2; kka1 = kka2; kv1 = kv2; v1 = v2; cc1 = cc2; }
                ((float*)(Yb + (size_t)(row0 + t0 + sb + (lane & 15)) * 5120))[hd * 64 + srow] = ysel;
            }
#undef SCAN_LD
            __builtin_amdgcn_s_setprio(0);
        }
        __syncthreads();
    }
    if (!loader) { float* dst = P.out() + (prompt ? O_PWKV + (((size_t)(l * 8 + b) * 4 + hd) * 64 + srow) * 64 : O_SWKV + (((size_t)(l * 128 + b) * 4 + hd) * 64 + srow) * 64) + i4; *(f32x4*)dst = S; }
}

__device__ __forceinline__ void rwkv_sample_wave(const KP& P, int l, unsigned char* smem, int b, int hd, int half) {
    const int tid = otid(), lane = tid & 63, wave = tid >> 6;
    const float* RW = (const float*)(P.ws() + OFF_RW); const float* C12 = (const float*)(P.ws() + OFF_C12); unsigned char* Yb = P.ws() + OFF_PROJ + 2560;
    float* wl = (float*)smem + wave * 1600;
    const int srow = half * 32 + (lane >> 1), kh = (lane & 1) * 32;
    float S[32];
    { const float* sp = P.in(5) + (((size_t)(l * 128 + b) * 4 + hd) * 64 + srow) * 64 + kh;
#pragma unroll
        for (int q = 0; q < 8; ++q) { const f32x4 x = *(const f32x4*)(sp + 4 * q); S[4 * q] = x.x; S[4 * q + 1] = x.y; S[4 * q + 2] = x.z; S[4 * q + 3] = x.w; } }
#pragma unroll
    for (int st = 0; st < 4; ++st) { const size_t r = (size_t)(MP + b * 4 + st);
#pragma unroll
        for (int vct = 0; vct < 6; ++vct) wl[st * 400 + vct * 64 + lane] = RW[vct * RWSZ + r * 256 + hd * 64 + lane];
        if (lane < 2) wl[st * 400 + 384 + lane] = C12[r * 16 + hd * 4 + lane]; }
    LDSWAIT();
#pragma unroll 1
    for (int st = 0; st < 4; ++st) { const float* w5 = wl + st * 400; float p1 = 0.f, p2 = 0.f;
#pragma unroll
        for (int q = 0; q < 8; ++q) { const f32x4 kk = *(const f32x4*)(w5 + kh + 4 * q), wr = *(const f32x4*)(w5 + 64 + kh + 4 * q);
#pragma unroll
            for (int j = 0; j < 4; ++j) { p1 += S[4 * q + j] * kk[j]; p2 += S[4 * q + j] * wr[j]; } }
        p1 = dpp_add<0xB1>(p1); p2 = dpp_add<0xB1>(p2);
        const float sa = -p1, v = w5[320 + srow], c1 = w5[384], c2 = w5[385];
        if ((lane & 1) == 0) ((float*)(Yb + (size_t)(MP + b * 4 + st) * 5120))[hd * 64 + srow] = p2 + sa * c1 + v * c2;
#pragma unroll
        for (int q = 0; q < 8; ++q) { const f32x4 w = *(const f32x4*)(w5 + 128 + kh + 4 * q), kka = *(const f32x4*)(w5 + 192 + kh + 4 * q), kv = *(const f32x4*)(w5 + 256 + kh + 4 * q);
#pragma unroll
            for (int j = 0; j < 4; ++j) S[4 * q + j] = S[4 * q + j] * w[j] + sa * kka[j] + v * kv[j]; } }
    { float* dp = P.out() + O_SWKV + (((size_t)(l * 128 + b) * 4 + hd) * 64 + srow) * 64 + kh;
#pragma unroll
        for (int q = 0; q < 8; ++q) *(f32x4*)(dp + 4 * q) = (f32x4){S[4 * q], S[4 * q + 1], S[4 * q + 2], S[4 * q + 3]}; }
    LDSWAIT();
}

#ifndef PROBE_VAL
#define PROBE_VAL tacc
#endif
#ifndef PROBE_CMASK
#define PROBE_CMASK 15
#endif
#ifndef PROBE_DMASK
#define PROBE_DMASK 31
#endif
__device__ __forceinline__ void phaseC(const KP& P0, int l, unsigned char* smem) {
    { const KP P = get_kp(); float* z1 = (float*)(P.ws() + OFF_RSQ1); float* z2 = (float*)(P.ws() + OFF_RSQ2);
      for (int i = blockIdx.x * 512 + otid(); i < MP; i += gridDim.x * 512) { z1[i] = 0.f; z2[i] = 0.f; } }
    const int tid = otid();
    unsigned* ctr = (unsigned*)(P0.ws() + OFF_CTR) + 2 + l;
    volatile int* s_task = (volatile int*)(smem + LDS_TASK_OFF);
    for (;;) {
        __syncthreads();
        if (tid == 0) *s_task = (int)atomicAdd(ctr, 1u);
        __syncthreads();
        const int t = *s_task;
        if (t >= 1312) break;
        const KP P = get_kp();
#ifdef PROBE_SEL
        const unsigned long long c0_ = __builtin_amdgcn_s_memrealtime();
#endif
        const int pt = (t < 560 && !(t & 1)) ? (t >> 1) : -1, lt = (t < 560) ? ((t & 1) ? (t >> 1) : -1) : t - 280;
        if (pt >= 0) { if (pt < 248) rwkv_prep_tile<2>(P, l, smem, pt); else rwkv_prep_tile<1>(P, l, smem, 496 + (pt - 248)); }
        else if (lt < 256) s5_task(P, l, smem, 0, lt);
        else if (lt < 520) pool_tile(P, l, smem, lt - 256);
        else { const int u = lt - 520; hgrn_task(P, l, smem, 0, u >> 6, (u >> 4) & 3, u & 15); }
#ifdef PROBE_SEL
        if (l == 0 && tid == 0) { float* sl = (float*)(P.ws() + OFF_CTR) + 52 + (t < 280 ? 0 : (t < 536 ? 1 : (t < 800 ? 2 : 3))); *sl = (float)(__builtin_amdgcn_s_memrealtime() - c0_) * 0.01f; }
#endif
    }
}
__device__ __forceinline__ void phaseD(const KP& P0, int l, unsigned char* smem) {
    const int tid = otid();
#ifdef PROBE_SEL
    float ptt[5] = {0.f, 0.f, 0.f, 0.f, 0.f}, ptn[5] = {0.f, 0.f, 0.f, 0.f, 0.f}; unsigned long long pt0 = __builtin_amdgcn_s_memrealtime();
#endif
    if ((PROBE_DMASK & 1) && blockIdx.x < 128) rwkv_scan_task(P0, l, smem, true, blockIdx.x >> 4, (blockIdx.x >> 2) & 3, blockIdx.x & 3);
#ifdef PROBE_SEL
    ptt[0] = (float)(__builtin_amdgcn_s_memrealtime() - pt0) * 0.01f; ptn[0] = 1.f;
#endif
    unsigned* ctr = (unsigned*)(P0.ws() + OFF_CTR) + l;
    volatile int* s_task = (volatile int*)(smem + LDS_TASK_OFF);
    for (;;) {
        __syncthreads();
        if (tid == 0) *s_task = (int)atomicAdd(ctr, 1u);
        __syncthreads();
        const int t = *s_task;
        if (t >= 1416 + 576 + (l == 0 ? 160 : 0)) break;
        const KP P = get_kp();
#ifdef PROBE_SEL
        pt0 = __builtin_amdgcn_s_memrealtime();
#endif
        if (t < 264) s5_task(P, l, smem, 1, t);
        else if (t < 776) { const int u = t - 264; hgrn_task(P, l, smem, 1, u >> 6, (u >> 4) & 3, 15 - (u & 15)); }
        else if (t < 1288) { const int u = t - 776; if (PROBE_DMASK & 8) hgrn_task(P, l, smem, 2, u >> 2, u & 3, 0); }
        else if (t < 1416) { const int u = (t - 1288) * 8 + (tid >> 6); rwkv_sample_wave(P, l, smem, u >> 3, (u >> 1) & 3, u & 1); }
        else { const int it = (t - 1416) * 8 + (tid >> 6), lane = tid & 63; float* scr = (float*)smem + (tid >> 6) * (64 * 33);
            if (it < 512) transpose_item(P.in(35) + (size_t)l * 1024 * 1024, 1024, 1024, (bf16_t*)(P.ws() + OFF_WOUTT), scr, it, lane, nullptr);
            else if (it < 2560) transpose_item(P.in(37) + (size_t)l * 1024 * 4096, 1024, 4096, (bf16_t*)(P.ws() + OFF_UPT), scr, it - 512, lane, P.in(36) + l * 1024);
            else if (it < 4608) transpose_item(P.in(38) + (size_t)l * 4096 * 1024, 4096, 1024, (bf16_t*)(P.ws() + OFF_DOWNT), scr, it - 2560, lane, nullptr);
            else transpose_item(P.in(9) + (size_t)(l + 1) * 1024 * 2560, 1024, 2560, (bf16_t*)(P.ws() + OFF_WINT), scr, it - 4608, lane, P.in(8) + (l + 1) * 1024); }
#ifdef PROBE_SEL
        { const int ty = t < 512 ? 1 : (t < 776 ? 2 : (t < 1288 ? 3 : 4)); const float d = (float)(__builtin_amdgcn_s_memrealtime() - pt0) * 0.01f;
#pragma unroll
          for (int c = 1; c < 5; ++c) if (c == ty) { ptt[c] += d; ptn[c] += 1.f; } }
#endif
    }
#ifdef PROBE_SEL
    if (l == 0 && tid == 0 && (blockIdx.x == 0 || blockIdx.x == 200)) { float* sl = (float*)(P0.ws() + OFF_CTR) + (blockIdx.x == 0 ? 16 : 32);
#pragma unroll
        for (int c = 0; c < 5; ++c) { sl[c] = ptt[c]; sl[8 + c] = ptn[c]; } }
#endif
}
__device__ __forceinline__ void phaseE(const KP& P, int l) {
    const int tid = otid(), lane = tid & 63, wave = tid >> 6, gw = blockIdx.x * 8 + wave, NGW = gridDim.x * 8;
    const unsigned char* Yb = P.ws() + OFF_PROJ + 2560; const float* Vb = (const float*)(P.ws() + OFF_RW) + 5 * RWSZ; const float* C12 = (const float*)(P.ws() + OFF_C12);
    bf16_t* MIXED = (bf16_t*)(P.ws() + OFF_MIXED);
    const int c0 = lane * 4, hd = lane >> 4;
    const f32x4 lg = *(const f32x4*)(P.in(31) + l * 256 + c0), lbb = *(const f32x4*)(P.in(32) + l * 256 + c0);
#pragma unroll 1
    for (int rb = gw; rb < MT; rb += 8 * NGW) {
        f32x4 yv[8], vv[8]; u32x2 gv[8]; float bsv[8];
#pragma unroll
        for (int q = 0; q < 8; ++q) { const int r = min(rb + q * NGW, MT - 1);
            yv[q] = *(const f32x4*)((const float*)(Yb + (size_t)r * 5120) + c0); vv[q] = *(const f32x4*)(Vb + (size_t)r * 256 + c0);
            gv[q] = *(const u32x2*)(MIXED + (size_t)r * 1024 + 512 + c0); bsv[q] = C12[(size_t)r * 16 + hd * 4 + 2]; }
#pragma unroll
        for (int q = 0; q < 8; ++q) { const int r = rb + q * NGW; const f32x4 y = yv[q], v = vv[q];
            float s = y.x + y.y + y.z + y.w; s += shx(s, lane, 1); s += shx(s, lane, 2); s += shx(s, lane, 4); s += shx(s, lane, 8);
            const float mean = s * (1.f / 64.f); const f32x4 d = y - mean;
            float qq = d.x * d.x + d.y * d.y + d.z * d.z + d.w * d.w; qq += shx(qq, lane, 1); qq += shx(qq, lane, 2); qq += shx(qq, lane, 4); qq += shx(qq, lane, 8);
            const float rs = rsqrtf(qq * (1.f / 64.f) + 64e-5f); const float bs = bsv[q];
            float g[4], o[4]; unpack4(gv[q], g);
#pragma unroll
            for (int j = 0; j < 4; ++j) o[j] = (d[j] * rs * lg[j] + lbb[j] + bs * v[j]) * g[j];
            if (r < MT) *(u32x2*)(MIXED + (size_t)r * 1024 + 512 + c0) = pack4(o); }
    }
}

template <class Epi> __device__ __forceinline__ void run_gemm(unsigned char* smem, const bf16_t* A, const bf16_t* Bt, int M, int N, int K, const Epi& E) {
    pg8::Gemm g; g.A = A; g.Bt = Bt; g.M = M; g.N = N; g.K = K; g.ld = K;
    pg8::StaticOrder S; S.init(M, N, (int)gridDim.x, (int)blockIdx.x);
    __syncthreads();
    pg8::gemm_phase<Epi, pg8::StaticOrder, false>((PG8_LAS unsigned char*)smem, g, S, E, nullptr);
    __syncthreads();
}
struct ResidOrder {
    pg8::StaticOrder main; int S, kbytes, ntail, G, c;
    __device__ bool next(int i, pg8::Unit& u) const {
        if (main.next(i, u)) return true;
        const int L = i * G + c - main.nwg; if (L < 0 || L >= 8 * S) return false;
        const int t = L / S, ks = L - t * S; u.pm = 64 + (t >> 2); u.pn = t & 3; u.kb = ks * kbytes; u.nt = ntail; return true; }
    __device__ __forceinline__ void a_ready(const pg8::Unit&) const {}
    __device__ __forceinline__ void done(const pg8::Unit&) const {}
};
__device__ __forceinline__ void run_gemm_resid(unsigned char* smem, const bf16_t* A, const bf16_t* Bt, int K, int split, pg8::EpiResid& E) {
    pg8::Gemm g; g.A = A; g.Bt = Bt; g.M = MP; g.N = 1024; g.K = K; g.ld = K;
    ResidOrder S; S.main.init(MP, 1024, (int)gridDim.x, (int)blockIdx.x); S.S = split; S.kbytes = (K / split) * 2; S.ntail = (K / split) / 64; S.G = (int)gridDim.x; S.c = (int)blockIdx.x;
    E.kbytes = S.kbytes;
    __syncthreads();
    pg8::gemm_phase<pg8::EpiResid, ResidOrder, false>((PG8_LAS unsigned char*)smem, g, S, E, nullptr);
    __syncthreads();
}

__device__ __forceinline__ void gbar(unsigned* bar, unsigned& target) {
    __syncthreads();
    if (threadIdx.x == 0) {
        target += gridDim.x;
        __threadfence();
        __hip_atomic_fetch_add(bar, 1u, __ATOMIC_RELAXED, __HIP_MEMORY_SCOPE_AGENT);
        while (__hip_atomic_load(bar, __ATOMIC_RELAXED, __HIP_MEMORY_SCOPE_AGENT) < target) __builtin_amdgcn_s_sleep(1);
        __threadfence();
    }
    __syncthreads();
}
#define SEAM(ID) do { if ((ID) == 0) grid.sync(); else gbar(bar, btarget); } while (0)
#ifdef PROBE_SEL
#define PH_END(ID) do { SEAM(ID); { const unsigned long long tn_ = __builtin_amdgcn_s_memrealtime(); const float d_ = (float)(tn_ - tprev) * 0.01f; tprev = tn_; const int ID_ = (ID); const int L_ = ID_ / 9, SUB_ = ID_ % 9; (void)L_; (void)SUB_; if (PROBE_SEL) tacc += d_; } } while (0)
#else
#define PH_END(ID) SEAM(ID)
#endif
__global__ void __launch_bounds__(512, 2) mega(Params Pk) {
    extern __shared__ __attribute__((aligned(16))) unsigned char smem[];
    cg::grid_group grid = cg::this_grid();
    unsigned long long tprev = 0ull; float tacc = 0.f;
    unsigned btarget = 0u; unsigned* bar = (unsigned*)(get_kp().ws() + OFF_CTR) + 8;
#ifdef PROBE_SEL
    tprev = __builtin_amdgcn_s_memrealtime();
#endif
#pragma unroll 1
    for (int ph = 0; ph < 18; ++ph) {
        int L = ph / 9; const int sub = ph - L * 9; L = __builtin_amdgcn_readfirstlane(L);
        if (sub == 0) phaseA(get_kp(), L, smem);
        else if (sub == 1 || sub == 7) { const KP P = get_kp(); pg8::EpiBf E; E.ACT = sub == 7; E.O = (bf16_t*)(P.ws() + (sub == 1 ? OFF_PROJ : OFF_HIDDEN)); E.ldc = sub == 1 ? 2560 : 4096; E.rsq = (const float*)(P.ws() + (sub == 1 ? OFF_RSQ1 : OFF_RSQ2));
            run_gemm(smem, (const bf16_t*)(P.ws() + (sub == 1 ? OFF_HB1 : OFF_XN2)), (const bf16_t*)(P.ws() + (sub == 1 ? OFF_WINT : OFF_UPT)), MT, sub == 1 ? 2560 : 4096, 1024, E); }
        else if (sub == 2) phaseC(get_kp(), L, smem);
        else if (sub == 3) phaseD(get_kp(), L, smem);
        else if (sub == 4) phaseE(get_kp(), L);
        else if (sub == 5 || sub == 8) { const KP P = get_kp(); pg8::EpiResid E; E.H = P.out(); E.Hin = (L == 0 && sub == 5) ? P.in(0) : P.out(); E.ldc = 1024; E.HB = (bf16_t*)(P.ws() + (sub == 5 ? OFF_XN2 : OFF_HB1)); E.rsq = (float*)(P.ws() + (sub == 5 ? OFF_RSQ2 : OFF_RSQ1));
            const bf16_t* A = (const bf16_t*)(P.ws() + (sub == 5 ? OFF_MIXED : OFF_HIDDEN)); const bf16_t* Bt = (const bf16_t*)(P.ws() + (sub == 5 ? OFF_WOUTT : OFF_DOWNT)); const int K = sub == 5 ? 1024 : 4096;
            E.PART = (float*)(P.ws() + OFF_PART); run_gemm_resid(smem, A, Bt, K, sub == 5 ? 4 : 8, E); }
        else phaseG(get_kp(), L, smem);
        PH_END(ph);
    }
#ifdef PROBE_SEL
    if (threadIdx.x == 0) { const KP P = get_kp(); ((int*)(P.ws() + WS_END))[blockIdx.x] = (int)((unsigned)__builtin_amdgcn_s_getreg((3 << 11) | 20) & 0xFu); }
#endif
    norm_rows(get_kp(), 0, 2);
#ifdef PROBE_SEL
    PH_END(18);
    float xmis = 0.f; { const KP P = get_kp(); const int* xt = (const int*)(P.ws() + WS_END); for (int i = 0; i < 256; ++i) xmis += (xt[i] != xt[i & 7]) ? 1.f : 0.f; } (void)xmis;
    if (blockIdx.x == 0) { const KP P = get_kp(); const float* sl = (const float*)(P.ws() + OFF_CTR); (void)sl; const float sc = 1.f + sqrtf((PROBE_VAL) * 1e-5f); for (int i = threadIdx.x; i < 16384; i += 512) P.out()[O_PSRE + i] *= sc; }
#endif
}

extern "C" void kernel_launch(void* const* d_in, const int* in_sizes, int n_in, void* d_out, int out_size, void* d_ws, size_t ws_size, hipStream_t stream) {
    static int grid = 0;
    if (grid == 0) {
        if (n_in != 40 || ws_size < WS_END) { fprintf(stderr, "kernel_launch: unexpected n_in %d / ws %zu\n", n_in, ws_size); grid = -1; return; }
        int dev = 0, cus = 0, per_cu = 0;
        hipGetDevice(&dev); hipDeviceGetAttribute(&cus, hipDeviceAttributeMultiprocessorCount, dev);
        if (hipFuncSetAttribute((const void*)mega, hipFuncAttributeMaxDynamicSharedMemorySize, LDS_BYTES) != hipSuccess) { fprintf(stderr, "kernel_launch: hipFuncSetAttribute failed\n"); grid = -1; return; }
        if (hipOccupancyMaxActiveBlocksPerMultiprocessor(&per_cu, (const void*)mega, 512, LDS_BYTES) != hipSuccess || per_cu < 1) { fprintf(stderr, "kernel_launch: occupancy query says %d\n", per_cu); per_cu = 1; }
        (void)hipGetLastError();
        grid = cus;
    }
    if (grid < 0) return;
    Params p{};
    for (int i = 0; i < 40; ++i) p.in[i] = (const float*)d_in[i];
    p.out = (float*)d_out; p.ws = (unsigned char*)d_ws;
    if (hipMemsetAsync((char*)d_ws + OFF_CTR + 32, 0, 4, stream) != hipSuccess) { fprintf(stderr, "kernel_launch: memset of the barrier word failed\n"); return; }
    void* args[] = {&p};
    hipError_t e = hipLaunchCooperativeKernel((const void*)mega, dim3(grid), dim3(512), args, LDS_BYTES, stream);
    if (e != hipSuccess) fprintf(stderr, "cooperative launch failed: %s (grid %d)\n", hipGetErrorString(e), grid);
}
```

```cpp
#include <hip/hip_runtime.h>
#include <hip/hip_cooperative_groups.h>
#include <cstdio>
#include <cstdint>
namespace cg = cooperative_groups;
__device__ __forceinline__ int otid() { int t = threadIdx.x; asm volatile("" : "+v"(t)); return t; }
namespace pg8 {
#define PG8_LAS __attribute__((address_space(3)))
typedef unsigned short bf16_t;
typedef short bf16x8 __attribute__((ext_vector_type(8)));
typedef float f32x4 __attribute__((ext_vector_type(4)));
typedef unsigned u32x4 __attribute__((ext_vector_type(4)));
constexpr int BM = 256, BK = 64, HALF = 128, HTB = HALF * BK * 2  , STAGE_BYTES = 8 * HTB, NXCD = 8, WGM = 8;

__host__ __device__ __forceinline__ int lds_byte(int r, int c) { const int st = (r >> 4) * 2 + (c >> 5), rr = r & 15, cc = c & 31, ob = rr * 64 + cc * 2; return st * 1024 + (ob ^ (((ob >> 9) & 1) << 5)); }
__host__ __device__ __forceinline__ void stage_rc(int b, int& R, int& C) { const int st = b / 1024, sb = b % 1024, swz = sb ^ (((sb >> 9) & 1) << 5); R = (st >> 1) * 16 + swz / 64; C = (st & 1) * 32 + (swz % 64) / 2; }
__host__ __device__ __forceinline__ int perm32(int rho) { const int n = rho >> 4, i = rho & 15; return 8 * (i >> 2) + 4 * n + (i & 3); }

struct Unit { int pm, pn, kb, nt; };
struct Gemm { const bf16_t* A; const bf16_t* Bt; int M, N, K, ld; };

struct StaticOrder {
    int nM, nN, nwg, G, c;
    __host__ __device__ void init(int M, int N, int G_, int c_) { nM = M / BM; nN = N / BM; nwg = nM * nN; G = G_; c = c_; }
    __host__ __device__ bool next(int i, Unit& u) const {
        const long L = (long)i * G + c; if (L >= nwg) return false;
        int wgid = (int)L; { const int q = nwg / NXCD, r = nwg % NXCD, xcd = wgid % NXCD, off = wgid / NXCD; wgid = (xcd < r ? xcd * (q + 1) : r * (q + 1) + (xcd - r) * q) + off; }
        const int nig = WGM * nN, gid = wgid / nig, fm = gid * WGM, gsz = (nM - fm) < WGM ? (nM - fm) : WGM;
        u.pm = fm + ((wgid % nig) % gsz); u.pn = (wgid % nig) / gsz; u.kb = 0; u.nt = 0; return true;
    }
    __device__ __forceinline__ void a_ready(const Unit&) const {}
    __device__ __forceinline__ void done(const Unit&) const {}
};
__device__ __forceinline__ unsigned cvt_pk_bf16(float lo, float hi) { unsigned r; asm volatile("v_cvt_pk_bf16_f32 %0, %1, %2" : "=v"(r) : "v"(lo), "v"(hi)); return r; }
struct EpiBf {
    static constexpr bool PERM = true, AFTER_DRAIN = false;
    bf16_t* O; int ldc; int ACT; const float* rsq;
    __device__ __forceinline__ void init(f32x4 (&acc)[2][2][4][2], const Unit&, int, int, int, int) const {
#pragma unroll
        for (int a = 0; a < 2; ++a)
#pragma unroll
            for (int b = 0; b < 2; ++b)
#pragma unroll
                for (int m = 0; m < 4; ++m)
#pragma unroll
                    for (int n = 0; n < 2; ++n) acc[a][b][m][n] = (f32x4){0.f, 0.f, 0.f, 0.f}; }
    __device__ __forceinline__ void operator()(const f32x4 (&acc)[2][2][4][2], const Unit& u, int wr, int wc, int fr, int fq) const {
        const int row0 = u.pm * BM + wr * 64 + fr; const int col0 = u.pn * BM + wc * 32 + 8 * fq;
#pragma unroll
        for (int ai = 0; ai < 2; ++ai)
#pragma unroll
            for (int m = 0; m < 4; ++m) { bf16_t* rowp = O + (size_t)(row0 + ai * HALF + m * 16) * ldc + col0; const float rstd = rsqrtf(rsq[row0 + ai * HALF + m * 16] * (1.f / 1024.f) + 1e-6f);
#pragma unroll
                for (int bj = 0; bj < 2; ++bj) { f32x4 v0 = acc[ai][bj][m][0] * rstd, v1 = acc[ai][bj][m][1] * rstd;
                    if (ACT) {
#pragma unroll
                        for (int j = 0; j < 4; ++j) { const float a = fmaxf(v0[j], 0.f), b = fmaxf(v1[j], 0.f); v0[j] = a * a; v1[j] = b * b; } }
                    u32x4 w; w.x = cvt_pk_bf16(v0[0], v0[1]); w.y = cvt_pk_bf16(v0[2], v0[3]); w.z = cvt_pk_bf16(v1[0], v1[1]); w.w = cvt_pk_bf16(v1[2], v1[3]);
                    *(u32x4*)(rowp + bj * HALF) = w; } }
    }
};
struct EpiResid {
    static constexpr bool PERM = false, AFTER_DRAIN = false;
    float* H; const float* Hin; int ldc; bf16_t* HB; float* rsq; float* PART; int kbytes;
    __device__ __forceinline__ void init(f32x4 (&acc)[2][2][4][2], const Unit& u, int wr, int wc, int fr, int fq) const {
        if (u.pm >= 64) {
#pragma unroll
        for (int a = 0; a < 2; ++a)
#pragma unroll
            for (int b = 0; b < 2; ++b)
#pragma unroll
                for (int m = 0; m < 4; ++m)
#pragma unroll
                    for (int n = 0; n < 2; ++n) acc[a][b][m][n] = (f32x4){0.f, 0.f, 0.f, 0.f};
            return; }
        const int row0 = u.pm * BM + wr * 64 + fr, col0 = u.pn * BM + wc * 32 + 4 * fq;
#pragma unroll
        for (int ai = 0; ai < 2; ++ai)
#pragma unroll
            for (int m = 0; m < 4; ++m) { const float* rowp = Hin + (size_t)(row0 + ai * HALF + m * 16) * ldc + col0;
#pragma unroll
                for (int bj = 0; bj < 2; ++bj)
#pragma unroll
                    for (int n = 0; n < 2; ++n) acc[ai][bj][m][n] = *(const f32x4*)(rowp + bj * HALF + n * 16); }
    }
    __device__ __forceinline__ void operator()(const f32x4 (&acc)[2][2][4][2], const Unit& u, int wr, int wc, int fr, int fq) const {
        if (u.pm >= 64) { const int ks = u.kb / kbytes, row0 = (u.pm - 64) * BM + wr * 64 + fr, col0 = u.pn * BM + wc * 32 + 4 * fq;
#pragma unroll
            for (int ai = 0; ai < 2; ++ai)
#pragma unroll
                for (int m = 0; m < 4; ++m) { float* rowp = PART + ((size_t)ks * 512 + row0 + ai * HALF + m * 16) * 1024 + col0;
#pragma unroll
                    for (int bj = 0; bj < 2; ++bj)
#pragma unroll
                        for (int n = 0; n < 2; ++n) *(f32x4*)(rowp + bj * HALF + n * 16) = acc[ai][bj][m][n]; }
            return; }
        const int row0 = u.pm * BM + wr * 64 + fr, col0 = u.pn * BM + wc * 32 + 4 * fq, lane = fq * 16 + fr;
#pragma unroll
        for (int ai = 0; ai < 2; ++ai)
#pragma unroll
            for (int m = 0; m < 4; ++m) { const int row = row0 + ai * HALF + m * 16; float* rowp = H + (size_t)row * ldc + col0; bf16_t* hbp = HB + (size_t)row * ldc + col0; float ss = 0.f;
#pragma unroll
                for (int bj = 0; bj < 2; ++bj)
#pragma unroll
                    for (int n = 0; n < 2; ++n) { const f32x4 v = acc[ai][bj][m][n]; *(f32x4*)(rowp + bj * HALF + n * 16) = v;
                        ss += v.x * v.x + v.y * v.y + v.z * v.z + v.w * v.w;
                        typedef unsigned u32x2_ __attribute__((ext_vector_type(2))); *(u32x2_*)(hbp + bj * HALF + n * 16) = (u32x2_){cvt_pk_bf16(v.x, v.y), cvt_pk_bf16(v.z, v.w)}; }
                ss += __int_as_float(__builtin_amdgcn_ds_bpermute((lane ^ 16) << 2, __float_as_int(ss))); ss += __int_as_float(__builtin_amdgcn_ds_bpermute((lane ^ 32) << 2, __float_as_int(ss)));
                if (fq == 0) unsafeAtomicAdd(rsq + row, ss); }
    }
};

template <class Epi, class Sched, bool STAMP = false>
__device__ __forceinline__ void gemm_phase(PG8_LAS unsigned char* lds, const Gemm g, const Sched& S, const Epi& E, unsigned long long* stamps) {
    const int tid = otid(), wid = __builtin_amdgcn_readfirstlane(tid >> 6), lane = tid & 63, wr = wid >> 2, wc = wid & 3, fr = lane & 15, fq = lane >> 4;
    const int K = g.ld, nt = g.K / BK;
    int ts_lo = 0, ts_hi = 0, nts = 0; const unsigned long long rt_entry = STAMP ? (unsigned long long)wall_clock64() : 0ull;
#define PG8_STAMP() do { if (STAMP && wid == 0 && nts < 64) { const unsigned long long _c = (unsigned long long)clock64(); \
        ts_lo = (lane == nts) ? (int)(unsigned)_c : ts_lo; ts_hi = (lane == nts) ? (int)(unsigned)(_c >> 32) : ts_hi; ++nts; } } while (0)
    PG8_STAMP();
    unsigned voffA[2], voffB[2];
#pragma unroll
    for (int i = 0; i < 2; ++i) { int R, C; stage_rc(tid * 16 + i * 8192, R, C); const int Rb = Epi::PERM ? ((R & ~31) + perm32(R & 31)) : R;
        voffA[i] = (unsigned)(R * K + C) * 2u; voffB[i] = (unsigned)(Rb * K + C) * 2u; }
    const size_t kstep = (size_t)(BK * 2);
    const size_t hstep = (size_t)HALF * K * 2;
    const size_t tstep = 2 * hstep;
    const unsigned ldsw = (unsigned)wid * 1024u;
    const int aoff = lds_byte(wr * 64 + fr, fq * 8), boff = lds_byte(wc * 32 + fr, fq * 8);
#define PG8_SA(b, h) (((b) * 2 + (h)) * HTB)
#define PG8_SB(b, h) ((4 + (b) * 2 + (h)) * HTB)
#define PG8_STAGE(bufoff, gbase, voff) do { _Pragma("unroll") for (int _i = 0; _i < 2; ++_i) \
        __builtin_amdgcn_global_load_lds((const unsigned*)((const char*)(gbase) + (voff)[_i]), (PG8_LAS unsigned*)(lds + (bufoff) + ldsw + _i * 8192), 16, 0, 0); } while (0)
#define PG8_LDA(dst, b, h) do { _Pragma("unroll") for (int m = 0; m < 4; ++m) _Pragma("unroll") for (int k = 0; k < 2; ++k) dst[m][k] = *(const PG8_LAS bf16x8*)(lds + PG8_SA(b, h) + aoff + m * 2048 + k * 1024); } while (0)
#define PG8_LDB(dst, b, h) do { _Pragma("unroll") for (int n = 0; n < 2; ++n) _Pragma("unroll") for (int k = 0; k < 2; ++k) dst[n][k] = *(const PG8_LAS bf16x8*)(lds + PG8_SB(b, h) + boff + n * 2048 + k * 1024); } while (0)
#define PG8_MMA(ai, bj, At, Bt) do { __builtin_amdgcn_s_setprio(1); _Pragma("unroll") for (int m = 0; m < 4; ++m) _Pragma("unroll") for (int n = 0; n < 2; ++n) _Pragma("unroll") for (int k = 0; k < 2; ++k) \
        acc[ai][bj][m][n] = __builtin_amdgcn_mfma_f32_16x16x32_bf16(Bt[n][k], At[m][k], acc[ai][bj][m][n], 0, 0, 0); __builtin_amdgcn_s_setprio(0); } while (0)
#define PG8_WAIT_V(n) asm volatile("s_waitcnt vmcnt(" #n ")" ::: "memory")
#define PG8_WAIT_L(n) asm volatile("s_waitcnt lgkmcnt(" #n ")" ::: "memory")
#define PG8_BAR __builtin_amdgcn_s_barrier()
#define PG8_SCHED __builtin_amdgcn_sched_barrier(0)
    Unit cur, nxt; int ui = 0;
    if (!S.next(0, cur)) return;
    f32x4 acc[2][2][4][2];
    bf16x8 At[4][2], B0[2][2], B1[2][2];
    const char* cA = (const char*)g.A + (size_t)cur.pm * tstep + cur.kb; const char* cB = (const char*)g.Bt + (size_t)cur.pn * tstep + cur.kb;
    S.a_ready(cur);
    E.init(acc, cur, wr, wc, fr, fq);
    PG8_STAGE(PG8_SB(0, 0), cB, voffB); PG8_STAGE(PG8_SA(0, 0), cA, voffA); PG8_STAGE(PG8_SB(0, 1), cB + hstep, voffB); PG8_STAGE(PG8_SA(0, 1), cA + hstep, voffA);
    if (wr == 1) PG8_BAR;
    PG8_WAIT_V(4); PG8_BAR;
    PG8_STAGE(PG8_SB(1, 0), cB + kstep, voffB); PG8_STAGE(PG8_SA(1, 0), cA + kstep, voffA); PG8_STAGE(PG8_SB(1, 1), cB + hstep + kstep, voffB);
    PG8_WAIT_V(6); PG8_BAR;
    PG8_STAMP();
    for (;;) {
        const bool has_next = S.next(ui + 1, nxt);
        const char* nA = has_next ? (const char*)g.A + (size_t)nxt.pm * tstep + nxt.kb : cA; const char* nB = has_next ? (const char*)g.Bt + (size_t)nxt.pn * tstep + nxt.kb : cB;
        const int unt = cur.nt > 0 ? cur.nt : nt;
        for (int t = 0; t < unt; t += 2) {
            const bool last = (t == unt - 2);
            const char* a1 = cA + (size_t)(t + 1) * kstep;
            const char* a2 = last ? nA : cA + (size_t)(t + 2) * kstep; const char* b2 = last ? nB : cB + (size_t)(t + 2) * kstep;
            const char* a3 = a2 + kstep; const char* b3 = b2 + kstep;
            if (last && has_next) S.a_ready(nxt);
            PG8_LDB(B0, 0, 0); PG8_SCHED; PG8_LDA(At, 0, 0); PG8_STAGE(PG8_SA(1, 1), a1 + hstep, voffA);
            PG8_WAIT_L(8); PG8_BAR; PG8_WAIT_L(0); PG8_MMA(0, 0, At, B0); PG8_BAR; PG8_SCHED;
            PG8_LDB(B1, 0, 1); PG8_STAGE(PG8_SB(0, 0), b2, voffB);
            PG8_BAR; PG8_WAIT_L(0); PG8_MMA(0, 1, At, B1); PG8_BAR;
            PG8_LDA(At, 0, 1); PG8_STAGE(PG8_SA(0, 0), a2, voffA);
            PG8_BAR; PG8_WAIT_L(0); PG8_MMA(1, 0, At, B0); PG8_BAR; PG8_SCHED;
            PG8_STAGE(PG8_SB(0, 1), b2 + hstep, voffB);
            PG8_WAIT_V(6); PG8_BAR; PG8_MMA(1, 1, At, B1); PG8_BAR;
            PG8_LDB(B0, 1, 0); PG8_SCHED; PG8_LDA(At, 1, 0); PG8_STAGE(PG8_SA(0, 1), a2 + hstep, voffA);
            PG8_WAIT_L(8); PG8_BAR; PG8_WAIT_L(0); PG8_MMA(0, 0, At, B0); PG8_BAR; PG8_SCHED;
            PG8_LDB(B1, 1, 1); PG8_STAGE(PG8_SB(1, 0), b3, voffB);
            PG8_BAR; PG8_WAIT_L(0); PG8_MMA(0, 1, At, B1); PG8_BAR;
            PG8_LDA(At, 1, 1); PG8_STAGE(PG8_SA(1, 0), a3, voffA);
            PG8_BAR; PG8_WAIT_L(0); PG8_MMA(1, 0, At, B0); PG8_BAR; PG8_SCHED;
            PG8_STAGE(PG8_SB(1, 1), b3 + hstep, voffB);
            PG8_WAIT_V(6); PG8_BAR; PG8_MMA(1, 1, At, B1); PG8_BAR;
        }
        PG8_STAMP();
        if constexpr (!Epi::AFTER_DRAIN) { E(acc, cur, wr, wc, fr, fq); S.done(cur); }
        PG8_STAMP();
        if (!has_next) break;
    E.init(acc, nxt, wr, wc, fr, fq);
        cur = nxt; cA = nA; cB = nB; ++ui;
    }
    PG8_WAIT_V(0);
    if (wr == 0) PG8_BAR;
    PG8_BAR;
    if constexpr (Epi::AFTER_DRAIN) { E.fused(acc, cur, wr, wc, fr, fq, lds, wid, lane); S.done(cur); }
    PG8_STAMP();
    if (STAMP && wid == 0) { stamps[lane] = lane < nts ? (((unsigned long long)(unsigned)ts_hi << 32) | (unsigned)ts_lo) : 0ull;
        if (lane == 62) stamps[62] = rt_entry; if (lane == 63) stamps[63] = (unsigned long long)wall_clock64(); }
#undef PG8_STAMP
#undef PG8_SA
#undef PG8_SB
#undef PG8_STAGE
#undef PG8_LDA
#undef PG8_LDB
#undef PG8_MMA
#undef PG8_WAIT_V
#undef PG8_WAIT_L
#undef PG8_BAR
#undef PG8_SCHED
}
}
using pg8::bf16_t; using pg8::bf16x8; using pg8::f32x4; using pg8::u32x4; using pg8::cvt_pk_bf16;
typedef unsigned u32x2 __attribute__((ext_vector_type(2)));
typedef float f32x2v __attribute__((ext_vector_type(2)));

constexpr int MT = 16896, MP = 16384;
constexpr size_t OFF_PROJ = 0;
constexpr size_t OFF_MIXED = 86507520;
constexpr size_t OFF_RW = 121110528;
constexpr size_t RWSZ = (size_t)MT * 256;
constexpr size_t OFF_Y = 224919552;
constexpr size_t OFF_UPT = OFF_Y, OFF_DOWNT = OFF_Y + 8388608;
constexpr size_t OFF_WINT = 242221056;
constexpr size_t OFF_WOUTT = 247463936;
constexpr size_t OFF_HST = 249561088;
constexpr size_t OFF_HD = 257949696;
constexpr size_t OFF_S5E = 258080768;
constexpr size_t OFF_C12 = 260177920;
constexpr size_t OFF_S5C = 261259264;
constexpr size_t OFF_CMT = OFF_S5C + 147456;
constexpr size_t OFF_GLUT = OFF_CMT + 65536;
constexpr size_t OFF_W2T = OFF_GLUT + 131072;
constexpr size_t OFF_A2T = OFF_W2T + 32768;
constexpr size_t OFF_G2T = OFF_A2T + 32768;
constexpr size_t OFF_PWT = OFF_G2T + 65536;
constexpr size_t OFF_LB = OFF_PWT + 32768;
constexpr size_t OFF_CTR = OFF_LB + 1024;
constexpr size_t OFF_HIDDEN = 0;
constexpr size_t OFF_XN2 = 138412032;
constexpr size_t OFF_BBT = OFF_CTR + 256;
constexpr size_t OFF_RSQ1 = OFF_BBT + 131072;
constexpr size_t OFF_RSQ2 = OFF_RSQ1 + 67584;
constexpr size_t OFF_HB1 = 173015040;
constexpr size_t CSTRIDE = 1048576;
constexpr size_t OFF_PART = 207618048;
constexpr size_t WS_END = OFF_RSQ2 + 67584;
constexpr size_t O_PSRE = 17301504, O_PSIM = O_PSRE + 16384, O_PHG = O_PSIM + 16384, O_PWKV = O_PHG + 262144, O_PSH = O_PWKV + 262144, O_PPOOL = O_PSH + 16384,
    O_SSRE = O_PPOOL + 61440, O_SSIM = O_SSRE + 262144, O_SHG = O_SSIM + 262144, O_SWKV = O_SHG + 4194304, O_SSH = O_SWKV + 4194304, O_SPOOL = O_SSH + 262144;
constexpr int LDS_BYTES = 147456;
constexpr int LDS_TASK_OFF = 146432;

struct Params { const float* in[40]; float* out; unsigned char* ws; };
#define AS4 __attribute__((address_space(4)))
struct KP { const AS4 char* k;
    __device__ __forceinline__ const float* in(int i) const { return *(const float* const AS4*)(k + 8 * i); }
    __device__ __forceinline__ float* out() const { return *(float* const AS4*)(k + 320); }
    __device__ __forceinline__ unsigned char* ws() const { return *(unsigned char* const AS4*)(k + 328); } };
__device__ __forceinline__ KP get_kp() { int z = 0; asm volatile("" : "+s"(z)); z = __builtin_amdgcn_readfirstlane(z); KP p; p.k = (const AS4 char*)__builtin_amdgcn_kernarg_segment_ptr() + z; return p; }

__device__ __forceinline__ float bf2f(bf16_t v) { return __uint_as_float(((unsigned)v) << 16); }
__device__ __forceinline__ float bflo(unsigned w) { return __uint_as_float(w << 16); }
__device__ __forceinline__ float bfhi(unsigned w) { return __uint_as_float(w & 0xffff0000u); }
__device__ __forceinline__ bf16_t f2bf(float f) { return (bf16_t)(cvt_pk_bf16(f, 0.f) & 0xffffu); }
__device__ __forceinline__ void unpack8(const u32x4 v, float* o) { o[0] = bflo(v.x); o[1] = bfhi(v.x); o[2] = bflo(v.y); o[3] = bfhi(v.y); o[4] = bflo(v.z); o[5] = bfhi(v.z); o[6] = bflo(v.w); o[7] = bfhi(v.w); }
__device__ __forceinline__ void unpack4(const u32x2 v, float* o) { o[0] = bflo(v.x); o[1] = bfhi(v.x); o[2] = bflo(v.y); o[3] = bfhi(v.y); }
__device__ __forceinline__ u32x2 pack4(const float* o) { u32x2 r; r.x = cvt_pk_bf16(o[0], o[1]); r.y = cvt_pk_bf16(o[2], o[3]); return r; }
__device__ __forceinline__ float sigm(float x) { return __builtin_amdgcn_rcpf(1.f + __expf(-x)); }
__device__ __forceinline__ float tanh_(float x) { return 1.f - 2.f * __builtin_amdgcn_rcpf(1.f + __expf(2.f * x)); }
__device__ __forceinline__ float gelu_t(float x) { return 0.5f * x * (1.f + tanh_(0.7978845608f * (x + 0.044715f * x * x * x))); }
__device__ __forceinline__ float shx(float v, int lane, int m) { return __int_as_float(__builtin_amdgcn_ds_bpermute((lane ^ m) << 2, __float_as_int(v))); }
__device__ __forceinline__ float wave_sum(float v, int lane) {
#pragma unroll
    for (int o = 1; o < 64; o <<= 1) v += shx(v, lane, o);
    return v; }
__device__ __forceinline__ void row_info(int r, int& b, int& t, bool& pr) { pr = r < MP; if (pr) { b = r >> 11; t = r & 2047; } else { b = (r - MP) >> 2; t = (r - MP) & 3; } }
#define MFMA16(a, b, c) __builtin_amdgcn_mfma_f32_16x16x32_bf16((a), (b), (c), 0, 0, 0)
#define LDSWAIT() asm volatile("s_waitcnt lgkmcnt(0)" ::: "memory")

__device__ __forceinline__ void transpose_item(const float* W, int K, int N, bf16_t* WT, float* scr, int item, int lane, const float* gk) {
    const int nblk = N >> 5, kb = item / nblk, nb = item - kb * nblk, k0 = kb << 6, n0 = nb << 5;
    float tv[32];
#pragma unroll
    for (int i = 0; i < 32; ++i) { const int kk = 2 * i + (lane >> 5); tv[i] = W[(size_t)(k0 + kk) * N + n0 + (lane & 31)]; }
    if (gk) {
#pragma unroll
        for (int i = 0; i < 32; ++i) tv[i] *= gk[k0 + 2 * i + (lane >> 5)]; }
#pragma unroll
    for (int i = 0; i < 32; ++i) { const int kk = 2 * i + (lane >> 5); scr[kk * 33 + (lane & 31)] = tv[i]; }
    LDSWAIT();
    const int c = lane & 7;
#pragma unroll
    for (int j = 0; j < 4; ++j) { const int n = (lane >> 3) + 8 * j; const float* s = scr + (8 * c) * 33 + n;
        u32x4 o; o.x = cvt_pk_bf16(s[0], s[33]); o.y = cvt_pk_bf16(s[66], s[99]); o.z = cvt_pk_bf16(s[132], s[165]); o.w = cvt_pk_bf16(s[198], s[231]);
        *(u32x4*)(WT + (size_t)(n0 + n) * K + k0 + 8 * c) = o; }
    LDSWAIT();
}
__device__ __forceinline__ void norm_rows(const KP& P, int l, int which) {
    const int tid = otid(), lane = tid & 63, wave = tid >> 6, gw = blockIdx.x * 8 + wave, NGW = gridDim.x * 8;
    const bool all = (which == 2) || (which == 0 && l == 0);
    const int nsplit = which == 1 ? 4 : ((which == 0 && l == 0) ? 0 : 8);
    const int rlo = all ? 0 : MP;
    bf16_t* HB = (bf16_t*)(P.ws() + (which == 0 ? OFF_HB1 : OFF_XN2));
    float* RSQ = (float*)(P.ws() + (which == 0 ? OFF_RSQ1 : OFF_RSQ2));
    f32x4 gg[4];
#pragma unroll
    for (int j = 0; j < 4; ++j) gg[j] = ((const f32x4*)P.in(39))[lane + 64 * j];
#pragma unroll 1
    for (int rb = rlo + gw; rb < MT; rb += 4 * NGW) {
        f32x4 v[4][4];
#pragma unroll
        for (int q = 0; q < 4; ++q) { const int r = rb + q * NGW;
            if (r < MT) { const float* src = P.out() + (size_t)r * 1024;
                if (l == 0 && which != 2 && !(which == 1 && false)) { if (which == 0 || which == 1) src = (r < MP) ? P.in(0) + (size_t)r * 1024 : P.in(1) + (size_t)(r - MP) * 1024; }
#pragma unroll
                for (int j = 0; j < 4; ++j) v[q][j] = ((const f32x4*)src)[lane + 64 * j];
                if (nsplit > 0 && r >= MP) { const float* pp = (const float*)(P.ws() + OFF_PART) + (size_t)(r - MP) * 1024;
#pragma unroll 1
                    for (int k0 = 0; k0 < nsplit; k0 += 4) { f32x4 pv[4][4];
#pragma unroll
                        for (int ks = 0; ks < 4; ++ks)
#pragma unroll
                            for (int j = 0; j < 4; ++j) pv[ks][j] = ((const f32x4*)(pp + (size_t)(k0 + ks) * 512 * 1024))[lane + 64 * j];
#pragma unroll
                        for (int ks = 0; ks < 4; ++ks)
#pragma unroll
                            for (int j = 0; j < 4; ++j) v[q][j] += pv[ks][j]; } } }
            else {
#pragma unroll
                for (int j = 0; j < 4; ++j) v[q][j] = (f32x4){0.f, 0.f, 0.f, 0.f}; } }
#pragma unroll
        for (int q = 0; q < 4; ++q) { const int r = rb + q * NGW; float s = 0.f;
#pragma unroll
            for (int j = 0; j < 4; ++j) s += v[q][j].x * v[q][j].x + v[q][j].y * v[q][j].y + v[q][j].z * v[q][j].z + v[q][j].w * v[q][j].w;
            s = wave_sum(s, lane);
            if (r < MT) { float* hrow = P.out() + (size_t)r * 1024;
                if (which == 2) { const float rstd = rsqrtf(s * (1.f / 1024.f) + 1e-6f);
#pragma unroll
                    for (int j = 0; j < 4; ++j) ((f32x4*)hrow)[lane + 64 * j] = v[q][j] * rstd * gg[j]; }
                else { if (lane == 0) RSQ[r] = s;
#pragma unroll
                    for (int j = 0; j < 4; ++j) { if (r >= MP && !(which == 0 && l == 0)) ((f32x4*)hrow)[lane + 64 * j] = v[q][j];
                        u32x2 w; w.x = cvt_pk_bf16(v[q][j].x, v[q][j].y); w.y = cvt_pk_bf16(v[q][j].z, v[q][j].w); *(u32x2*)(HB + (size_t)r * 1024 + (lane + 64 * j) * 4) = w; } } }
        }
    }
}
__device__ __forceinline__ void phaseA(const KP& P, int l0, unsigned char* smem) {
    const int l = l0;
    const int tid = otid(), lane = tid & 63, wave = tid >> 6, gw = blockIdx.x * 8 + wave, NGW = gridDim.x * 8;
#ifdef PROBE_SEL
    const unsigned long long a0_ = __builtin_amdgcn_s_memrealtime();
#endif
    norm_rows(P, l, 0);
#ifdef PROBE_SEL
    const unsigned long long a1_ = __builtin_amdgcn_s_memrealtime();
#endif
    float* scr = (float*)smem + wave * (64 * 33);
    if (l == 0) for (int it = gw; it < 1280; it += NGW) transpose_item(P.in(9), 1024, 2560, (bf16_t*)(P.ws() + OFF_WINT), scr, it, lane, P.in(8));
#ifdef PROBE_SEL
    const unsigned long long a2_ = __builtin_amdgcn_s_memrealtime();
#endif
    {
    const int gt = blockIdx.x * 512 + tid, NT = gridDim.x * 512;
    float* S5C = (float*)(P.ws() + OFF_S5C + l * CSTRIDE);
    for (int e = gt; e < 16384; e += NT) {
        const int idx = e >> 4, h = e & 15, g = idx >> 6, pp = idx & 63;
        const float lr = P.in(10)[l * 1024 + idx], li = P.in(11)[l * 1024 + idx], dt = expf(P.in(12)[l * 16 + g]);
        const float mag = expf(lr * dt); float sn, cs; sincosf(li * dt, &sn, &cs);
        const float abr = mag * cs, abi = mag * sn;
        if (h == 0) { const float magL = expf(64.f * lr * dt); float snL, csL; sincosf(64.f * li * dt, &snL, &csL);
            S5C[idx] = abr; S5C[1024 + idx] = abi; S5C[2048 + idx] = magL * csL; S5C[3072 + idx] = magL * snL; }
        const float den = lr * lr + li * li, zr = abr - 1.f, zi = abi;
        const float cr = (zr * lr + zi * li) / den, ci = (zi * lr - zr * li) / den;
        const float br = P.in(13)[((size_t)l * 1024 + idx) * 16 + h], bi = P.in(14)[((size_t)l * 1024 + idx) * 16 + h];
        bf16_t* BBT = (bf16_t*)(P.ws() + OFF_BBT + l * CSTRIDE);
        BBT[(g * 128 + pp) * 32 + h] = f2bf(cr * br - ci * bi); BBT[(g * 128 + 64 + pp) * 32 + h] = f2bf(cr * bi + ci * br); BBT[(g * 128 + pp) * 32 + 16 + h] = 0; BBT[(g * 128 + 64 + pp) * 32 + 16 + h] = 0;
    }
    bf16_t* CMT = (bf16_t*)(P.ws() + OFF_CMT + l * CSTRIDE);
    for (int idx = gt; idx < 32768; idx += NT) { const int gh = idx >> 7, pp = idx & 127;
        const float v = pp < 64 ? P.in(15)[((size_t)l * 256 + gh) * 64 + pp] : -P.in(16)[((size_t)l * 256 + gh) * 64 + pp - 64]; CMT[idx] = f2bf(v); }
    bf16_t* GLUT = (bf16_t*)(P.ws() + OFF_GLUT + l * CSTRIDE);
    for (int idx = gt; idx < 65536; idx += NT) { const int n = idx >> 8, k = idx & 255; GLUT[idx] = f2bf(P.in(18)[(size_t)l * 65536 + k * 256 + n]); }
    bf16_t* W2T = (bf16_t*)(P.ws() + OFF_W2T + l * CSTRIDE); bf16_t* A2T = (bf16_t*)(P.ws() + OFF_A2T + l * CSTRIDE); bf16_t* G2T = (bf16_t*)(P.ws() + OFF_G2T + l * CSTRIDE); bf16_t* PWT = (bf16_t*)(P.ws() + OFF_PWT + l * CSTRIDE);
    for (int idx = gt; idx < 16384; idx += NT) { const int c = idx >> 6, j = idx & 63;
        W2T[idx] = f2bf(P.in(24)[(size_t)l * 16384 + j * 256 + c]); A2T[idx] = f2bf(P.in(26)[(size_t)l * 16384 + j * 256 + c]);
        const int gi = idx >> 12, d = (idx >> 6) & 63, cc = idx & 63; PWT[idx] = f2bf(P.in(33)[(size_t)l * 16384 + gi * 4096 + cc * 64 + d]); }
    for (int idx = gt; idx < 32768; idx += NT) { const int c = idx >> 7, j = idx & 127; G2T[idx] = f2bf(P.in(27)[(size_t)l * 32768 + j * 256 + c]); }
    float* LB = (float*)(P.ws() + OFF_LB + l * CSTRIDE);
    for (int idx = gt; idx < 256; idx += NT) LB[idx] = (l == 0) ? 0.f : sigm(P.in(20)[256 + idx] - P.in(20)[idx]);
    }
#ifdef PROBE_SEL
    if (l == 0 && tid == 0 && (blockIdx.x == 0 || blockIdx.x == 100)) { float* sl = (float*)(P.ws() + OFF_CTR) + (blockIdx.x == 0 ? 56 : 60); const unsigned long long a3_ = __builtin_amdgcn_s_memrealtime();
        sl[0] = (float)(a1_ - a0_) * 0.01f; sl[1] = (float)(a2_ - a1_) * 0.01f; sl[2] = (float)(a3_ - a2_) * 0.01f; }
#endif
    if (blockIdx.x == 0 && tid == 0) { ((unsigned*)(P.ws() + OFF_CTR))[l] = 0u; ((unsigned*)(P.ws() + OFF_CTR))[2 + l] = 0u; }
}
__device__ __forceinline__ void phaseG(const KP& P, int l, unsigned char* smem) { norm_rows(P, l, 1); }

template <int MTW  > __device__ __forceinline__ void rwkv_prep_tile(const KP& P, int l, unsigned char* smem, int tile) {
    const int tid = otid(), lane = tid & 63, wave = tid >> 6, fr = lane & 15, fq = lane >> 4;
    const int r0 = tile * (32 * MTW);
    const bf16_t* PROJ = (const bf16_t*)(P.ws() + OFF_PROJ);
    bf16_t* MIXED = (bf16_t*)(P.ws() + OFF_MIXED);
    bf16_t* Aop = (bf16_t*)smem;
    const float* mu = P.in(22) + l * 1024;
    const float* shs = P.in(6) + (size_t)l * 128 * 1024;
    __syncthreads();
#pragma unroll 2
    for (int i = 0; i < 2 * MTW; ++i) {
        const int item = tid + 512 * i, tok = item >> 5, j0 = (item & 31) * 8, r = r0 + tok;
        int b, t; bool pr; row_info(r, b, t, pr);
        float p[8], q[8], o[8];
        unpack8(*(const u32x4*)(PROJ + (size_t)r * 2560 + 2048 + j0), p);
        if (t > 0) unpack8(*(const u32x4*)(PROJ + (size_t)(r - 1) * 2560 + 2048 + j0), q);
        else if (!pr) { const float* s = shs + (size_t)b * 1024 + 768 + j0;
#pragma unroll
            for (int e = 0; e < 8; ++e) q[e] = s[e]; }
        else {
#pragma unroll
            for (int e = 0; e < 8; ++e) q[e] = 0.f; }
#pragma unroll
        for (int e = 0; e < 8; ++e) { const float xs = p[e] + (q[e] - p[e]) * mu[768 + j0 + e]; o[e] = j0 < 64 ? tanh_(xs) : (j0 < 128 ? xs : sigm(xs)); }
        u32x4 w; w.x = cvt_pk_bf16(o[0], o[1]); w.y = cvt_pk_bf16(o[2], o[3]); w.z = cvt_pk_bf16(o[4], o[5]); w.w = cvt_pk_bf16(o[6], o[7]);
        *(u32x4*)(Aop + tok * 264 + j0) = w;
    }
    bf16_t* XS = (bf16_t*)(smem + 34816);
#pragma unroll 2
    for (int i = 0; i < 6 * MTW; ++i) {
        const int item = tid + 512 * i, tok = item / 96, j0 = (item - tok * 96) * 8, r = r0 + tok;
        int b, t; bool pr; row_info(r, b, t, pr);
        float p[8], q[8], o[8];
        unpack8(*(const u32x4*)(PROJ + (size_t)r * 2560 + 1280 + j0), p);
        if (t > 0) unpack8(*(const u32x4*)(PROJ + (size_t)(r - 1) * 2560 + 1280 + j0), q);
        else if (!pr) { const float* sp = shs + (size_t)b * 1024 + j0;
#pragma unroll
            for (int e = 0; e < 8; ++e) q[e] = sp[e]; }
        else {
#pragma unroll
            for (int e = 0; e < 8; ++e) q[e] = 0.f; }
#pragma unroll
        for (int e = 0; e < 8; ++e) o[e] = p[e] + (q[e] - p[e]) * mu[j0 + e];
        u32x4 w; w.x = cvt_pk_bf16(o[0], o[1]); w.y = cvt_pk_bf16(o[2], o[3]); w.z = cvt_pk_bf16(o[4], o[5]); w.w = cvt_pk_bf16(o[6], o[7]);
        *(u32x4*)(XS + tok * 776 + j0) = w;
    }
#pragma unroll 1
    for (int tok = 0; tok < 32 * MTW; ++tok) { const int r = r0 + tok; int b, t; bool pr; row_info(r, b, t, pr);
        if (pr ? (t == 2047) : (t == 3)) { float* dst = P.out() + (pr ? O_PSH + (size_t)(l * 8 + b) * 1024 : O_SSH + (size_t)(l * 128 + b) * 1024);
            for (int idx = tid; idx < 1024; idx += 512) dst[idx] = bf2f(PROJ[(size_t)r * 2560 + 1280 + idx]); } }
    __syncthreads();
    const int hd = wave & 3, th = wave >> 2;
    const bf16_t* W2T = (const bf16_t*)(P.ws() + OFF_W2T + l * CSTRIDE); const bf16_t* A2T = (const bf16_t*)(P.ws() + OFF_A2T + l * CSTRIDE); const bf16_t* G2T = (const bf16_t*)(P.ws() + OFF_G2T + l * CSTRIDE);
    f32x4 accw[4][MTW], acca[4][MTW], accg[4][MTW];
#pragma unroll
    for (int nt = 0; nt < 4; ++nt)
#pragma unroll
        for (int mt = 0; mt < MTW; ++mt) { accw[nt][mt] = (f32x4){0.f, 0.f, 0.f, 0.f}; acca[nt][mt] = accw[nt][mt]; accg[nt][mt] = accw[nt][mt]; }
#pragma unroll
    for (int nt = 0; nt < 4; ++nt) { const int n = hd * 64 + nt * 16 + fr;
#pragma unroll
        for (int ks = 0; ks < 2; ++ks) {
            const bf16x8 wf = *(const bf16x8*)(W2T + n * 64 + ks * 32 + fq * 8), af = *(const bf16x8*)(A2T + n * 64 + ks * 32 + fq * 8);
#pragma unroll
            for (int mt = 0; mt < MTW; ++mt) { const bf16_t* xr = Aop + (th * 16 * MTW + mt * 16 + fr) * 264 + ks * 32 + fq * 8;
                accw[nt][mt] = MFMA16(wf, *(const bf16x8*)xr, accw[nt][mt]); acca[nt][mt] = MFMA16(af, *(const bf16x8*)(xr + 64), acca[nt][mt]); } }
#pragma unroll
        for (int ks = 0; ks < 4; ++ks) { const bf16x8 gf = *(const bf16x8*)(G2T + n * 128 + ks * 32 + fq * 8);
#pragma unroll
            for (int mt = 0; mt < MTW; ++mt) accg[nt][mt] = MFMA16(gf, *(const bf16x8*)(Aop + (th * 16 * MTW + mt * 16 + fr) * 264 + 128 + ks * 32 + fq * 8), accg[nt][mt]); } }
    float* RW = (float*)(P.ws() + OFF_RW);
    float* C12 = (float*)(P.ws() + OFF_C12);
    const float* w0 = P.in(23) + l * 256; const float* a0 = P.in(25) + l * 256; const float* kkw = P.in(28) + l * 256; const float* kaw = P.in(29) + l * 256; const float* rkw = P.in(30) + l * 256;
#pragma unroll
    for (int mt = 0; mt < MTW; ++mt) {
        const int r = r0 + th * 16 * MTW + mt * 16 + fr; int b, t; bool pr; row_info(r, b, t, pr);
        float kkr[4][4], av[4][4], xrr[4][4]; float ss = 0.f, bs = 0.f, c2 = 0.f;
#pragma unroll
        for (int nt = 0; nt < 4; ++nt) {
            const int c0 = hd * 64 + nt * 16 + fq * 4;
            float xr4[4], xk4[4], xv4[4];
            { const bf16_t* xrow = XS + (th * 16 * MTW + mt * 16 + fr) * 776 + c0; unpack4(*(const u32x2*)(xrow), xr4); unpack4(*(const u32x2*)(xrow + 256), xk4); unpack4(*(const u32x2*)(xrow + 512), xv4); }
            f32x4 owr, ow, ok, ov; float gg[4];
#pragma unroll
            for (int j = 0; j < 4; ++j) { const int c = c0 + j;
                const float xr = xr4[j], xk = xk4[j], xv = xv4[j];
                const float wp = w0[c] + accw[nt][mt][j];
                const float nx = -wp;
                const float sp = fmaxf(nx, 0.f) + __logf(1.f + __expf(-fabsf(nx)));
                const float wv = -sp - 0.5f;
                const float dec = __expf(-__expf(wv));
                const float a = sigm(a0[c] + acca[nt][mt][j]);
                const float kr = xk * kkw[c]; ss += kr * kr;
                const float k = xk * (1.f + (a - 1.f) * kaw[c]);
                bs += xr * k * rkw[c]; c2 += xr * k;
                kkr[nt][j] = kr; av[nt][j] = a; xrr[nt][j] = xr;
                owr[j] = dec * xr; ow[j] = dec; ok[j] = k; ov[j] = xv; gg[j] = accg[nt][mt][j]; }
            const size_t o = (size_t)r * 256 + c0;
            *(f32x4*)(RW + 1 * RWSZ + o) = owr; *(f32x4*)(RW + 2 * RWSZ + o) = ow; *(f32x4*)(RW + 4 * RWSZ + o) = ok; *(f32x4*)(RW + 5 * RWSZ + o) = ov;
            *(u32x2*)(MIXED + (size_t)r * 1024 + 512 + c0) = pack4(gg);
        }
        ss += shx(ss, lane, 16); ss += shx(ss, lane, 32); bs += shx(bs, lane, 16); bs += shx(bs, lane, 32); c2 += shx(c2, lane, 16); c2 += shx(c2, lane, 32);
        const float inv = __builtin_amdgcn_rsqf(fmaxf(ss, 1e-24f)); float c1 = 0.f;
#pragma unroll
        for (int nt = 0; nt < 4; ++nt) { const int c0 = hd * 64 + nt * 16 + fq * 4; f32x4 okk, okka;
#pragma unroll
            for (int j = 0; j < 4; ++j) { const float kk = kkr[nt][j] * inv, kka = kk * av[nt][j]; okk[j] = kk; okka[j] = kka; c1 += kka * xrr[nt][j]; }
            const size_t o = (size_t)r * 256 + c0; *(f32x4*)(RW + 0 * RWSZ + o) = okk; *(f32x4*)(RW + 3 * RWSZ + o) = okka; }
        c1 += shx(c1, lane, 16); c1 += shx(c1, lane, 32);
        if (fq == 0) *(f32x4*)(C12 + (size_t)r * 16 + hd * 4) = (f32x4){c1, c2, bs, 0.f};
    }
}

__device__ __forceinline__ void pool_tile(const KP& P, int l, unsigned char* smem, int tile) {
    const int tid = otid(), lane = tid & 63, wave = tid >> 6, fr = lane & 15, fq = lane >> 4;
    const int r0 = tile * 64;
    const bf16_t* PROJ = (const bf16_t*)(P.ws() + OFF_PROJ);
    bf16_t* MIXED = (bf16_t*)(P.ws() + OFF_MIXED);
    bf16_t* Pop = (bf16_t*)smem;
    const float* pst = P.in(7) + (size_t)l * 128 * 15 * 256;
    __syncthreads();
#pragma unroll 2
    for (int i = 0; i < 4; ++i) {
        const int item = tid + 512 * i, tok = item >> 5, ch0 = (item & 31) * 8, r = r0 + tok, win = 2 << (ch0 >> 6);
        int b, t; bool pr; row_info(r, b, t, pr);
        float s[8], u[8];
#pragma unroll
        for (int e = 0; e < 8; ++e) { s[e] = 0.f; u[e] = 0.f; }
        if (pr) {
            u32x4 xv[16];
#pragma unroll
            for (int j = 0; j < 16; ++j) { xv[j] = (u32x4){0u, 0u, 0u, 0u}; if (j < win && t - j >= 0) xv[j] = *(const u32x4*)(PROJ + (size_t)(r - j) * 2560 + 2304 + ch0); }
#pragma unroll
            for (int j = 0; j < 16; ++j) { float x[8]; unpack8(xv[j], x);
#pragma unroll
                for (int e = 0; e < 8; ++e) { s[e] += x[e]; if (j == 0) u[e] = x[e]; } }
        } else {
            for (int j = 0; j < win; ++j) { const int tt = t - j; float x[8];
                if (tt >= 0) unpack8(*(const u32x4*)(PROJ + (size_t)(r - j) * 2560 + 2304 + ch0), x);
                else { const float* bp = pst + ((size_t)b * 15 + 15 + tt) * 256 + ch0;
#pragma unroll
                    for (int e = 0; e < 8; ++e) x[e] = bp[e]; }
                if (j == 0) {
#pragma unroll
                    for (int e = 0; e < 8; ++e) u[e] = x[e]; }
#pragma unroll
                for (int e = 0; e < 8; ++e) s[e] += x[e]; }
        }
        const float cnt = pr ? (float)min(t + 1, win) : (float)win, ic = 1.f / cnt; float o[8];
#pragma unroll
        for (int e = 0; e < 8; ++e) o[e] = s[e] * ic - u[e];
        u32x4 w; w.x = cvt_pk_bf16(o[0], o[1]); w.y = cvt_pk_bf16(o[2], o[3]); w.z = cvt_pk_bf16(o[4], o[5]); w.w = cvt_pk_bf16(o[6], o[7]);
        *(u32x4*)(Pop + tok * 264 + ch0) = w;
    }
    if (r0 < MP) { if ((r0 & 2047) == 1984) { const int b = r0 >> 11; float* dst = P.out() + O_PPOOL + (size_t)(l * 8 + b) * 3840;
            for (int idx = tid; idx < 3840; idx += 512) { const int j = idx >> 8, ch = idx & 255; dst[idx] = bf2f(PROJ[(size_t)(b * 2048 + 2033 + j) * 2560 + 2304 + ch]); } } }
    else { const int b0 = (r0 - MP) >> 2;
        for (int idx = tid; idx < 16 * 3840; idx += 512) { const int bb = idx / 3840, rem = idx - bb * 3840, j = rem >> 8, ch = rem & 255, b = b0 + bb;
            const float v = j < 11 ? pst[((size_t)b * 15 + j + 4) * 256 + ch] : bf2f(PROJ[(size_t)(MP + b * 4 + j - 11) * 2560 + 2304 + ch]);
            P.out()[O_SPOOL + (size_t)(l * 128 + b) * 3840 + rem] = v; } }
    __syncthreads();
    const bf16_t* PWT = (const bf16_t*)(P.ws() + OFF_PWT + l * CSTRIDE);
    const float* scale = P.in(34) + l * 256;
    f32x4 acc[2][4];
#pragma unroll
    for (int nt = 0; nt < 2; ++nt)
#pragma unroll
        for (int mt = 0; mt < 4; ++mt) acc[nt][mt] = (f32x4){0.f, 0.f, 0.f, 0.f};
#pragma unroll
    for (int nt = 0; nt < 2; ++nt) { const int n0 = wave * 32 + nt * 16, gi = n0 >> 6;
#pragma unroll
        for (int ks = 0; ks < 2; ++ks) { const bf16x8 wf = *(const bf16x8*)(PWT + (n0 + fr) * 64 + ks * 32 + fq * 8);
#pragma unroll
            for (int mt = 0; mt < 4; ++mt) acc[nt][mt] = MFMA16(wf, *(const bf16x8*)(Pop + (mt * 16 + fr) * 264 + gi * 64 + ks * 32 + fq * 8), acc[nt][mt]); } }
#pragma unroll
    for (int nt = 0; nt < 2; ++nt)
#pragma unroll
        for (int mt = 0; mt < 4; ++mt) { const int r = r0 + mt * 16 + fr, ch = wave * 32 + nt * 16 + fq * 4; float o[4];
#pragma unroll
            for (int j = 0; j < 4; ++j) o[j] = acc[nt][mt][j] * scale[ch + j];
            *(u32x2*)(MIXED + (size_t)r * 1024 + 768 + ch) = pack4(o); }
}

__device__ __forceinline__ void s5_task(const KP& P, int l, unsigned char* smem, int mode, int tile) {
    const int tid = otid(), lane = tid & 63, wave = tid >> 6, fr = lane & 15, fq = lane >> 4;
    const bool prompt = tile < 256;
    const int b = tile >> 5, c = tile & 31, st8 = tile - 256;
    const int r0 = prompt ? b * 2048 + c * 64 : MP + st8 * 64, b0 = st8 * 16;
    const bf16_t* PROJ = (const bf16_t*)(P.ws() + OFF_PROJ);
    bf16_t* MIXED = (bf16_t*)(P.ws() + OFF_MIXED);
    bf16_t* U = (bf16_t*)smem;
    bf16_t* Zb = (bf16_t*)(smem + 32768);
    float* BU = (float*)(smem + 32768 + 33792 + wave * 8448);
    __syncthreads();
#pragma unroll
    for (int i = 0; i < 4; ++i) { const int item = tid + 512 * i, tok = item >> 5, j0 = (item & 31) * 8;
        *(u32x4*)(U + tok * 256 + j0) = *(const u32x4*)(PROJ + (size_t)(r0 + tok) * 2560 + j0); }
    __syncthreads();
    const float* S5C = (const float*)(P.ws() + OFF_S5C + l * CSTRIDE);
    const bf16_t* CMT = (const bf16_t*)(P.ws() + OFF_CMT + l * CSTRIDE);
    const bf16_t* BBT = (const bf16_t*)(P.ws() + OFF_BBT + l * CSTRIDE);
    float* S5E = (float*)(P.ws() + OFF_S5E);
    const float* dsk = P.in(17) + l * 256;
#pragma unroll 1
    for (int gg = 0; gg < 2; ++gg) {
        const int g = 2 * wave + gg, gp = g * 64 + lane;
        const float ar = S5C[gp], ai = S5C[1024 + gp];
        float hr = 0.f, hi = 0.f;
        if (prompt && mode == 1) { const float alr = S5C[2048 + gp], ali = S5C[3072 + gp];
#pragma unroll 1
            for (int j0 = 0; j0 < c; j0 += 8) { f32x2v e[8];
#pragma unroll
                for (int jj = 0; jj < 8; ++jj) e[jj] = (j0 + jj < c) ? *(const f32x2v*)(S5E + ((size_t)((b * 32 + j0 + jj) * 16 + g) * 64 + lane) * 2) : (f32x2v){0.f, 0.f};
#pragma unroll
                for (int jj = 0; jj < 8; ++jj) if (j0 + jj < c) { const float nr = alr * hr - ali * hi + e[jj].x, ni = alr * hi + ali * hr + e[jj].y; hr = nr; hi = ni; } } }
        bf16x8 bfr[8], cfr[4];
#pragma unroll
        for (int pt = 0; pt < 8; ++pt) bfr[pt] = *(const bf16x8*)(BBT + (g * 128 + pt * 16 + fr) * 32 + fq * 8);
        if (mode == 1) {
#pragma unroll
            for (int ks = 0; ks < 4; ++ks) cfr[ks] = *(const bf16x8*)(CMT + (g * 16 + fr) * 128 + ks * 32 + fq * 8); }
        const f32x4 dsk4 = *(const f32x4*)(dsk + g * 16 + fq * 4);
#pragma unroll 1
        for (int st = 0; st < 4; ++st) {
            { bf16x8 uf = (bf16x8){0, 0, 0, 0, 0, 0, 0, 0};
              if (fq < 2) uf = *(const bf16x8*)(U + (st * 16 + fr) * 256 + g * 16 + fq * 8);
#pragma unroll
              for (int pt = 0; pt < 8; ++pt) { const f32x4 d = MFMA16(bfr[pt], uf, ((f32x4){0.f, 0.f, 0.f, 0.f})); *(f32x4*)(BU + fr * 132 + pt * 16 + fq * 4) = d; } }
            if (prompt) {
                float bur = BU[lane], bui = BU[64 + lane];
#pragma unroll
                for (int tt = 0; tt < 16; ++tt) {
                    const float nbr = BU[((tt + 1) & 15) * 132 + lane], nbi = BU[((tt + 1) & 15) * 132 + 64 + lane];
                    const float nr = ar * hr - ai * hi + bur, ni = ar * hi + ai * hr + bui; hr = nr; hi = ni; bur = nbr; bui = nbi;
                    if (mode == 1) { bf16_t* hb = (bf16_t*)(BU + tt * 132); hb[lane] = f2bf(hr); hb[64 + lane] = f2bf(hi); } }
            } else {
#pragma unroll 4
                for (int tt = 0; tt < 16; ++tt) { const int t = st * 16 + tt;
                    if ((t & 3) == 0) { const size_t so = ((size_t)(l * 128 + b0 + (t >> 2)) * 16 + g) * 64 + lane; hr = P.in(2)[so]; hi = P.in(3)[so]; }
                    const float bur = BU[tt * 132 + lane], bui = BU[tt * 132 + 64 + lane];
                    const float nr = ar * hr - ai * hi + bur, ni = ar * hi + ai * hr + bui; hr = nr; hi = ni;
                    bf16_t* hb = (bf16_t*)(BU + tt * 132); hb[lane] = f2bf(hr); hb[64 + lane] = f2bf(hi);
                    if ((t & 3) == 3) { const size_t so = ((size_t)(l * 128 + b0 + (t >> 2)) * 16 + g) * 64 + lane; P.out()[O_SSRE + so] = hr; P.out()[O_SSIM + so] = hi; } }
            }
            if (mode == 1) {
                f32x4 acc = (f32x4){0.f, 0.f, 0.f, 0.f};
#pragma unroll
                for (int ks = 0; ks < 4; ++ks) acc = MFMA16(cfr[ks], *(const bf16x8*)((const bf16_t*)(BU + fr * 132) + ks * 32 + fq * 8), acc);
                const int t = st * 16 + fr, ch = g * 16 + fq * 4; float u4[4], z[4];
                unpack4(*(const u32x2*)(U + t * 256 + ch), u4);
#pragma unroll
                for (int j = 0; j < 4; ++j) z[j] = gelu_t(acc[j] + dsk4[j] * u4[j]);
                *(u32x2*)(Zb + t * 264 + ch) = pack4(z);
            }
        }
        if (prompt && mode == 1 && c == 31) { const size_t so = ((size_t)(l * 8 + b) * 16 + g) * 64 + lane; P.out()[O_PSRE + so] = hr; P.out()[O_PSIM + so] = hi; }
        if (mode == 0) *(f32x2v*)(S5E + ((size_t)((b * 32 + c) * 16 + g) * 64 + lane) * 2) = (f32x2v){hr, hi};
    }
    if (mode == 1) {
        __syncthreads();
        const bf16_t* GLUT = (const bf16_t*)(P.ws() + OFF_GLUT + l * CSTRIDE);
        const float* gb = P.in(19) + l * 256;
        f32x4 acc[2][4];
#pragma unroll
        for (int nt = 0; nt < 2; ++nt)
#pragma unroll
            for (int mt = 0; mt < 4; ++mt) acc[nt][mt] = (f32x4){0.f, 0.f, 0.f, 0.f};
#pragma unroll
        for (int ks = 0; ks < 8; ++ks)
#pragma unroll
            for (int nt = 0; nt < 2; ++nt) { const bf16x8 wf = *(const bf16x8*)(GLUT + (wave * 32 + nt * 16 + fr) * 256 + ks * 32 + fq * 8);
#pragma unroll
                for (int mt = 0; mt < 4; ++mt) acc[nt][mt] = MFMA16(wf, *(const bf16x8*)(Zb + (mt * 16 + fr) * 264 + ks * 32 + fq * 8), acc[nt][mt]); }
#pragma unroll
        for (int nt = 0; nt < 2; ++nt)
#pragma unroll
            for (int mt = 0; mt < 4; ++mt) { const int tok = mt * 16 + fr, ch = wave * 32 + nt * 16 + fq * 4; float z4[4], o[4];
                unpack4(*(const u32x2*)(Zb + tok * 264 + ch), z4);
#pragma unroll
                for (int j = 0; j < 4; ++j) o[j] = z4[j] * sigm(acc[nt][mt][j] + gb[ch + j]);
                *(u32x2*)(MIXED + (size_t)(r0 + tok) * 1024 + ch) = pack4(o); }
    }
}

__device__ __forceinline__ void hgrn_task(const KP& P, int l, unsigned char* smem, int mode, int b, int hd, int sc) {
    const int tid = otid(), lane = tid & 63, wave = tid >> 6, fr = lane & 15, fq = lane >> 4;
    const bf16_t* PROJ = (const bf16_t*)(P.ws() + OFF_PROJ);
    bf16_t* MIXED = (bf16_t*)(P.ws() + OFF_MIXED);
    bf16_t* Qp = (bf16_t*)smem;
    bf16_t* Kn = Qp + 32 * 72;
    bf16_t* Kdt = Kn + 32 * 72;
    bf16_t* Vt = Kdt + 64 * 40;
    bf16_t* Att = Vt + 64 * 40;
    bf16_t* St = Att + 32 * 40;
    float* TOT = (float*)(St + 64 * 72);
    float* EB = TOT + 512;
    float* HST = (float*)(P.ws() + OFF_HST); float* HD = (float*)(P.ws() + OFF_HD);
    const int k = tid & 63, sg = tid >> 6, kt = wave >> 1, vt0 = (wave & 1) * 2;
    const float lbv = ((const float*)(P.ws() + OFF_LB + l * CSTRIDE))[hd * 64 + k];
    f32x4 accS[2] = {(f32x4){0.f, 0.f, 0.f, 0.f}, (f32x4){0.f, 0.f, 0.f, 0.f}};
    if (mode == 1) {
#pragma unroll 1
        for (int j0 = 0; j0 < sc; j0 += 4) { float dd[4][4], xx[4][2][4];
#pragma unroll
            for (int u = 0; u < 4; ++u) { const size_t bi = (size_t)((b * 4 + hd) * 16 + min(j0 + u, sc - 1));
#pragma unroll
                for (int jj = 0; jj < 4; ++jj) { const int kk = kt * 16 + fq * 4 + jj; dd[u][jj] = HD[bi * 64 + kk];
#pragma unroll
                    for (int i = 0; i < 2; ++i) xx[u][i][jj] = HST[(bi * 64 + kk) * 64 + (vt0 + i) * 16 + fr]; } }
#pragma unroll
            for (int u = 0; u < 4; ++u) if (j0 + u < sc) {
#pragma unroll
                for (int jj = 0; jj < 4; ++jj)
#pragma unroll
                    for (int i = 0; i < 2; ++i) accS[i][jj] = dd[u][jj] * accS[i][jj] + xx[u][i][jj]; } }
    } else if (mode == 2) { const float* sp = P.in(4) + ((size_t)(l * 128 + b) * 4 + hd) * 4096;
#pragma unroll
        for (int jj = 0; jj < 4; ++jj)
#pragma unroll
            for (int i = 0; i < 2; ++i) accS[i][jj] = sp[(kt * 16 + fq * 4 + jj) * 64 + (vt0 + i) * 16 + fr]; }
    __syncthreads();
    if (mode != 0) {
#pragma unroll
        for (int i = 0; i < 2; ++i) { float t4[4] = {accS[i][0], accS[i][1], accS[i][2], accS[i][3]}; *(u32x2*)(St + ((vt0 + i) * 16 + fr) * 72 + kt * 16 + fq * 4) = pack4(t4); } }
    float dsum = 0.f;
    const int nch = mode == 2 ? 1 : 4, L = mode == 2 ? 4 : 32;
    const int rbase = mode == 2 ? MP + b * 4 : b * 2048 + sc * 128;
    bf16_t rz[4], rq[4], rv[4];
#pragma unroll
    for (int e = 0; e < 4; ++e) { const int s = 4 * sg + e; rz[e] = 0; rq[e] = 0; rv[e] = 0;
        if (s < L) { const bf16_t* row = PROJ + (size_t)(rbase + s) * 2560 + hd * 64 + k; rz[e] = row[512]; rq[e] = row[256]; rv[e] = row[768]; } }
    f32x4 ngv[4];
#pragma unroll
    for (int vt = 0; vt < 4; ++vt) ngv[vt] = *(const f32x4*)(P.in(21) + l * 256 + hd * 64 + vt * 16 + fq * 4);
#pragma unroll 1
    for (int ch = 0; ch < nch; ++ch) {
        const int r0 = rbase + ch * 32;
        bf16_t nz[4], nq[4], nv[4];
#pragma unroll
        for (int e = 0; e < 4; ++e) { nz[e] = 0; nq[e] = 0; nv[e] = 0;
            if (ch + 1 < nch) { const bf16_t* row = PROJ + (size_t)(r0 + 32 + 4 * sg + e) * 2560 + hd * 64 + k; nz[e] = row[512]; nq[e] = row[256]; nv[e] = row[768]; } }
        u32x2 pgv[4];
#pragma unroll
        for (int vt = 0; vt < 4; ++vt) { pgv[vt] = (u32x2){0u, 0u}; if (mode != 0 && wave < 2 && wave * 16 + fr < L) pgv[vt] = *(const u32x2*)(PROJ + (size_t)(r0 + wave * 16 + fr) * 2560 + 1024 + hd * 64 + vt * 16 + fq * 4); }
        float lf[4], kv[4], q[4], vv[4], cs[4];
#pragma unroll
        for (int e = 0; e < 4; ++e) { const int s = 4 * sg + e; lf[e] = 0.f; kv[e] = 0.f; q[e] = 0.f; vv[e] = 0.f;
            if (s < L) { const float z = bf2f(rz[e]); const float f = lbv + (1.f - lbv) * sigm(z); lf[e] = __logf(f); kv[e] = 1.f - f;
                if (mode != 0) { const float pq = bf2f(rq[e]); q[e] = pq * sigm(pq); }
                vv[e] = bf2f(rv[e]); } }
#pragma unroll
        for (int e = 0; e < 4; ++e) { rz[e] = nz[e]; rq[e] = nq[e]; rv[e] = nv[e]; }
        cs[0] = lf[0]; cs[1] = cs[0] + lf[1]; cs[2] = cs[1] + lf[2]; cs[3] = cs[2] + lf[3];
        TOT[sg * 64 + k] = cs[3];
        __syncthreads();
        float off = 0.f, blast = 0.f;
#pragma unroll
        for (int j = 0; j < 8; ++j) { const float tj = TOT[j * 64 + k]; if (j < sg) off += tj; blast += tj; }
        { float kd4[4];
#pragma unroll
            for (int e = 0; e < 4; ++e) { const int s = 4 * sg + e; const float bsv = off + cs[e];
                Qp[s * 72 + k] = f2bf(q[e] * __expf(bsv)); Kn[s * 72 + k] = f2bf(kv[e] * __expf(-bsv)); kd4[e] = kv[e] * __expf(blast - bsv); }
            *(u32x2*)(Kdt + k * 40 + 4 * sg) = pack4(kd4); *(u32x2*)(Vt + k * 40 + 4 * sg) = pack4(vv); }
        if (sg == 0) { EB[k] = __expf(blast); dsum += blast; }
        __syncthreads();
        { const f32x4 eb = *(const f32x4*)(EB + kt * 16 + fq * 4); const bf16x8 af = *(const bf16x8*)(Kdt + (kt * 16 + fr) * 40 + fq * 8);
#pragma unroll
            for (int i = 0; i < 2; ++i) { accS[i] = accS[i] * eb; accS[i] = MFMA16(af, *(const bf16x8*)(Vt + ((vt0 + i) * 16 + fr) * 40 + fq * 8), accS[i]); } }
        if (mode != 0) {
            if (wave < 4) { const int tt = wave >> 1, st = wave & 1; f32x4 a = (f32x4){0.f, 0.f, 0.f, 0.f};
                if (st <= tt) {
#pragma unroll
                    for (int ks = 0; ks < 2; ++ks) a = MFMA16(*(const bf16x8*)(Kn + (st * 16 + fr) * 72 + ks * 32 + fq * 8), *(const bf16x8*)(Qp + (tt * 16 + fr) * 72 + ks * 32 + fq * 8), a);
                    float m4[4];
#pragma unroll
                    for (int j = 0; j < 4; ++j) m4[j] = (st * 16 + fq * 4 + j <= tt * 16 + fr) ? a[j] : 0.f;
                    *(u32x2*)(Att + (tt * 16 + fr) * 40 + st * 16 + fq * 4) = pack4(m4);
                } else { *(u32x2*)(Att + (tt * 16 + fr) * 40 + st * 16 + fq * 4) = (u32x2){0u, 0u}; } }
            __syncthreads();
            if (wave < 2) { const int tt = wave; f32x4 o[4]; float ss = 0.f;
                const bf16x8 attf = *(const bf16x8*)(Att + (tt * 16 + fr) * 40 + fq * 8), q0 = *(const bf16x8*)(Qp + (tt * 16 + fr) * 72 + fq * 8), q1 = *(const bf16x8*)(Qp + (tt * 16 + fr) * 72 + 32 + fq * 8);
#pragma unroll
                for (int vt = 0; vt < 4; ++vt) { f32x4 a = MFMA16(*(const bf16x8*)(Vt + (vt * 16 + fr) * 40 + fq * 8), attf, ((f32x4){0.f, 0.f, 0.f, 0.f}));
                    a = MFMA16(*(const bf16x8*)(St + (vt * 16 + fr) * 72 + fq * 8), q0, a); a = MFMA16(*(const bf16x8*)(St + (vt * 16 + fr) * 72 + 32 + fq * 8), q1, a);
                    o[vt] = a; ss += a.x * a.x + a.y * a.y + a.z * a.z + a.w * a.w; }
                ss += shx(ss, lane, 16); ss += shx(ss, lane, 32);
                const float rn = rsqrtf(ss * (1.f / 64.f) + 1e-5f); const int t = tt * 16 + fr;
                if (t < L) { const int r = r0 + t;
#pragma unroll
                    for (int vt = 0; vt < 4; ++vt) { const int ci = hd * 64 + vt * 16 + fq * 4; const f32x4 ng = ngv[vt]; float pg[4], ov[4];
                        unpack4(pgv[vt], pg);
#pragma unroll
                        for (int j = 0; j < 4; ++j) ov[j] = o[vt][j] * rn * ng[j] * (pg[j] * sigm(pg[j]));
                        *(u32x2*)(MIXED + (size_t)r * 1024 + 256 + ci) = pack4(ov); } } }
            __syncthreads();
#pragma unroll
            for (int i = 0; i < 2; ++i) { float t4[4] = {accS[i][0], accS[i][1], accS[i][2], accS[i][3]}; *(u32x2*)(St + ((vt0 + i) * 16 + fr) * 72 + kt * 16 + fq * 4) = pack4(t4); }
        }
    }
    float* dst = nullptr;
    if (mode == 0) { const size_t bi = (size_t)((b * 4 + hd) * 16 + sc); dst = HST + bi * 4096; if (sg == 0) HD[bi * 64 + k] = __expf(dsum); }
    else if (mode == 1) { if (sc == 15) dst = P.out() + O_PHG + ((size_t)(l * 8 + b) * 4 + hd) * 4096; }
    else dst = P.out() + O_SHG + ((size_t)(l * 128 + b) * 4 + hd) * 4096;
    if (dst) {
#pragma unroll
        for (int jj = 0; jj < 4; ++jj)
#pragma unroll
            for (int i = 0; i < 2; ++i) dst[(kt * 16 + fq * 4 + jj) * 64 + (vt0 + i) * 16 + fr] = accS[i][jj]; }
    __syncthreads();
}

template <int CTRL> __device__ __forceinline__ float dpp_add(float x) { return x + __int_as_float(__builtin_amdgcn_update_dpp(0, __float_as_int(x), CTRL, 0xF, 0xF, false)); }
__device__ __forceinline__ float row16_sum(float x) { x = dpp_add<0xB1>(x); x = dpp_add<0x4E>(x); x = dpp_add<0x141>(x); x = dpp_add<0x140>(x); return x; }
#ifndef SCAN_EVEN
#define SCAN_EVEN 0
#endif
#if SCAN_EVEN
#define SCAN_LOADER(w) (((w) & 1) != 0)
#define SCAN_IDX(w) ((w) >> 1)
#else
#define SCAN_LOADER(w) ((w) >= 4)
#define SCAN_IDX(w) ((w) & 3)
#endif
__device__ __forceinline__ void rwkv_scan_task(const KP& P, int l, unsigned char* smem, bool prompt, int b, int hd, int rq) {
    const int tid = otid(), lane = tid & 63, wave = tid >> 6;
    const int T = prompt ? 2048 : 4, row0 = prompt ? b * 2048 : MP + b * 4;
    const float* RW = (const float*)(P.ws() + OFF_RW);
    const float* C12 = (const float*)(P.ws() + OFF_C12);
    unsigned char* Yb = P.ws() + OFF_PROJ + 2560;
    constexpr int BUFF = 32 * 340;
    float* buf = (float*)smem;
    const bool loader = SCAN_LOADER(wave);
    const int sw = SCAN_IDX(wave), ltid = sw * 64 + lane;
    const int rr = lane >> 4, i4 = (lane & 15) * 4, srow = rq * 16 + sw * 4 + rr;
    f32x4 S = (f32x4){0.f, 0.f, 0.f, 0.f};
    if (!loader && !prompt) S = *(const f32x4*)(P.in(5) + (((size_t)(l * 128 + b) * 4 + hd) * 64 + srow) * 64 + i4);
    const int nchunks = (T + 31) >> 5;
    __syncthreads();
#pragma unroll 1
    for (int c = -1; c < nchunks; ++c) {
        if (loader) {
            if (c + 1 < nchunks) { const int t0 = (c + 1) * 32, n = min(32, T - t0); float* bw = buf + ((c + 1) & 1) * BUFF;
                f32x4 x[5][2]; float vx[2]; float cx = 0.f;
#pragma unroll
                for (int i = 0; i < 2; ++i) { const int idx = ltid + 256 * i, stp = idx >> 4, q = idx & 15; const size_t o = (size_t)(row0 + t0 + stp) * 256 + hd * 64 + q * 4;
#pragma unroll
                    for (int vct = 0; vct < 5; ++vct) x[vct][i] = (stp < n) ? *(const f32x4*)(RW + vct * RWSZ + o) : (f32x4){0.f, 0.f, 0.f, 0.f};
                    vx[i] = (stp < n) ? RW[5 * RWSZ + (size_t)(row0 + t0 + stp) * 256 + hd * 64 + rq * 16 + q] : 0.f; }
                if (ltid < 64) { const int stp = ltid >> 1; if (stp < n) cx = C12[(size_t)(row0 + t0 + stp) * 16 + hd * 4 + (ltid & 1)]; }
#pragma unroll
                for (int i = 0; i < 2; ++i) { const int idx = ltid + 256 * i, stp = idx >> 4, q = idx & 15;
#pragma unroll
                    for (int vct = 0; vct < 5; ++vct) *(f32x4*)(bw + vct * 2048 + stp * 64 + q * 4) = x[vct][i];
                    bw[10240 + stp * 16 + q] = vx[i]; }
                if (ltid < 64) bw[10752 + (ltid >> 1) * 4 + (ltid & 1)] = cx;
            }
        } else if (c >= 0) {
            __builtin_amdgcn_s_setprio(3);
            const int t0 = c * 32; const float* br = buf + (c & 1) * BUFF;
#define SCAN_LD(s_, kk_, wr_, w_, kka_, kv_, v_, cc_) do { kk_ = *(const f32x4*)(br + (s_) * 64 + i4); wr_ = *(const f32x4*)(br + 2048 + (s_) * 64 + i4); w_ = *(const f32x4*)(br + 4096 + (s_) * 64 + i4); \
                kka_ = *(const f32x4*)(br + 6144 + (s_) * 64 + i4); kv_ = *(const f32x4*)(br + 8192 + (s_) * 64 + i4); v_ = br[10240 + (s_) * 16 + sw * 4 + rr]; cc_ = *(const f32x2v*)(br + 10752 + (s_) * 4); } while (0)
            f32x4 kk, wr, w, kka, kv; float v; f32x2v cc;
            f32x4 kk1, wr1, w1, kka1, kv1; float v1; f32x2v cc1;
            SCAN_LD(0, kk, wr, w, kka, kv, v, cc); SCAN_LD(1, kk1, wr1, w1, kka1, kv1, v1, cc1);
#pragma unroll 1
            for (int sb = 0; sb < 32; sb += 16) {
                float ysel = 0.f;
#pragma unroll
                for (int s2 = 0; s2 < 16; ++s2) { const int s = sb + s2;
                    f32x4 kk2, wr2, w2, kka2, kv2; float v2; f32x2v cc2;
                    SCAN_LD(s + 2, kk2, wr2, w2, kka2, kv2, v2, cc2);
                    asm volatile("" ::: "memory");
                    const f32x2v S01 = (f32x2v){S.x, S.y}, S23 = (f32x2v){S.z, S.w};
                    f32x2v d1 = S01 * (f32x2v){kk.x, kk.y}; d1 = __builtin_elementwise_fma(S23, (f32x2v){kk.z, kk.w}, d1);
                    f32x2v d2 = S01 * (f32x2v){wr.x, wr.y}; d2 = __builtin_elementwise_fma(S23, (f32x2v){wr.z, wr.w}, d2);
                    float p1 = d1.x + d1.y, p2 = d2.x + d2.y;
                    p1 = row16_sum(p1); p2 = row16_sum(p2);
                    const float sa = -p1, y = p2 + sa * cc.x + v * cc.y;
                    S = S * w + sa * kka + v * kv;
                    ysel = ((lane & 15) == s2) ? y : ysel;
                    kk = kk1; wr = wr1; w = w1; kka = kka1; kv = kv1; v = v1; cc = cc1;
                    kk1 = kk2; wr1 = wr2; w1 = w2; kka1 = kka2; kv1 = kv2; v1 = v2; cc1 = cc2; }
                ((float*)(Yb + (size_t)(row0 + t0 + sb + (lane & 15)) * 5120))[hd * 64 + srow] = ysel;
            }
#undef SCAN_LD
            __builtin_amdgcn_s_setprio(0);
        }
        __syncthreads();
    }
    if (!loader) { float* dst = P.out() + (prompt ? O_PWKV + (((size_t)(l * 8 + b) * 4 + hd) * 64 + srow) * 64 : O_SWKV + (((size_t)(l * 128 + b) * 4 + hd) * 64 + srow) * 64) + i4; *(f32x4*)dst = S; }
}

__device__ __forceinline__ void rwkv_sample_wave(const KP& P, int l, unsigned char* smem, int b, int hd, int half) {
    const int tid = otid(), lane = tid & 63, wave = tid >> 6;
    const float* RW = (const float*)(P.ws() + OFF_RW); const float* C12 = (const float*)(P.ws() + OFF_C12); unsigned char* Yb = P.ws() + OFF_PROJ + 2560;
    float* wl = (float*)smem + wave * 1600;
    const int srow = half * 32 + (lane >> 1), kh = (lane & 1) * 32;
    float S[32];
    { const float* sp = P.in(5) + (((size_t)(l * 128 + b) * 4 + hd) * 64 + srow) * 64 + kh;
#pragma unroll
        for (int q = 0; q < 8; ++q) { const f32x4 x = *(const f32x4*)(sp + 4 * q); S[4 * q] = x.x; S[4 * q + 1] = x.y; S[4 * q + 2] = x.z; S[4 * q + 3] = x.w; } }
#pragma unroll
    for (int st = 0; st < 4; ++st) { const size_t r = (size_t)(MP + b * 4 + st);
#pragma unroll
        for (int vct = 0; vct < 6; ++vct) wl[st * 400 + vct * 64 + lane] = RW[vct * RWSZ + r * 256 + hd * 64 + lane];
        if (lane < 2) wl[st * 400 + 384 + lane] = C12[r * 16 + hd * 4 + lane]; }
    LDSWAIT();
#pragma unroll 1
    for (int st = 0; st < 4; ++st) { const float* w5 = wl + st * 400; float p1 = 0.f, p2 = 0.f;
#pragma unroll
        for (int q = 0; q < 8; ++q) { const f32x4 kk = *(const f32x4*)(w5 + kh + 4 * q), wr = *(const f32x4*)(w5 + 64 + kh + 4 * q);
#pragma unroll
            for (int j = 0; j < 4; ++j) { p1 += S[4 * q + j] * kk[j]; p2 += S[4 * q + j] * wr[j]; } }
        p1 = dpp_add<0xB1>(p1); p2 = dpp_add<0xB1>(p2);
        const float sa = -p1, v = w5[320 + srow], c1 = w5[384], c2 = w5[385];
        if ((lane & 1) == 0) ((float*)(Yb + (size_t)(MP + b * 4 + st) * 5120))[hd * 64 + srow] = p2 + sa * c1 + v * c2;
#pragma unroll
        for (int q = 0; q < 8; ++q) { const f32x4 w = *(const f32x4*)(w5 + 128 + kh + 4 * q), kka = *(const f32x4*)(w5 + 192 + kh + 4 * q), kv = *(const f32x4*)(w5 + 256 + kh + 4 * q);
#pragma unroll
            for (int j = 0; j < 4; ++j) S[4 * q + j] = S[4 * q + j] * w[j] + sa * kka[j] + v * kv[j]; } }
    { float* dp = P.out() + O_SWKV + (((size_t)(l * 128 + b) * 4 + hd) * 64 + srow) * 64 + kh;
#pragma unroll
        for (int q = 0; q < 8; ++q) *(f32x4*)(dp + 4 * q) = (f32x4){S[4 * q], S[4 * q + 1], S[4 * q + 2], S[4 * q + 3]}; }
    LDSWAIT();
}

#ifndef PROBE_VAL
#define PROBE_VAL tacc
#endif
#ifndef PROBE_CMASK
#define PROBE_CMASK 15
#endif
#ifndef PROBE_DMASK
#define PROBE_DMASK 31
#endif
__device__ __forceinline__ void phaseC(const KP& P0, int l, unsigned char* smem) {
    { const KP P = get_kp(); float* z1 = (float*)(P.ws() + OFF_RSQ1); float* z2 = (float*)(P.ws() + OFF_RSQ2);
      for (int i = blockIdx.x * 512 + otid(); i < MP; i += gridDim.x * 512) { z1[i] = 0.f; z2[i] = 0.f; } }
    const int tid = otid();
    unsigned* ctr = (unsigned*)(P0.ws() + OFF_CTR) + 2 + l;
    volatile int* s_task = (volatile int*)(smem + LDS_TASK_OFF);
    for (;;) {
        __syncthreads();
        if (tid == 0) *s_task = (int)atomicAdd(ctr, 1u);
        __syncthreads();
        const int t = *s_task;
        if (t >= 1312) break;
        const KP P = get_kp();
#ifdef PROBE_SEL
        const unsigned long long c0_ = __builtin_amdgcn_s_memrealtime();
#endif
        const int pt = (t < 560 && !(t & 1)) ? (t >> 1) : -1, lt = (t < 560) ? ((t & 1) ? (t >> 1) : -1) : t - 280;
        if (pt >= 0) { if (pt < 248) rwkv_prep_tile<2>(P, l, smem, pt); else rwkv_prep_tile<1>(P, l, smem, 496 + (pt - 248)); }
        else if (lt < 256) s5_task(P, l, smem, 0, lt);
        else if (lt < 520) pool_tile(P, l, smem, lt - 256);
        else { const int u = lt - 520; hgrn_task(P, l, smem, 0, u >> 6, (u >> 4) & 3, u & 15); }
#ifdef PROBE_SEL
        if (l == 0 && tid == 0) { float* sl = (float*)(P.ws() + OFF_CTR) + 52 + (t < 280 ? 0 : (t < 536 ? 1 : (t < 800 ? 2 : 3))); *sl = (float)(__builtin_amdgcn_s_memrealtime() - c0_) * 0.01f; }
#endif
    }
}
__device__ __forceinline__ void phaseD(const KP& P0, int l, unsigned char* smem) {
    const int tid = otid();
#ifdef PROBE_SEL
    float ptt[5] = {0.f, 0.f, 0.f, 0.f, 0.f}, ptn[5] = {0.f, 0.f, 0.f, 0.f, 0.f}; unsigned long long pt0 = __builtin_amdgcn_s_memrealtime();
#endif
    if ((PROBE_DMASK & 1) && blockIdx.x < 128) rwkv_scan_task(P0, l, smem, true, blockIdx.x >> 4, (blockIdx.x >> 2) & 3, blockIdx.x & 3);
#ifdef PROBE_SEL
    ptt[0] = (float)(__builtin_amdgcn_s_memrealtime() - pt0) * 0.01f; ptn[0] = 1.f;
#endif
    unsigned* ctr = (unsigned*)(P0.ws() + OFF_CTR) + l;
    volatile int* s_task = (volatile int*)(smem + LDS_TASK_OFF);
    for (;;) {
        __syncthreads();
        if (tid == 0) *s_task = (int)atomicAdd(ctr, 1u);
        __syncthreads();
        const int t = *s_task;
        if (t >= 1416 + 576 + (l == 0 ? 160 : 0)) break;
        const KP P = get_kp();
#ifdef PROBE_SEL
        pt0 = __builtin_amdgcn_s_memrealtime();
#endif
        if (t < 264) s5_task(P, l, smem, 1, t);
        else if (t < 776) { const int u = t - 264; hgrn_task(P, l, smem, 1, u >> 6, (u >> 4) & 3, 15 - (u & 15)); }
        else if (t < 1288) { const int u = t - 776; if (PROBE_DMASK & 8) hgrn_task(P, l, smem, 2, u >> 2, u & 3, 0); }
        else if (t < 1416) { const int u = (t - 1288) * 8 + (tid >> 6); rwkv_sample_wave(P, l, smem, u >> 3, (u >> 1) & 3, u & 1); }
        else { const int it = (t - 1416) * 8 + (tid >> 6), lane = tid & 63; float* scr = (float*)smem + (tid >> 6) * (64 * 33);
            if (it < 512) transpose_item(P.in(35) + (size_t)l * 1024 * 1024, 1024, 1024, (bf16_t*)(P.ws() + OFF_WOUTT), scr, it, lane, nullptr);
            else if (it < 2560) transpose_item(P.in(37) + (size_t)l * 1024 * 4096, 1024, 4096, (bf16_t*)(P.ws() + OFF_UPT), scr, it - 512, lane, P.in(36) + l * 1024);
            else if (it < 4608) transpose_item(P.in(38) + (size_t)l * 4096 * 1024, 4096, 1024, (bf16_t*)(P.ws() + OFF_DOWNT), scr, it - 2560, lane, nullptr);
            else transpose_item(P.in(9) + (size_t)(l + 1) * 1024 * 2560, 1024, 2560, (bf16_t*)(P.ws() + OFF_WINT), scr, it - 4608, lane, P.in(8) + (l + 1) * 1024); }
#ifdef PROBE_SEL
        { const int ty = t < 512 ? 1 : (t < 776 ? 2 : (t < 1288 ? 3 : 4)); const float d = (float)(__builtin_amdgcn_s_memrealtime() - pt0) * 0.01f;
#pragma unroll
          for (int c = 1; c < 5; ++c) if (c == ty) { ptt[c] += d; ptn[c] += 1.f; } }
#endif
    }
#ifdef PROBE_SEL
    if (l == 0 && tid == 0 && (blockIdx.x == 0 || blockIdx.x == 200)) { float* sl = (float*)(P0.ws() + OFF_CTR) + (blockIdx.x == 0 ? 16 : 32);
#pragma unroll
        for (int c = 0; c < 5; ++c) { sl[c] = ptt[c]; sl[8 + c] = ptn[c]; } }
#endif
}
__device__ __forceinline__ void phaseE(const KP& P, int l) {
    const int tid = otid(), lane = tid & 63, wave = tid >> 6, gw = blockIdx.x * 8 + wave, NGW = gridDim.x * 8;
    const unsigned char* Yb = P.ws() + OFF_PROJ + 2560; const float* Vb = (const float*)(P.ws() + OFF_RW) + 5 * RWSZ; const float* C12 = (const float*)(P.ws() + OFF_C12);
    bf16_t* MIXED = (bf16_t*)(P.ws() + OFF_MIXED);
    const int c0 = lane * 4, hd = lane >> 4;
    const f32x4 lg = *(const f32x4*)(P.in(31) + l * 256 + c0), lbb = *(const f32x4*)(P.in(32) + l * 256 + c0);
#pragma unroll 1
    for (int rb = gw; rb < MT; rb += 8 * NGW) {
        f32x4 yv[8], vv[8]; u32x2 gv[8]; float bsv[8];
#pragma unroll
        for (int q = 0; q < 8; ++q) { const int r = min(rb + q * NGW, MT - 1);
            yv[q] = *(const f32x4*)((const float*)(Yb + (size_t)r * 5120) + c0); vv[q] = *(const f32x4*)(Vb + (size_t)r * 256 + c0);
            gv[q] = *(const u32x2*)(MIXED + (size_t)r * 1024 + 512 + c0); bsv[q] = C12[(size_t)r * 16 + hd * 4 + 2]; }
#pragma unroll
        for (int q = 0; q < 8; ++q) { const int r = rb + q * NGW; const f32x4 y = yv[q], v = vv[q];
            float s = y.x + y.y + y.z + y.w; s += shx(s, lane, 1); s += shx(s, lane, 2); s += shx(s, lane, 4); s += shx(s, lane, 8);
            const float mean = s * (1.f / 64.f); const f32x4 d = y - mean;
            float qq = d.x * d.x + d.y * d.y + d.z * d.z + d.w * d.w; qq += shx(qq, lane, 1); qq += shx(qq, lane, 2); qq += shx(qq, lane, 4); qq += shx(qq, lane, 8);
            const float rs = rsqrtf(qq * (1.f / 64.f) + 64e-5f); const float bs = bsv[q];
            float g[4], o[4]; unpack4(gv[q], g);
#pragma unroll
            for (int j = 0; j < 4; ++j) o[j] = (d[j] * rs * lg[j] + lbb[j] + bs * v[j]) * g[j];
            if (r < MT) *(u32x2*)(MIXED + (size_t)r * 1024 + 512 + c0) = pack4(o); }
    }
}

template <class Epi> __device__ __forceinline__ void run_gemm(unsigned char* smem, const bf16_t* A, const bf16_t* Bt, int M, int N, int K, const Epi& E) {
    pg8::Gemm g; g.A = A; g.Bt = Bt; g.M = M; g.N = N; g.K = K; g.ld = K;
    pg8::StaticOrder S; S.init(M, N, (int)gridDim.x, (int)blockIdx.x);
    __syncthreads();
    pg8::gemm_phase<Epi, pg8::StaticOrder, false>((PG8_LAS unsigned char*)smem, g, S, E, nullptr);
    __syncthreads();
}
struct ResidOrder {
    pg8::StaticOrder main; int S, kbytes, ntail, G, c;
    __device__ bool next(int i, pg8::Unit& u) const {
        if (main.next(i, u)) return true;
        const int L = i * G + c - main.nwg; if (L < 0 || L >= 8 * S) return false;
        const int t = L / S, ks = L - t * S; u.pm = 64 + (t >> 2); u.pn = t & 3; u.kb = ks * kbytes; u.nt = ntail; return true; }
    __device__ __forceinline__ void a_ready(const pg8::Unit&) const {}
    __device__ __forceinline__ void done(const pg8::Unit&) const {}
};
__device__ __forceinline__ void run_gemm_resid(unsigned char* smem, const bf16_t* A, const bf16_t* Bt, int K, int split, pg8::EpiResid& E) {
    pg8::Gemm g; g.A = A; g.Bt = Bt; g.M = MP; g.N = 1024; g.K = K; g.ld = K;
    ResidOrder S; S.main.init(MP, 1024, (int)gridDim.x, (int)blockIdx.x); S.S = split; S.kbytes = (K / split) * 2; S.ntail = (K / split) / 64; S.G = (int)gridDim.x; S.c = (int)blockIdx.x;
    E.kbytes = S.kbytes;
    __syncthreads();
    pg8::gemm_phase<pg8::EpiResid, ResidOrder, false>((PG8_LAS unsigned char*)smem, g, S, E, nullptr);
    __syncthreads();
}

__device__ __forceinline__ void gbar(unsigned* bar, unsigned& target) {
    __syncthreads();
    if (threadIdx.x == 0) {
        target += gridDim.x;
        __builtin_amdgcn_fence(__ATOMIC_RELEASE, "agent");
        __hip_atomic_fetch_add(bar, 1u, __ATOMIC_RELAXED, __HIP_MEMORY_SCOPE_AGENT);
        while (__hip_atomic_load(bar, __ATOMIC_RELAXED, __HIP_MEMORY_SCOPE_AGENT) < target) __builtin_amdgcn_s_sleep(1);
        __builtin_amdgcn_fence(__ATOMIC_ACQUIRE, "agent");
    }
    __syncthreads();
}
#define SEAM(ID) do { if ((ID) == 0) grid.sync(); else gbar(bar, btarget); } while (0)
#ifdef PROBE_SEL
#define PH_END(ID) do { SEAM(ID); { const unsigned long long tn_ = __builtin_amdgcn_s_memrealtime(); const float d_ = (float)(tn_ - tprev) * 0.01f; tprev = tn_; const int ID_ = (ID); const int L_ = ID_ / 9, SUB_ = ID_ % 9; (void)L_; (void)SUB_; if (PROBE_SEL) tacc += d_; } } while (0)
#else
#define PH_END(ID) SEAM(ID)
#endif
__global__ void __launch_bounds__(512, 2) mega(Params Pk) {
    extern __shared__ __attribute__((aligned(16))) unsigned char smem[];
    cg::grid_group grid = cg::this_grid();
    unsigned long long tprev = 0ull; float tacc = 0.f;
    unsigned btarget = 0u; unsigned* bar = (unsigned*)(get_kp().ws() + OFF_CTR) + 8;
#ifdef PROBE_SEL
    tprev = __builtin_amdgcn_s_memrealtime();
#endif
#pragma unroll 1
    for (int ph = 0; ph < 18; ++ph) {
        int L = ph / 9; const int sub = ph - L * 9; L = __builtin_amdgcn_readfirstlane(L);
        if (sub == 0) phaseA(get_kp(), L, smem);
        else if (sub == 1 || sub == 7) { const KP P = get_kp(); pg8::EpiBf E; E.ACT = sub == 7; E.O = (bf16_t*)(P.ws() + (sub == 1 ? OFF_PROJ : OFF_HIDDEN)); E.ldc = sub == 1 ? 2560 : 4096; E.rsq = (const float*)(P.ws() + (sub == 1 ? OFF_RSQ1 : OFF_RSQ2));
            run_gemm(smem, (const bf16_t*)(P.ws() + (sub == 1 ? OFF_HB1 : OFF_XN2)), (const bf16_t*)(P.ws() + (sub == 1 ? OFF_WINT : OFF_UPT)), MT, sub == 1 ? 2560 : 4096, 1024, E); }
        else if (sub == 2) phaseC(get_kp(), L, smem);
        else if (sub == 3) phaseD(get_kp(), L, smem);
        else if (sub == 4) phaseE(get_kp(), L);
        else if (sub == 5 || sub == 8) { const KP P = get_kp(); pg8::EpiResid E; E.H = P.out(); E.Hin = (L == 0 && sub == 5) ? P.in(0) : P.out(); E.ldc = 1024; E.HB = (bf16_t*)(P.ws() + (sub == 5 ? OFF_XN2 : OFF_HB1)); E.rsq = (float*)(P.ws() + (sub == 5 ? OFF_RSQ2 : OFF_RSQ1));
            const bf16_t* A = (const bf16_t*)(P.ws() + (sub == 5 ? OFF_MIXED : OFF_HIDDEN)); const bf16_t* Bt = (const bf16_t*)(P.ws() + (sub == 5 ? OFF_WOUTT : OFF_DOWNT)); const int K = sub == 5 ? 1024 : 4096;
            E.PART = (float*)(P.ws() + OFF_PART); run_gemm_resid(smem, A, Bt, K, sub == 5 ? 4 : 8, E); }
        else phaseG(get_kp(), L, smem);
        PH_END(ph);
    }
#ifdef PROBE_SEL
    if (threadIdx.x == 0) { const KP P = get_kp(); ((int*)(P.ws() + WS_END))[blockIdx.x] = (int)((unsigned)__builtin_amdgcn_s_getreg((3 << 11) | 20) & 0xFu); }
#endif
    norm_rows(get_kp(), 0, 2);
#ifdef PROBE_SEL
    PH_END(18);
    float xmis = 0.f; { const KP P = get_kp(); const int* xt = (const int*)(P.ws() + WS_END); for (int i = 0; i < 256; ++i) xmis += (xt[i] != xt[i & 7]) ? 1.f : 0.f; } (void)xmis;
    if (blockIdx.x == 0) { const KP P = get_kp(); const float* sl = (const float*)(P.ws() + OFF_CTR); (void)sl; const float sc = 1.f + sqrtf((PROBE_VAL) * 1e-5f); for (int i = threadIdx.x; i < 16384; i += 512) P.out()[O_PSRE + i] *= sc; }
#endif
}

extern "C" void kernel_launch(void* const* d_in, const int* in_sizes, int n_in, void* d_out, int out_size, void* d_ws, size_t ws_size, hipStream_t stream) {
    static int grid = 0;
    if (grid == 0) {
        if (n_in != 40 || ws_size < WS_END) { fprintf(stderr, "kernel_launch: unexpected n_in %d / ws %zu\n", n_in, ws_size); grid = -1; return; }
        int dev = 0, cus = 0, per_cu = 0;
        hipGetDevice(&dev); hipDeviceGetAttribute(&cus, hipDeviceAttributeMultiprocessorCount, dev);
        if (hipFuncSetAttribute((const void*)mega, hipFuncAttributeMaxDynamicSharedMemorySize, LDS_BYTES) != hipSuccess) { fprintf(stderr, "kernel_launch: hipFuncSetAttribute failed\n"); grid = -1; return; }
        if (hipOccupancyMaxActiveBlocksPerMultiprocessor(&per_cu, (const void*)mega, 512, LDS_BYTES) != hipSuccess || per_cu < 1) { fprintf(stderr, "kernel_launch: occupancy query says %d\n", per_cu); per_cu = 1; }
        (void)hipGetLastError();
        grid = cus;
    }
    if (grid < 0) return;
    Params p{};
    for (int i = 0; i < 40; ++i) p.in[i] = (const float*)d_in[i];
    p.out = (float*)d_out; p.ws = (unsigned char*)d_ws;
    if (hipMemsetAsync((char*)d_ws + OFF_CTR + 32, 0, 4, stream) != hipSuccess) { fprintf(stderr, "kernel_launch: memset of the barrier word failed\n"); return; }
    void* args[] = {&p};
    hipError_t e = hipLaunchCooperativeKernel((const void*)mega, dim3(grid), dim3(512), args, LDS_BYTES, stream);
    if (e != hipSuccess) fprintf(stderr, "cooperative launch failed: %s (grid %d)\n", hipGetErrorString(e), grid);
}
```

```cpp
#include <hip/hip_runtime.h>
#include <hip/hip_cooperative_groups.h>
#include <cstdio>
#include <cstdint>
namespace cg = cooperative_groups;
__device__ __forceinline__ int otid() { int t = threadIdx.x; asm volatile("" : "+v"(t)); return t; }
namespace pg8 {
#define PG8_LAS __attribute__((address_space(3)))
typedef unsigned short bf16_t;
typedef short bf16x8 __attribute__((ext_vector_type(8)));
typedef float f32x4 __attribute__((ext_vector_type(4)));
typedef unsigned u32x4 __attribute__((ext_vector_type(4)));
constexpr int BM = 256, BK = 64, HALF = 128, HTB = HALF * BK * 2  , STAGE_BYTES = 8 * HTB, NXCD = 8, WGM = 8;

__host__ __device__ __forceinline__ int lds_byte(int r, int c) { const int st = (r >> 4) * 2 + (c >> 5), rr = r & 15, cc = c & 31, ob = rr * 64 + cc * 2; return st * 1024 + (ob ^ (((ob >> 9) & 1) << 5)); }
__host__ __device__ __forceinline__ void stage_rc(int b, int& R, int& C) { const int st = b / 1024, sb = b % 1024, swz = sb ^ (((sb >> 9) & 1) << 5); R = (st >> 1) * 16 + swz / 64; C = (st & 1) * 32 + (swz % 64) / 2; }
__host__ __device__ __forceinline__ int perm32(int rho) { const int n = rho >> 4, i = rho & 15; return 8 * (i >> 2) + 4 * n + (i & 3); }

struct Unit { int pm, pn, kb, nt; };
struct Gemm { const bf16_t* A; const bf16_t* Bt; int M, N, K, ld; };

struct StaticOrder {
    int nM, nN, nwg, G, c;
    __host__ __device__ void init(int M, int N, int G_, int c_) { nM = M / BM; nN = N / BM; nwg = nM * nN; G = G_; c = c_; }
    __host__ __device__ bool next(int i, Unit& u) const {
        const long L = (long)i * G + c; if (L >= nwg) return false;
        int wgid = (int)L; { const int q = nwg / NXCD, r = nwg % NXCD, xcd = wgid % NXCD, off = wgid / NXCD; wgid = (xcd < r ? xcd * (q + 1) : r * (q + 1) + (xcd - r) * q) + off; }
        const int nig = WGM * nN, gid = wgid / nig, fm = gid * WGM, gsz = (nM - fm) < WGM ? (nM - fm) : WGM;
        u.pm = fm + ((wgid % nig) % gsz); u.pn = (wgid % nig) / gsz; u.kb = 0; u.nt = 0; return true;
    }
    __device__ __forceinline__ void a_ready(const Unit&) const {}
    __device__ __forceinline__ void done(const Unit&) const {}
};
__device__ __forceinline__ unsigned cvt_pk_bf16(float lo, float hi) { unsigned r; asm volatile("v_cvt_pk_bf16_f32 %0, %1, %2" : "=v"(r) : "v"(lo), "v"(hi)); return r; }
struct EpiBf {
    static constexpr bool PERM = true, AFTER_DRAIN = false;
    bf16_t* O; int ldc; int ACT; const float* rsq;
    __device__ __forceinline__ void init(f32x4 (&acc)[2][2][4][2], const Unit&, int, int, int, int) const {
#pragma unroll
        for (int a = 0; a < 2; ++a)
#pragma unroll
            for (int b = 0; b < 2; ++b)
#pragma unroll
                for (int m = 0; m < 4; ++m)
#pragma unroll
                    for (int n = 0; n < 2; ++n) acc[a][b][m][n] = (f32x4){0.f, 0.f, 0.f, 0.f}; }
    __device__ __forceinline__ void operator()(const f32x4 (&acc)[2][2][4][2], const Unit& u, int wr, int wc, int fr, int fq) const {
        const int row0 = u.pm * BM + wr * 64 + fr; const int col0 = u.pn * BM + wc * 32 + 8 * fq;
#pragma unroll
        for (int ai = 0; ai < 2; ++ai)
#pragma unroll
            for (int m = 0; m < 4; ++m) { bf16_t* rowp = O + (size_t)(row0 + ai * HALF + m * 16) * ldc + col0; const float rstd = rsqrtf(rsq[row0 + ai * HALF + m * 16] * (1.f / 1024.f) + 1e-6f);
#pragma unroll
                for (int bj = 0; bj < 2; ++bj) { f32x4 v0 = acc[ai][bj][m][0] * rstd, v1 = acc[ai][bj][m][1] * rstd;
                    if (ACT) {
#pragma unroll
                        for (int j = 0; j < 4; ++j) { const float a = fmaxf(v0[j], 0.f), b = fmaxf(v1[j], 0.f); v0[j] = a * a; v1[j] = b * b; } }
                    u32x4 w; w.x = cvt_pk_bf16(v0[0], v0[1]); w.y = cvt_pk_bf16(v0[2], v0[3]); w.z = cvt_pk_bf16(v1[0], v1[1]); w.w = cvt_pk_bf16(v1[2], v1[3]);
                    *(u32x4*)(rowp + bj * HALF) = w; } }
    }
};
struct EpiResid {
    static constexpr bool PERM = false, AFTER_DRAIN = false;
    float* H; const float* Hin; int ldc; bf16_t* HB; float* rsq; float* PART; int kbytes;
    __device__ __forceinline__ void init(f32x4 (&acc)[2][2][4][2], const Unit& u, int wr, int wc, int fr, int fq) const {
        if (u.pm >= 64) {
#pragma unroll
        for (int a = 0; a < 2; ++a)
#pragma unroll
            for (int b = 0; b < 2; ++b)
#pragma unroll
                for (int m = 0; m < 4; ++m)
#pragma unroll
                    for (int n = 0; n < 2; ++n) acc[a][b][m][n] = (f32x4){0.f, 0.f, 0.f, 0.f};
            return; }
        const int row0 = u.pm * BM + wr * 64 + fr, col0 = u.pn * BM + wc * 32 + 4 * fq;
#pragma unroll
        for (int ai = 0; ai < 2; ++ai)
#pragma unroll
            for (int m = 0; m < 4; ++m) { const float* rowp = Hin + (size_t)(row0 + ai * HALF + m * 16) * ldc + col0;
#pragma unroll
                for (int bj = 0; bj < 2; ++bj)
#pragma unroll
                    for (int n = 0; n < 2; ++n) acc[ai][bj][m][n] = *(const f32x4*)(rowp + bj * HALF + n * 16); }
    }
    __device__ __forceinline__ void operator()(const f32x4 (&acc)[2][2][4][2], const Unit& u, int wr, int wc, int fr, int fq) const {
        if (u.pm >= 64) { const int ks = u.kb / kbytes, row0 = (u.pm - 64) * BM + wr * 64 + fr, col0 = u.pn * BM + wc * 32 + 4 * fq;
#pragma unroll
            for (int ai = 0; ai < 2; ++ai)
#pragma unroll
                for (int m = 0; m < 4; ++m) { float* rowp = PART + ((size_t)ks * 512 + row0 + ai * HALF + m * 16) * 1024 + col0;
#pragma unroll
                    for (int bj = 0; bj < 2; ++bj)
#pragma unroll
                        for (int n = 0; n < 2; ++n) *(f32x4*)(rowp + bj * HALF + n * 16) = acc[ai][bj][m][n]; }
            return; }
        const int row0 = u.pm * BM + wr * 64 + fr, col0 = u.pn * BM + wc * 32 + 4 * fq, lane = fq * 16 + fr;
#pragma unroll
        for (int ai = 0; ai < 2; ++ai)
#pragma unroll
            for (int m = 0; m < 4; ++m) { const int row = row0 + ai * HALF + m * 16; float* rowp = H + (size_t)row * ldc + col0; bf16_t* hbp = HB + (size_t)row * ldc + col0; float ss = 0.f;
#pragma unroll
                for (int bj = 0; bj < 2; ++bj)
#pragma unroll
                    for (int n = 0; n < 2; ++n) { const f32x4 v = acc[ai][bj][m][n]; *(f32x4*)(rowp + bj * HALF + n * 16) = v;
                        ss += v.x * v.x + v.y * v.y + v.z * v.z + v.w * v.w;
                        typedef unsigned u32x2_ __attribute__((ext_vector_type(2))); *(u32x2_*)(hbp + bj * HALF + n * 16) = (u32x2_){cvt_pk_bf16(v.x, v.y), cvt_pk_bf16(v.z, v.w)}; }
                ss += __int_as_float(__builtin_amdgcn_ds_bpermute((lane ^ 16) << 2, __float_as_int(ss))); ss += __int_as_float(__builtin_amdgcn_ds_bpermute((lane ^ 32) << 2, __float_as_int(ss)));
                if (fq == 0) unsafeAtomicAdd(rsq + row, ss); }
    }
};

template <class Epi, class Sched, bool STAMP = false>
__device__ __forceinline__ void gemm_phase(PG8_LAS unsigned char* lds, const Gemm g, const Sched& S, const Epi& E, unsigned long long* stamps) {
    const int tid = otid(), wid = __builtin_amdgcn_readfirstlane(tid >> 6), lane = tid & 63, wr = wid >> 2, wc = wid & 3, fr = lane & 15, fq = lane >> 4;
    const int K = g.ld, nt = g.K / BK;
    int ts_lo = 0, ts_hi = 0, nts = 0; const unsigned long long rt_entry = STAMP ? (unsigned long long)wall_clock64() : 0ull;
#define PG8_STAMP() do { if (STAMP && wid == 0 && nts < 64) { const unsigned long long _c = (unsigned long long)clock64(); \
        ts_lo = (lane == nts) ? (int)(unsigned)_c : ts_lo; ts_hi = (lane == nts) ? (int)(unsigned)(_c >> 32) : ts_hi; ++nts; } } while (0)
    PG8_STAMP();
    unsigned voffA[2], voffB[2];
#pragma unroll
    for (int i = 0; i < 2; ++i) { int R, C; stage_rc(tid * 16 + i * 8192, R, C); const int Rb = Epi::PERM ? ((R & ~31) + perm32(R & 31)) : R;
        voffA[i] = (unsigned)(R * K + C) * 2u; voffB[i] = (unsigned)(Rb * K + C) * 2u; }
    const size_t kstep = (size_t)(BK * 2);
    const size_t hstep = (size_t)HALF * K * 2;
    const size_t tstep = 2 * hstep;
    const unsigned ldsw = (unsigned)wid * 1024u;
    const int aoff = lds_byte(wr * 64 + fr, fq * 8), boff = lds_byte(wc * 32 + fr, fq * 8);
#define PG8_SA(b, h) (((b) * 2 + (h)) * HTB)
#define PG8_SB(b, h) ((4 + (b) * 2 + (h)) * HTB)
#define PG8_STAGE(bufoff, gbase, voff) do { _Pragma("unroll") for (int _i = 0; _i < 2; ++_i) \
        __builtin_amdgcn_global_load_lds((const unsigned*)((const char*)(gbase) + (voff)[_i]), (PG8_LAS unsigned*)(lds + (bufoff) + ldsw + _i * 8192), 16, 0, 0); } while (0)
#define PG8_LDA(dst, b, h) do { _Pragma("unroll") for (int m = 0; m < 4; ++m) _Pragma("unroll") for (int k = 0; k < 2; ++k) dst[m][k] = *(const PG8_LAS bf16x8*)(lds + PG8_SA(b, h) + aoff + m * 2048 + k * 1024); } while (0)
#define PG8_LDB(dst, b, h) do { _Pragma("unroll") for (int n = 0; n < 2; ++n) _Pragma("unroll") for (int k = 0; k < 2; ++k) dst[n][k] = *(const PG8_LAS bf16x8*)(lds + PG8_SB(b, h) + boff + n * 2048 + k * 1024); } while (0)
#define PG8_MMA(ai, bj, At, Bt) do { __builtin_amdgcn_s_setprio(1); _Pragma("unroll") for (int m = 0; m < 4; ++m) _Pragma("unroll") for (int n = 0; n < 2; ++n) _Pragma("unroll") for (int k = 0; k < 2; ++k) \
        acc[ai][bj][m][n] = __builtin_amdgcn_mfma_f32_16x16x32_bf16(Bt[n][k], At[m][k], acc[ai][bj][m][n], 0, 0, 0); __builtin_amdgcn_s_setprio(0); } while (0)
#define PG8_WAIT_V(n) asm volatile("s_waitcnt vmcnt(" #n ")" ::: "memory")
#define PG8_WAIT_L(n) asm volatile("s_waitcnt lgkmcnt(" #n ")" ::: "memory")
#define PG8_BAR __builtin_amdgcn_s_barrier()
#define PG8_SCHED __builtin_amdgcn_sched_barrier(0)
    Unit cur, nxt; int ui = 0;
    if (!S.next(0, cur)) return;
    f32x4 acc[2][2][4][2];
    bf16x8 At[4][2], B0[2][2], B1[2][2];
    const char* cA = (const char*)g.A + (size_t)cur.pm * tstep + cur.kb; const char* cB = (const char*)g.Bt + (size_t)cur.pn * tstep + cur.kb;
    S.a_ready(cur);
    E.init(acc, cur, wr, wc, fr, fq);
    PG8_STAGE(PG8_SB(0, 0), cB, voffB); PG8_STAGE(PG8_SA(0, 0), cA, voffA); PG8_STAGE(PG8_SB(0, 1), cB + hstep, voffB); PG8_STAGE(PG8_SA(0, 1), cA + hstep, voffA);
    if (wr == 1) PG8_BAR;
    PG8_WAIT_V(4); PG8_BAR;
    PG8_STAGE(PG8_SB(1, 0), cB + kstep, voffB); PG8_STAGE(PG8_SA(1, 0), cA + kstep, voffA); PG8_STAGE(PG8_SB(1, 1), cB + hstep + kstep, voffB);
    PG8_WAIT_V(6); PG8_BAR;
    PG8_STAMP();
    for (;;) {
        const bool has_next = S.next(ui + 1, nxt);
        const char* nA = has_next ? (const char*)g.A + (size_t)nxt.pm * tstep + nxt.kb : cA; const char* nB = has_next ? (const char*)g.Bt + (size_t)nxt.pn * tstep + nxt.kb : cB;
        const int unt = cur.nt > 0 ? cur.nt : nt;
        for (int t = 0; t < unt; t += 2) {
            const bool last = (t == unt - 2);
            const char* a1 = cA + (size_t)(t + 1) * kstep;
            const char* a2 = last ? nA : cA + (size_t)(t + 2) * kstep; const char* b2 = last ? nB : cB + (size_t)(t + 2) * kstep;
            const char* a3 = a2 + kstep; const char* b3 = b2 + kstep;
            if (last && has_next) S.a_ready(nxt);
            PG8_LDB(B0, 0, 0); PG8_SCHED; PG8_LDA(At, 0, 0); PG8_STAGE(PG8_SA(1, 1), a1 + hstep, voffA);
            PG8_WAIT_L(8); PG8_BAR; PG8_WAIT_L(0); PG8_MMA(0, 0, At, B0); PG8_BAR; PG8_SCHED;
            PG8_LDB(B1, 0, 1); PG8_STAGE(PG8_SB(0, 0), b2, voffB);
            PG8_BAR; PG8_WAIT_L(0); PG8_MMA(0, 1, At, B1); PG8_BAR;
            PG8_LDA(At, 0, 1); PG8_STAGE(PG8_SA(0, 0), a2, voffA);
            PG8_BAR; PG8_WAIT_L(0); PG8_MMA(1, 0, At, B0); PG8_BAR; PG8_SCHED;
            PG8_STAGE(PG8_SB(0, 1), b2 + hstep, voffB);
            PG8_WAIT_V(6); PG8_BAR; PG8_MMA(1, 1, At, B1); PG8_BAR;
            PG8_LDB(B0, 1, 0); PG8_SCHED; PG8_LDA(At, 1, 0); PG8_STAGE(PG8_SA(0, 1), a2 + hstep, voffA);
            PG8_WAIT_L(8); PG8_BAR; PG8_WAIT_L(0); PG8_MMA(0, 0, At, B0); PG8_BAR; PG8_SCHED;
            PG8_LDB(B1, 1, 1); PG8_STAGE(PG8_SB(1, 0), b3, voffB);
            PG8_BAR; PG8_WAIT_L(0); PG8_MMA(0, 1, At, B1); PG8_BAR;
            PG8_LDA(At, 1, 1); PG8_STAGE(PG8_SA(1, 0), a3, voffA);
            PG8_BAR; PG8_WAIT_L(0); PG8_MMA(1, 0, At, B0); PG8_BAR; PG8_SCHED;
            PG8_STAGE(PG8_SB(1, 1), b3 + hstep, voffB);
            PG8_WAIT_V(6); PG8_BAR; PG8_MMA(1, 1, At, B1); PG8_BAR;
        }
        PG8_STAMP();
        if constexpr (!Epi::AFTER_DRAIN) { E(acc, cur, wr, wc, fr, fq); S.done(cur); }
        PG8_STAMP();
        if (!has_next) break;
    E.init(acc, nxt, wr, wc, fr, fq);
        cur = nxt; cA = nA; cB = nB; ++ui;
    }
    PG8_WAIT_V(0);
    if (wr == 0) PG8_BAR;
    PG8_BAR;
    if constexpr (Epi::AFTER_DRAIN) { E.fused(acc, cur, wr, wc, fr, fq, lds, wid, lane); S.done(cur); }
    PG8_STAMP();
    if (STAMP && wid == 0) { stamps[lane] = lane < nts ? (((unsigned long long)(unsigned)ts_hi << 32) | (unsigned)ts_lo) : 0ull;
        if (lane == 62) stamps[62] = rt_entry; if (lane == 63) stamps[63] = (unsigned long long)wall_clock64(); }
#undef PG8_STAMP
#undef PG8_SA
#undef PG8_SB
#undef PG8_STAGE
#undef PG8_LDA
#undef PG8_LDB
#undef PG8_MMA
#undef PG8_WAIT_V
#undef PG8_WAIT_L
#undef PG8_BAR
#undef PG8_SCHED
}
}
using pg8::bf16_t; using pg8::bf16x8; using pg8::f32x4; using pg8::u32x4; using pg8::cvt_pk_bf16;
typedef unsigned u32x2 __attribute__((ext_vector_type(2)));
typedef float f32x2v __attribute__((ext_vector_type(2)));

constexpr int MT = 16896, MP = 16384;
constexpr size_t OFF_PROJ = 0;
constexpr size_t OFF_MIXED = 86507520;
constexpr size_t OFF_RW = 121110528;
constexpr size_t RWSZ = (size_t)MT * 256;
constexpr size_t OFF_Y = 224919552;
constexpr size_t OFF_UPT = OFF_Y, OFF_DOWNT = OFF_Y + 8388608;
constexpr size_t OFF_WINT = 242221056;
constexpr size_t OFF_WOUTT = 247463936;
constexpr size_t OFF_HST = 249561088;
constexpr size_t OFF_HD = 257949696;
constexpr size_t OFF_S5E = 258080768;
constexpr size_t OFF_C12 = 260177920;
constexpr size_t OFF_S5C = 261259264;
constexpr size_t OFF_CMT = OFF_S5C + 147456;
constexpr size_t OFF_GLUT = OFF_CMT + 65536;
constexpr size_t OFF_W2T = OFF_GLUT + 131072;
constexpr size_t OFF_A2T = OFF_W2T + 32768;
constexpr size_t OFF_G2T = OFF_A2T + 32768;
constexpr size_t OFF_PWT = OFF_G2T + 65536;
constexpr size_t OFF_LB = OFF_PWT + 32768;
constexpr size_t OFF_CTR = OFF_LB + 1024;
constexpr size_t OFF_HIDDEN = 0;
constexpr size_t OFF_XN2 = 138412032;
constexpr size_t OFF_BBT = OFF_CTR + 256;
constexpr size_t OFF_RSQ1 = OFF_BBT + 131072;
constexpr size_t OFF_RSQ2 = OFF_RSQ1 + 67584;
constexpr size_t OFF_HB1 = 173015040;
constexpr size_t CSTRIDE = 1048576;
constexpr size_t OFF_PART = 207618048;
constexpr size_t WS_END = OFF_RSQ2 + 67584;
constexpr size_t O_PSRE = 17301504, O_PSIM = O_PSRE + 16384, O_PHG = O_PSIM + 16384, O_PWKV = O_PHG + 262144, O_PSH = O_PWKV + 262144, O_PPOOL = O_PSH + 16384,
    O_SSRE = O_PPOOL + 61440, O_SSIM = O_SSRE + 262144, O_SHG = O_SSIM + 262144, O_SWKV = O_SHG + 4194304, O_SSH = O_SWKV + 4194304, O_SPOOL = O_SSH + 262144;
constexpr int LDS_BYTES = 147456;
constexpr int LDS_TASK_OFF = 146432;

struct Params { const float* in[40]; float* out; unsigned char* ws; };
#define AS4 __attribute__((address_space(4)))
struct KP { const AS4 char* k;
    __device__ __forceinline__ const float* in(int i) const { return *(const float* const AS4*)(k + 8 * i); }
    __device__ __forceinline__ float* out() const { return *(float* const AS4*)(k + 320); }
    __device__ __forceinline__ unsigned char* ws() const { return *(unsigned char* const AS4*)(k + 328); } };
__device__ __forceinline__ KP get_kp() { int z = 0; asm volatile("" : "+s"(z)); z = __builtin_amdgcn_readfirstlane(z); KP p; p.k = (const AS4 char*)__builtin_amdgcn_kernarg_segment_ptr() + z; return p; }

__device__ __forceinline__ float bf2f(bf16_t v) { return __uint_as_float(((unsigned)v) << 16); }
__device__ __forceinline__ float bflo(unsigned w) { return __uint_as_float(w << 16); }
__device__ __forceinline__ float bfhi(unsigned w) { return __uint_as_float(w & 0xffff0000u); }
__device__ __forceinline__ bf16_t f2bf(float f) { return (bf16_t)(cvt_pk_bf16(f, 0.f) & 0xffffu); }
__device__ __forceinline__ void unpack8(const u32x4 v, float* o) { o[0] = bflo(v.x); o[1] = bfhi(v.x); o[2] = bflo(v.y); o[3] = bfhi(v.y); o[4] = bflo(v.z); o[5] = bfhi(v.z); o[6] = bflo(v.w); o[7] = bfhi(v.w); }
__device__ __forceinline__ void unpack4(const u32x2 v, float* o) { o[0] = bflo(v.x); o[1] = bfhi(v.x); o[2] = bflo(v.y); o[3] = bfhi(v.y); }
__device__ __forceinline__ u32x2 pack4(const float* o) { u32x2 r; r.x = cvt_pk_bf16(o[0], o[1]); r.y = cvt_pk_bf16(o[2], o[3]); return r; }
__device__ __forceinline__ float sigm(float x) { return __builtin_amdgcn_rcpf(1.f + __expf(-x)); }
__device__ __forceinline__ float tanh_(float x) { return 1.f - 2.f * __builtin_amdgcn_rcpf(1.f + __expf(2.f * x)); }
__device__ __forceinline__ float gelu_t(float x) { return 0.5f * x * (1.f + tanh_(0.7978845608f * (x + 0.044715f * x * x * x))); }
__device__ __forceinline__ float shx(float v, int lane, int m) { return __int_as_float(__builtin_amdgcn_ds_bpermute((lane ^ m) << 2, __float_as_int(v))); }
__device__ __forceinline__ float wave_sum(float v, int lane) {
#pragma unroll
    for (int o = 1; o < 64; o <<= 1) v += shx(v, lane, o);
    return v; }
__device__ __forceinline__ void row_info(int r, int& b, int& t, bool& pr) { pr = r < MP; if (pr) { b = r >> 11; t = r & 2047; } else { b = (r - MP) >> 2; t = (r - MP) & 3; } }
#define MFMA16(a, b, c) __builtin_amdgcn_mfma_f32_16x16x32_bf16((a), (b), (c), 0, 0, 0)
#define LDSWAIT() asm volatile("s_waitcnt lgkmcnt(0)" ::: "memory")

__device__ __forceinline__ void transpose_item(const float* W, int K, int N, bf16_t* WT, float* scr, int item, int lane, const float* gk) {
    const int nblk = N >> 5, kb = item / nblk, nb = item - kb * nblk, k0 = kb << 6, n0 = nb << 5;
    float tv[32];
#pragma unroll
    for (int i = 0; i < 32; ++i) { const int kk = 2 * i + (lane >> 5); tv[i] = W[(size_t)(k0 + kk) * N + n0 + (lane & 31)]; }
    if (gk) {
#pragma unroll
        for (int i = 0; i < 32; ++i) tv[i] *= gk[k0 + 2 * i + (lane >> 5)]; }
#pragma unroll
    for (int i = 0; i < 32; ++i) { const int kk = 2 * i + (lane >> 5); scr[kk * 33 + (lane & 31)] = tv[i]; }
    LDSWAIT();
    const int c = lane & 7;
#pragma unroll
    for (int j = 0; j < 4; ++j) { const int n = (lane >> 3) + 8 * j; const float* s = scr + (8 * c) * 33 + n;
        u32x4 o; o.x = cvt_pk_bf16(s[0], s[33]); o.y = cvt_pk_bf16(s[66], s[99]); o.z = cvt_pk_bf16(s[132], s[165]); o.w = cvt_pk_bf16(s[198], s[231]);
        *(u32x4*)(WT + (size_t)(n0 + n) * K + k0 + 8 * c) = o; }
    LDSWAIT();
}
__device__ __forceinline__ void norm_rows(const KP& P, int l, int which) {
    const int tid = otid(), lane = tid & 63, wave = tid >> 6, gw = blockIdx.x * 8 + wave, NGW = gridDim.x * 8;
    const bool all = (which == 2) || (which == 0 && l == 0);
    const int nsplit = which == 1 ? 4 : ((which == 0 && l == 0) ? 0 : 8);
    const int rlo = all ? 0 : MP;
    bf16_t* HB = (bf16_t*)(P.ws() + (which == 0 ? OFF_HB1 : OFF_XN2));
    float* RSQ = (float*)(P.ws() + (which == 0 ? OFF_RSQ1 : OFF_RSQ2));
    f32x4 gg[4];
#pragma unroll
    for (int j = 0; j < 4; ++j) gg[j] = ((const f32x4*)P.in(39))[lane + 64 * j];
#pragma unroll 1
    for (int rb = rlo + gw; rb < MT; rb += 4 * NGW) {
        f32x4 v[4][4];
#pragma unroll
        for (int q = 0; q < 4; ++q) { const int r = rb + q * NGW;
            if (r < MT) { const float* src = P.out() + (size_t)r * 1024;
                if (l == 0 && which != 2 && !(which == 1 && false)) { if (which == 0 || which == 1) src = (r < MP) ? P.in(0) + (size_t)r * 1024 : P.in(1) + (size_t)(r - MP) * 1024; }
#pragma unroll
                for (int j = 0; j < 4; ++j) v[q][j] = ((const f32x4*)src)[lane + 64 * j];
                if (nsplit > 0 && r >= MP) { const float* pp = (const float*)(P.ws() + OFF_PART) + (size_t)(r - MP) * 1024;
#pragma unroll 1
                    for (int k0 = 0; k0 < nsplit; k0 += 4) { f32x4 pv[4][4];
#pragma unroll
                        for (int ks = 0; ks < 4; ++ks)
#pragma unroll
                            for (int j = 0; j < 4; ++j) pv[ks][j] = ((const f32x4*)(pp + (size_t)(k0 + ks) * 512 * 1024))[lane + 64 * j];
#pragma unroll
                        for (int ks = 0; ks < 4; ++ks)
#pragma unroll
                            for (int j = 0; j < 4; ++j) v[q][j] += pv[ks][j]; } } }
            else {
#pragma unroll
                for (int j = 0; j < 4; ++j) v[q][j] = (f32x4){0.f, 0.f, 0.f, 0.f}; } }
#pragma unroll
        for (int q = 0; q < 4; ++q) { const int r = rb + q * NGW; float s = 0.f;
#pragma unroll
            for (int j = 0; j < 4; ++j) s += v[q][j].x * v[q][j].x + v[q][j].y * v[q][j].y + v[q][j].z * v[q][j].z + v[q][j].w * v[q][j].w;
            s = wave_sum(s, lane);
            if (r < MT) { float* hrow = P.out() + (size_t)r * 1024;
                if (which == 2) { const float rstd = rsqrtf(s * (1.f / 1024.f) + 1e-6f);
#pragma unroll
                    for (int j = 0; j < 4; ++j) ((f32x4*)hrow)[lane + 64 * j] = v[q][j] * rstd * gg[j]; }
                else { if (lane == 0) RSQ[r] = s;
#pragma unroll
                    for (int j = 0; j < 4; ++j) { if (r >= MP && !(which == 0 && l == 0)) ((f32x4*)hrow)[lane + 64 * j] = v[q][j];
                        u32x2 w; w.x = cvt_pk_bf16(v[q][j].x, v[q][j].y); w.y = cvt_pk_bf16(v[q][j].z, v[q][j].w); *(u32x2*)(HB + (size_t)r * 1024 + (lane + 64 * j) * 4) = w; } } }
        }
    }
}
__device__ __forceinline__ void phaseA(const KP& P, int l0, unsigned char* smem) {
    const int l = l0;
    const int tid = otid(), lane = tid & 63, wave = tid >> 6, gw = blockIdx.x * 8 + wave, NGW = gridDim.x * 8;
#ifdef PROBE_SEL
    const unsigned long long a0_ = __builtin_amdgcn_s_memrealtime();
#endif
    norm_rows(P, l, 0);
#ifdef PROBE_SEL
    const unsigned long long a1_ = __builtin_amdgcn_s_memrealtime();
#endif
    float* scr = (float*)smem + wave * (64 * 33);
    if (l == 0) for (int it = gw; it < 1280; it += NGW) transpose_item(P.in(9), 1024, 2560, (bf16_t*)(P.ws() + OFF_WINT), scr, it, lane, P.in(8));
#ifdef PROBE_SEL
    const unsigned long long a2_ = __builtin_amdgcn_s_memrealtime();
#endif
    {
    const int gt = blockIdx.x * 512 + tid, NT = gridDim.x * 512;
    float* S5C = (float*)(P.ws() + OFF_S5C + l * CSTRIDE);
    for (int e = gt; e < 16384; e += NT) {
        const int idx = e >> 4, h = e & 15, g = idx >> 6, pp = idx & 63;
        const float lr = P.in(10)[l * 1024 + idx], li = P.in(11)[l * 1024 + idx], dt = expf(P.in(12)[l * 16 + g]);
        const float mag = expf(lr * dt); float sn, cs; sincosf(li * dt, &sn, &cs);
        const float abr = mag * cs, abi = mag * sn;
        if (h == 0) { const float magL = expf(64.f * lr * dt); float snL, csL; sincosf(64.f * li * dt, &snL, &csL);
            S5C[idx] = abr; S5C[1024 + idx] = abi; S5C[2048 + idx] = magL * csL; S5C[3072 + idx] = magL * snL; }
        const float den = lr * lr + li * li, zr = abr - 1.f, zi = abi;
        const float cr = (zr * lr + zi * li) / den, ci = (zi * lr - zr * li) / den;
        const float br = P.in(13)[((size_t)l * 1024 + idx) * 16 + h], bi = P.in(14)[((size_t)l * 1024 + idx) * 16 + h];
        bf16_t* BBT = (bf16_t*)(P.ws() + OFF_BBT + l * CSTRIDE);
        BBT[(g * 128 + pp) * 32 + h] = f2bf(cr * br - ci * bi); BBT[(g * 128 + 64 + pp) * 32 + h] = f2bf(cr * bi + ci * br); BBT[(g * 128 + pp) * 32 + 16 + h] = 0; BBT[(g * 128 + 64 + pp) * 32 + 16 + h] = 0;
    }
    bf16_t* CMT = (bf16_t*)(P.ws() + OFF_CMT + l * CSTRIDE);
    for (int idx = gt; idx < 32768; idx += NT) { const int gh = idx >> 7, pp = idx & 127;
        const float v = pp < 64 ? P.in(15)[((size_t)l * 256 + gh) * 64 + pp] : -P.in(16)[((size_t)l * 256 + gh) * 64 + pp - 64]; CMT[idx] = f2bf(v); }
    bf16_t* GLUT = (bf16_t*)(P.ws() + OFF_GLUT + l * CSTRIDE);
    for (int idx = gt; idx < 65536; idx += NT) { const int n = idx >> 8, k = idx & 255; GLUT[idx] = f2bf(P.in(18)[(size_t)l * 65536 + k * 256 + n]); }
    bf16_t* W2T = (bf16_t*)(P.ws() + OFF_W2T + l * CSTRIDE); bf16_t* A2T = (bf16_t*)(P.ws() + OFF_A2T + l * CSTRIDE); bf16_t* G2T = (bf16_t*)(P.ws() + OFF_G2T + l * CSTRIDE); bf16_t* PWT = (bf16_t*)(P.ws() + OFF_PWT + l * CSTRIDE);
    for (int idx = gt; idx < 16384; idx += NT) { const int c = idx >> 6, j = idx & 63;
        W2T[idx] = f2bf(P.in(24)[(size_t)l * 16384 + j * 256 + c]); A2T[idx] = f2bf(P.in(26)[(size_t)l * 16384 + j * 256 + c]);
        const int gi = idx >> 12, d = (idx >> 6) & 63, cc = idx & 63; PWT[idx] = f2bf(P.in(33)[(size_t)l * 16384 + gi * 4096 + cc * 64 + d]); }
    for (int idx = gt; idx < 32768; idx += NT) { const int c = idx >> 7, j = idx & 127; G2T[idx] = f2bf(P.in(27)[(size_t)l * 32768 + j * 256 + c]); }
    float* LB = (float*)(P.ws() + OFF_LB + l * CSTRIDE);
    for (int idx = gt; idx < 256; idx += NT) LB[idx] = (l == 0) ? 0.f : sigm(P.in(20)[256 + idx] - P.in(20)[idx]);
    }
#ifdef PROBE_SEL
    if (l == 0 && tid == 0 && (blockIdx.x == 0 || blockIdx.x == 100)) { float* sl = (float*)(P.ws() + OFF_CTR) + (blockIdx.x == 0 ? 56 : 60); const unsigned long long a3_ = __builtin_amdgcn_s_memrealtime();
        sl[0] = (float)(a1_ - a0_) * 0.01f; sl[1] = (float)(a2_ - a1_) * 0.01f; sl[2] = (float)(a3_ - a2_) * 0.01f; }
#endif
    if (blockIdx.x == 0 && tid == 0) { ((unsigned*)(P.ws() + OFF_CTR))[l] = 0u; ((unsigned*)(P.ws() + OFF_CTR))[2 + l] = 0u; }
}
__device__ __forceinline__ void phaseG(const KP& P, int l, unsigned char* smem) { norm_rows(P, l, 1); }

template <int MTW  > __device__ __forceinline__ void rwkv_prep_tile(const KP& P, int l, unsigned char* smem, int tile) {
    const int tid = otid(), lane = tid & 63, wave = tid >> 6, fr = lane & 15, fq = lane >> 4;
    const int r0 = tile * (32 * MTW);
    const bf16_t* PROJ = (const bf16_t*)(P.ws() + OFF_PROJ);
    bf16_t* MIXED = (bf16_t*)(P.ws() + OFF_MIXED);
    bf16_t* Aop = (bf16_t*)smem;
    const float* mu = P.in(22) + l * 1024;
    const float* shs = P.in(6) + (size_t)l * 128 * 1024;
    __syncthreads();
#pragma unroll 2
    for (int i = 0; i < 2 * MTW; ++i) {
        const int item = tid + 512 * i, tok = item >> 5, j0 = (item & 31) * 8, r = r0 + tok;
        int b, t; bool pr; row_info(r, b, t, pr);
        float p[8], q[8], o[8];
        unpack8(*(const u32x4*)(PROJ + (size_t)r * 2560 + 2048 + j0), p);
        if (t > 0) unpack8(*(const u32x4*)(PROJ + (size_t)(r - 1) * 2560 + 2048 + j0), q);
        else if (!pr) { const float* s = shs + (size_t)b * 1024 + 768 + j0;
#pragma unroll
            for (int e = 0; e < 8; ++e) q[e] = s[e]; }
        else {
#pragma unroll
            for (int e = 0; e < 8; ++e) q[e] = 0.f; }
#pragma unroll
        for (int e = 0; e < 8; ++e) { const float xs = p[e] + (q[e] - p[e]) * mu[768 + j0 + e]; o[e] = j0 < 64 ? tanh_(xs) : (j0 < 128 ? xs : sigm(xs)); }
        u32x4 w; w.x = cvt_pk_bf16(o[0], o[1]); w.y = cvt_pk_bf16(o[2], o[3]); w.z = cvt_pk_bf16(o[4], o[5]); w.w = cvt_pk_bf16(o[6], o[7]);
        *(u32x4*)(Aop + tok * 264 + j0) = w;
    }
    bf16_t* XS = (bf16_t*)(smem + 34816);
#pragma unroll 2
    for (int i = 0; i < 6 * MTW; ++i) {
        const int item = tid + 512 * i, tok = item / 96, j0 = (item - tok * 96) * 8, r = r0 + tok;
        int b, t; bool pr; row_info(r, b, t, pr);
        float p[8], q[8], o[8];
        unpack8(*(const u32x4*)(PROJ + (size_t)r * 2560 + 1280 + j0), p);
        if (t > 0) unpack8(*(const u32x4*)(PROJ + (size_t)(r - 1) * 2560 + 1280 + j0), q);
        else if (!pr) { const float* sp = shs + (size_t)b * 1024 + j0;
#pragma unroll
            for (int e = 0; e < 8; ++e) q[e] = sp[e]; }
        else {
#pragma unroll
            for (int e = 0; e < 8; ++e) q[e] = 0.f; }
#pragma unroll
        for (int e = 0; e < 8; ++e) o[e] = p[e] + (q[e] - p[e]) * mu[j0 + e];
        u32x4 w; w.x = cvt_pk_bf16(o[0], o[1]); w.y = cvt_pk_bf16(o[2], o[3]); w.z = cvt_pk_bf16(o[4], o[5]); w.w = cvt_pk_bf16(o[6], o[7]);
        *(u32x4*)(XS + tok * 776 + j0) = w;
    }
#pragma unroll 1
    for (int tok = 0; tok < 32 * MTW; ++tok) { const int r = r0 + tok; int b, t; bool pr; row_info(r, b, t, pr);
        if (pr ? (t == 2047) : (t == 3)) { float* dst = P.out() + (pr ? O_PSH + (size_t)(l * 8 + b) * 1024 : O_SSH + (size_t)(l * 128 + b) * 1024);
            for (int idx = tid; idx < 1024; idx += 512) dst[idx] = bf2f(PROJ[(size_t)r * 2560 + 1280 + idx]); } }
    __syncthreads();
    const int hd = wave & 3, th = wave >> 2;
    const bf16_t* W2T = (const bf16_t*)(P.ws() + OFF_W2T + l * CSTRIDE); const bf16_t* A2T = (const bf16_t*)(P.ws() + OFF_A2T + l * CSTRIDE); const bf16_t* G2T = (const bf16_t*)(P.ws() + OFF_G2T + l * CSTRIDE);
    f32x4 accw[4][MTW], acca[4][MTW], accg[4][MTW];
#pragma unroll
    for (int nt = 0; nt < 4; ++nt)
#pragma unroll
        for (int mt = 0; mt < MTW; ++mt) { accw[nt][mt] = (f32x4){0.f, 0.f, 0.f, 0.f}; acca[nt][mt] = accw[nt][mt]; accg[nt][mt] = accw[nt][mt]; }
#pragma unroll
    for (int nt = 0; nt < 4; ++nt) { const int n = hd * 64 + nt * 16 + fr;
#pragma unroll
        for (int ks = 0; ks < 2; ++ks) {
            const bf16x8 wf = *(const bf16x8*)(W2T + n * 64 + ks * 32 + fq * 8), af = *(const bf16x8*)(A2T + n * 64 + ks * 32 + fq * 8);
#pragma unroll
            for (int mt = 0; mt < MTW; ++mt) { const bf16_t* xr = Aop + (th * 16 * MTW + mt * 16 + fr) * 264 + ks * 32 + fq * 8;
                accw[nt][mt] = MFMA16(wf, *(const bf16x8*)xr, accw[nt][mt]); acca[nt][mt] = MFMA16(af, *(const bf16x8*)(xr + 64), acca[nt][mt]); } }
#pragma unroll
        for (int ks = 0; ks < 4; ++ks) { const bf16x8 gf = *(const bf16x8*)(G2T + n * 128 + ks * 32 + fq * 8);
#pragma unroll
            for (int mt = 0; mt < MTW; ++mt) accg[nt][mt] = MFMA16(gf, *(const bf16x8*)(Aop + (th * 16 * MTW + mt * 16 + fr) * 264 + 128 + ks * 32 + fq * 8), accg[nt][mt]); } }
    float* RW = (float*)(P.ws() + OFF_RW);
    float* C12 = (float*)(P.ws() + OFF_C12);
    const float* w0 = P.in(23) + l * 256; const float* a0 = P.in(25) + l * 256; const float* kkw = P.in(28) + l * 256; const float* kaw = P.in(29) + l * 256; const float* rkw = P.in(30) + l * 256;
#pragma unroll
    for (int mt = 0; mt < MTW; ++mt) {
        const int r = r0 + th * 16 * MTW + mt * 16 + fr; int b, t; bool pr; row_info(r, b, t, pr);
        float kkr[4][4], av[4][4], xrr[4][4]; float ss = 0.f, bs = 0.f, c2 = 0.f;
#pragma unroll
        for (int nt = 0; nt < 4; ++nt) {
            const int c0 = hd * 64 + nt * 16 + fq * 4;
            float xr4[4], xk4[4], xv4[4];
            { const bf16_t* xrow = XS + (th * 16 * MTW + mt * 16 + fr) * 776 + c0; unpack4(*(const u32x2*)(xrow), xr4); unpack4(*(const u32x2*)(xrow + 256), xk4); unpack4(*(const u32x2*)(xrow + 512), xv4); }
            f32x4 owr, ow, ok, ov; float gg[4];
#pragma unroll
            for (int j = 0; j < 4; ++j) { const int c = c0 + j;
                const float xr = xr4[j], xk = xk4[j], xv = xv4[j];
                const float wp = w0[c] + accw[nt][mt][j];
                const float nx = -wp;
                const float sp = fmaxf(nx, 0.f) + __logf(1.f + __expf(-fabsf(nx)));
                const float wv = -sp - 0.5f;
                const float dec = __expf(-__expf(wv));
                const float a = sigm(a0[c] + acca[nt][mt][j]);
                const float kr = xk * kkw[c]; ss += kr * kr;
                const float k = xk * (1.f + (a - 1.f) * kaw[c]);
                bs += xr * k * rkw[c]; c2 += xr * k;
                kkr[nt][j] = kr; av[nt][j] = a; xrr[nt][j] = xr;
                owr[j] = dec * xr; ow[j] = dec; ok[j] = k; ov[j] = xv; gg[j] = accg[nt][mt][j]; }
            const size_t o = (size_t)r * 256 + c0;
            *(f32x4*)(RW + 1 * RWSZ + o) = owr; *(f32x4*)(RW + 2 * RWSZ + o) = ow; *(f32x4*)(RW + 4 * RWSZ + o) = ok; *(f32x4*)(RW + 5 * RWSZ + o) = ov;
            *(u32x2*)(MIXED + (size_t)r * 1024 + 512 + c0) = pack4(gg);
        }
        ss += shx(ss, lane, 16); ss += shx(ss, lane, 32); bs += shx(bs, lane, 16); bs += shx(bs, lane, 32); c2 += shx(c2, lane, 16); c2 += shx(c2, lane, 32);
        const float inv = __builtin_amdgcn_rsqf(fmaxf(ss, 1e-24f)); float c1 = 0.f;
#pragma unroll
        for (int nt = 0; nt < 4; ++nt) { const int c0 = hd * 64 + nt * 16 + fq * 4; f32x4 okk, okka;
#pragma unroll
            for (int j = 0; j < 4; ++j) { const float kk = kkr[nt][j] * inv, kka = kk * av[nt][j]; okk[j] = kk; okka[j] = kka; c1 += kka * xrr[nt][j]; }
            const size_t o = (size_t)r * 256 + c0; *(f32x4*)(RW + 0 * RWSZ + o) = okk; *(f32x4*)(RW + 3 * RWSZ + o) = okka; }
        c1 += shx(c1, lane, 16); c1 += shx(c1, lane, 32);
        if (fq == 0) *(f32x4*)(C12 + (size_t)r * 16 + hd * 4) = (f32x4){c1, c2, bs, 0.f};
    }
}

__device__ __forceinline__ void pool_tile(const KP& P, int l, unsigned char* smem, int tile) {
    const int tid = otid(), lane = tid & 63, wave = tid >> 6, fr = lane & 15, fq = lane >> 4;
    const int r0 = tile * 64;
    const bf16_t* PROJ = (const bf16_t*)(P.ws() + OFF_PROJ);
    bf16_t* MIXED = (bf16_t*)(P.ws() + OFF_MIXED);
    bf16_t* Pop = (bf16_t*)smem;
    const float* pst = P.in(7) + (size_t)l * 128 * 15 * 256;
    __syncthreads();
#pragma unroll 2
    for (int i = 0; i < 4; ++i) {
        const int item = tid + 512 * i, tok = item >> 5, ch0 = (item & 31) * 8, r = r0 + tok, win = 2 << (ch0 >> 6);
        int b, t; bool pr; row_info(r, b, t, pr);
        float s[8], u[8];
#pragma unroll
        for (int e = 0; e < 8; ++e) { s[e] = 0.f; u[e] = 0.f; }
        if (pr) {
            u32x4 xv[16];
#pragma unroll
            for (int j = 0; j < 16; ++j) { xv[j] = (u32x4){0u, 0u, 0u, 0u}; if (j < win && t - j >= 0) xv[j] = *(const u32x4*)(PROJ + (size_t)(r - j) * 2560 + 2304 + ch0); }
#pragma unroll
            for (int j = 0; j < 16; ++j) { float x[8]; unpack8(xv[j], x);
#pragma unroll
                for (int e = 0; e < 8; ++e) { s[e] += x[e]; if (j == 0) u[e] = x[e]; } }
        } else {
            for (int j = 0; j < win; ++j) { const int tt = t - j; float x[8];
                if (tt >= 0) unpack8(*(const u32x4*)(PROJ + (size_t)(r - j) * 2560 + 2304 + ch0), x);
                else { const float* bp = pst + ((size_t)b * 15 + 15 + tt) * 256 + ch0;
#pragma unroll
                    for (int e = 0; e < 8; ++e) x[e] = bp[e]; }
                if (j == 0) {
#pragma unroll
                    for (int e = 0; e < 8; ++e) u[e] = x[e]; }
#pragma unroll
                for (int e = 0; e < 8; ++e) s[e] += x[e]; }
        }
        const float cnt = pr ? (float)min(t + 1, win) : (float)win, ic = 1.f / cnt; float o[8];
#pragma unroll
        for (int e = 0; e < 8; ++e) o[e] = s[e] * ic - u[e];
        u32x4 w; w.x = cvt_pk_bf16(o[0], o[1]); w.y = cvt_pk_bf16(o[2], o[3]); w.z = cvt_pk_bf16(o[4], o[5]); w.w = cvt_pk_bf16(o[6], o[7]);
        *(u32x4*)(Pop + tok * 264 + ch0) = w;
    }
    if (r0 < MP) { if ((r0 & 2047) == 1984) { const int b = r0 >> 11; float* dst = P.out() + O_PPOOL + (size_t)(l * 8 + b) * 3840;
            for (int idx = tid; idx < 3840; idx += 512) { const int j = idx >> 8, ch = idx & 255; dst[idx] = bf2f(PROJ[(size_t)(b * 2048 + 2033 + j) * 2560 + 2304 + ch]); } } }
    else { const int b0 = (r0 - MP) >> 2;
        for (int idx = tid; idx < 16 * 3840; idx += 512) { const int bb = idx / 3840, rem = idx - bb * 3840, j = rem >> 8, ch = rem & 255, b = b0 + bb;
            const float v = j < 11 ? pst[((size_t)b * 15 + j + 4) * 256 + ch] : bf2f(PROJ[(size_t)(MP + b * 4 + j - 11) * 2560 + 2304 + ch]);
            P.out()[O_SPOOL + (size_t)(l * 128 + b) * 3840 + rem] = v; } }
    __syncthreads();
    const bf16_t* PWT = (const bf16_t*)(P.ws() + OFF_PWT + l * CSTRIDE);
    const float* scale = P.in(34) + l * 256;
    f32x4 acc[2][4];
#pragma unroll
    for (int nt = 0; nt < 2; ++nt)
#pragma unroll
        for (int mt = 0; mt < 4; ++mt) acc[nt][mt] = (f32x4){0.f, 0.f, 0.f, 0.f};
#pragma unroll
    for (int nt = 0; nt < 2; ++nt) { const int n0 = wave * 32 + nt * 16, gi = n0 >> 6;
#pragma unroll
        for (int ks = 0; ks < 2; ++ks) { const bf16x8 wf = *(const bf16x8*)(PWT + (n0 + fr) * 64 + ks * 32 + fq * 8);
#pragma unroll
            for (int mt = 0; mt < 4; ++mt) acc[nt][mt] = MFMA16(wf, *(const bf16x8*)(Pop + (mt * 16 + fr) * 264 + gi * 64 + ks * 32 + fq * 8), acc[nt][mt]); } }
#pragma unroll
    for (int nt = 0; nt < 2; ++nt)
#pragma unroll
        for (int mt = 0; mt < 4; ++mt) { const int r = r0 + mt * 16 + fr, ch = wave * 32 + nt * 16 + fq * 4; float o[4];
#pragma unroll
            for (int j = 0; j < 4; ++j) o[j] = acc[nt][mt][j] * scale[ch + j];
            *(u32x2*)(MIXED + (size_t)r * 1024 + 768 + ch) = pack4(o); }
}

__device__ __forceinline__ void s5_task(const KP& P, int l, unsigned char* smem, int mode, int tile) {
    const int tid = otid(), lane = tid & 63, wave = tid >> 6, fr = lane & 15, fq = lane >> 4;
    const bool prompt = tile < 256;
    const int b = tile >> 5, c = tile & 31, st8 = tile - 256;
    const int r0 = prompt ? b * 2048 + c * 64 : MP + st8 * 64, b0 = st8 * 16;
    const bf16_t* PROJ = (const bf16_t*)(P.ws() + OFF_PROJ);
    bf16_t* MIXED = (bf16_t*)(P.ws() + OFF_MIXED);
    bf16_t* U = (bf16_t*)smem;
    bf16_t* Zb = (bf16_t*)(smem + 32768);
    float* BU = (float*)(smem + 32768 + 33792 + wave * 8448);
    __syncthreads();
#pragma unroll
    for (int i = 0; i < 4; ++i) { const int item = tid + 512 * i, tok = item >> 5, j0 = (item & 31) * 8;
        *(u32x4*)(U + tok * 256 + j0) = *(const u32x4*)(PROJ + (size_t)(r0 + tok) * 2560 + j0); }
    __syncthreads();
    const float* S5C = (const float*)(P.ws() + OFF_S5C + l * CSTRIDE);
    const bf16_t* CMT = (const bf16_t*)(P.ws() + OFF_CMT + l * CSTRIDE);
    const bf16_t* BBT = (const bf16_t*)(P.ws() + OFF_BBT + l * CSTRIDE);
    float* S5E = (float*)(P.ws() + OFF_S5E);
    const float* dsk = P.in(17) + l * 256;
#pragma unroll 1
    for (int gg = 0; gg < 2; ++gg) {
        const int g = 2 * wave + gg, gp = g * 64 + lane;
        const float ar = S5C[gp], ai = S5C[1024 + gp];
        float hr = 0.f, hi = 0.f;
        if (prompt && mode == 1) { const float alr = S5C[2048 + gp], ali = S5C[3072 + gp];
#pragma unroll 1
            for (int j0 = 0; j0 < c; j0 += 8) { f32x2v e[8];
#pragma unroll
                for (int jj = 0; jj < 8; ++jj) e[jj] = (j0 + jj < c) ? *(const f32x2v*)(S5E + ((size_t)((b * 32 + j0 + jj) * 16 + g) * 64 + lane) * 2) : (f32x2v){0.f, 0.f};
#pragma unroll
                for (int jj = 0; jj < 8; ++jj) if (j0 + jj < c) { const float nr = alr * hr - ali * hi + e[jj].x, ni = alr * hi + ali * hr + e[jj].y; hr = nr; hi = ni; } } }
        bf16x8 bfr[8], cfr[4];
#pragma unroll
        for (int pt = 0; pt < 8; ++pt) bfr[pt] = *(const bf16x8*)(BBT + (g * 128 + pt * 16 + fr) * 32 + fq * 8);
        if (mode == 1) {
#pragma unroll
            for (int ks = 0; ks < 4; ++ks) cfr[ks] = *(const bf16x8*)(CMT + (g * 16 + fr) * 128 + ks * 32 + fq * 8); }
        const f32x4 dsk4 = *(const f32x4*)(dsk + g * 16 + fq * 4);
#pragma unroll 1
        for (int st = 0; st < 4; ++st) {
            { bf16x8 uf = (bf16x8){0, 0, 0, 0, 0, 0, 0, 0};
              if (fq < 2) uf = *(const bf16x8*)(U + (st * 16 + fr) * 256 + g * 16 + fq * 8);
#pragma unroll
              for (int pt = 0; pt < 8; ++pt) { const f32x4 d = MFMA16(bfr[pt], uf, ((f32x4){0.f, 0.f, 0.f, 0.f})); *(f32x4*)(BU + fr * 132 + pt * 16 + fq * 4) = d; } }
            if (prompt) {
                float bur = BU[lane], bui = BU[64 + lane];
#pragma unroll
                for (int tt = 0; tt < 16; ++tt) {
                    const float nbr = BU[((tt + 1) & 15) * 132 + lane], nbi = BU[((tt + 1) & 15) * 132 + 64 + lane];
                    const float nr = ar * hr - ai * hi + bur, ni = ar * hi + ai * hr + bui; hr = nr; hi = ni; bur = nbr; bui = nbi;
                    if (mode == 1) { bf16_t* hb = (bf16_t*)(BU + tt * 132); hb[lane] = f2bf(hr); hb[64 + lane] = f2bf(hi); } }
            } else {
#pragma unroll 4
                for (int tt = 0; tt < 16; ++tt) { const int t = st * 16 + tt;
                    if ((t & 3) == 0) { const size_t so = ((size_t)(l * 128 + b0 + (t >> 2)) * 16 + g) * 64 + lane; hr = P.in(2)[so]; hi = P.in(3)[so]; }
                    const float bur = BU[tt * 132 + lane], bui = BU[tt * 132 + 64 + lane];
                    const float nr = ar * hr - ai * hi + bur, ni = ar * hi + ai * hr + bui; hr = nr; hi = ni;
                    bf16_t* hb = (bf16_t*)(BU + tt * 132); hb[lane] = f2bf(hr); hb[64 + lane] = f2bf(hi);
                    if ((t & 3) == 3) { const size_t so = ((size_t)(l * 128 + b0 + (t >> 2)) * 16 + g) * 64 + lane; P.out()[O_SSRE + so] = hr; P.out()[O_SSIM + so] = hi; } }
            }
            if (mode == 1) {
                f32x4 acc = (f32x4){0.f, 0.f, 0.f, 0.f};
#pragma unroll
                for (int ks = 0; ks < 4; ++ks) acc = MFMA16(cfr[ks], *(const bf16x8*)((const bf16_t*)(BU + fr * 132) + ks * 32 + fq * 8), acc);
                const int t = st * 16 + fr, ch = g * 16 + fq * 4; float u4[4], z[4];
                unpack4(*(const u32x2*)(U + t * 256 + ch), u4);
#pragma unroll
                for (int j = 0; j < 4; ++j) z[j] = gelu_t(acc[j] + dsk4[j] * u4[j]);
                *(u32x2*)(Zb + t * 264 + ch) = pack4(z);
            }
        }
        if (prompt && mode == 1 && c == 31) { const size_t so = ((size_t)(l * 8 + b) * 16 + g) * 64 + lane; P.out()[O_PSRE + so] = hr; P.out()[O_PSIM + so] = hi; }
        if (mode == 0) *(f32x2v*)(S5E + ((size_t)((b * 32 + c) * 16 + g) * 64 + lane) * 2) = (f32x2v){hr, hi};
    }
    if (mode == 1) {
        __syncthreads();
        const bf16_t* GLUT = (const bf16_t*)(P.ws() + OFF_GLUT + l * CSTRIDE);
        const float* gb = P.in(19) + l * 256;
        f32x4 acc[2][4];
#pragma unroll
        for (int nt = 0; nt < 2; ++nt)
#pragma unroll
            for (int mt = 0; mt < 4; ++mt) acc[nt][mt] = (f32x4){0.f, 0.f, 0.f, 0.f};
#pragma unroll
        for (int ks = 0; ks < 8; ++ks)
#pragma unroll
            for (int nt = 0; nt < 2; ++nt) { const bf16x8 wf = *(const bf16x8*)(GLUT + (wave * 32 + nt * 16 + fr) * 256 + ks * 32 + fq * 8);
#pragma unroll
                for (int mt = 0; mt < 4; ++mt) acc[nt][mt] = MFMA16(wf, *(const bf16x8*)(Zb + (mt * 16 + fr) * 264 + ks * 32 + fq * 8), acc[nt][mt]); }
#pragma unroll
        for (int nt = 0; nt < 2; ++nt)
#pragma unroll
            for (int mt = 0; mt < 4; ++mt) { const int tok = mt * 16 + fr, ch = wave * 32 + nt * 16 + fq * 4; float z4[4], o[4];
                unpack4(*(const u32x2*)(Zb + tok * 264 + ch), z4);
#pragma unroll
                for (int j = 0; j < 4; ++j) o[j] = z4[j] * sigm(acc[nt][mt][j] + gb[ch + j]);
                *(u32x2*)(MIXED + (size_t)(r0 + tok) * 1024 + ch) = pack4(o); }
    }
}

__device__ __forceinline__ void hgrn_task(const KP& P, int l, unsigned char* smem, int mode, int b, int hd, int sc) {
    const int tid = otid(), lane = tid & 63, wave = tid >> 6, fr = lane & 15, fq = lane >> 4;
    const bf16_t* PROJ = (const bf16_t*)(P.ws() + OFF_PROJ);
    bf16_t* MIXED = (bf16_t*)(P.ws() + OFF_MIXED);
    bf16_t* Qp = (bf16_t*)smem;
    bf16_t* Kn = Qp + 32 * 72;
    bf16_t* Kdt = Kn + 32 * 72;
    bf16_t* Vt = Kdt + 64 * 40;
    bf16_t* Att = Vt + 64 * 40;
    bf16_t* St = Att + 32 * 40;
    float* TOT = (float*)(St + 64 * 72);
    float* EB = TOT + 512;
    float* HST = (float*)(P.ws() + OFF_HST); float* HD = (float*)(P.ws() + OFF_HD);
    const int k = tid & 63, sg = tid >> 6, kt = wave >> 1, vt0 = (wave & 1) * 2;
    const float lbv = ((const float*)(P.ws() + OFF_LB + l * CSTRIDE))[hd * 64 + k];
    f32x4 accS[2] = {(f32x4){0.f, 0.f, 0.f, 0.f}, (f32x4){0.f, 0.f, 0.f, 0.f}};
    if (mode == 1) {
#pragma unroll 1
        for (int j0 = 0; j0 < sc; j0 += 4) { float dd[4][4], xx[4][2][4];
#pragma unroll
            for (int u = 0; u < 4; ++u) { const size_t bi = (size_t)((b * 4 + hd) * 16 + min(j0 + u, sc - 1));
#pragma unroll
                for (int jj = 0; jj < 4; ++jj) { const int kk = kt * 16 + fq * 4 + jj; dd[u][jj] = HD[bi * 64 + kk];
#pragma unroll
                    for (int i = 0; i < 2; ++i) xx[u][i][jj] = HST[(bi * 64 + kk) * 64 + (vt0 + i) * 16 + fr]; } }
#pragma unroll
            for (int u = 0; u < 4; ++u) if (j0 + u < sc) {
#pragma unroll
                for (int jj = 0; jj < 4; ++jj)
#pragma unroll
                    for (int i = 0; i < 2; ++i) accS[i][jj] = dd[u][jj] * accS[i][jj] + xx[u][i][jj]; } }
    } else if (mode == 2) { const float* sp = P.in(4) + ((size_t)(l * 128 + b) * 4 + hd) * 4096;
#pragma unroll
        for (int jj = 0; jj < 4; ++jj)
#pragma unroll
            for (int i = 0; i < 2; ++i) accS[i][jj] = sp[(kt * 16 + fq * 4 + jj) * 64 + (vt0 + i) * 16 + fr]; }
    __syncthreads();
    if (mode != 0) {
#pragma unroll
        for (int i = 0; i < 2; ++i) { float t4[4] = {accS[i][0], accS[i][1], accS[i][2], accS[i][3]}; *(u32x2*)(St + ((vt0 + i) * 16 + fr) * 72 + kt * 16 + fq * 4) = pack4(t4); } }
    float dsum = 0.f;
    const int nch = mode == 2 ? 1 : 4, L = mode == 2 ? 4 : 32;
    const int rbase = mode == 2 ? MP + b * 4 : b * 2048 + sc * 128;
    bf16_t rz[4], rq[4], rv[4];
#pragma unroll
    for (int e = 0; e < 4; ++e) { const int s = 4 * sg + e; rz[e] = 0; rq[e] = 0; rv[e] = 0;
        if (s < L) { const bf16_t* row = PROJ + (size_t)(rbase + s) * 2560 + hd * 64 + k; rz[e] = row[512]; rq[e] = row[256]; rv[e] = row[768]; } }
    f32x4 ngv[4];
#pragma unroll
    for (int vt = 0; vt < 4; ++vt) ngv[vt] = *(const f32x4*)(P.in(21) + l * 256 + hd * 64 + vt * 16 + fq * 4);
#pragma unroll 1
    for (int ch = 0; ch < nch; ++ch) {
        const int r0 = rbase + ch * 32;
        bf16_t nz[4], nq[4], nv[4];
#pragma unroll
        for (int e = 0; e < 4; ++e) { nz[e] = 0; nq[e] = 0; nv[e] = 0;
            if (ch + 1 < nch) { const bf16_t* row = PROJ + (size_t)(r0 + 32 + 4 * sg + e) * 2560 + hd * 64 + k; nz[e] = row[512]; nq[e] = row[256]; nv[e] = row[768]; } }
        u32x2 pgv[4];
#pragma unroll
        for (int vt = 0; vt < 4; ++vt) { pgv[vt] = (u32x2){0u, 0u}; if (mode != 0 && wave < 2 && wave * 16 + fr < L) pgv[vt] = *(const u32x2*)(PROJ + (size_t)(r0 + wave * 16 + fr) * 2560 + 1024 + hd * 64 + vt * 16 + fq * 4); }
        float lf[4], kv[4], q[4], vv[4], cs[4];
#pragma unroll
        for (int e = 0; e < 4; ++e) { const int s = 4 * sg + e; lf[e] = 0.f; kv[e] = 0.f; q[e] = 0.f; vv[e] = 0.f;
            if (s < L) { const float z = bf2f(rz[e]); const float f = lbv + (1.f - lbv) * sigm(z); lf[e] = __logf(f); kv[e] = 1.f - f;
                if (mode != 0) { const float pq = bf2f(rq[e]); q[e] = pq * sigm(pq); }
                vv[e] = bf2f(rv[e]); } }
#pragma unroll
        for (int e = 0; e < 4; ++e) { rz[e] = nz[e]; rq[e] = nq[e]; rv[e] = nv[e]; }
        cs[0] = lf[0]; cs[1] = cs[0] + lf[1]; cs[2] = cs[1] + lf[2]; cs[3] = cs[2] + lf[3];
        TOT[sg * 64 + k] = cs[3];
        __syncthreads();
        float off = 0.f, blast = 0.f;
#pragma unroll
        for (int j = 0; j < 8; ++j) { const float tj = TOT[j * 64 + k]; if (j < sg) off += tj; blast += tj; }
        { float kd4[4];
#pragma unroll
            for (int e = 0; e < 4; ++e) { const int s = 4 * sg + e; const float bsv = off + cs[e];
                Qp[s * 72 + k] = f2bf(q[e] * __expf(bsv)); Kn[s * 72 + k] = f2bf(kv[e] * __expf(-bsv)); kd4[e] = kv[e] * __expf(blast - bsv); }
            *(u32x2*)(Kdt + k * 40 + 4 * sg) = pack4(kd4); *(u32x2*)(Vt + k * 40 + 4 * sg) = pack4(vv); }
        if (sg == 0) { EB[k] = __expf(blast); dsum += blast; }
        __syncthreads();
        { const f32x4 eb = *(const f32x4*)(EB + kt * 16 + fq * 4); const bf16x8 af = *(const bf16x8*)(Kdt + (kt * 16 + fr) * 40 + fq * 8);
#pragma unroll
            for (int i = 0; i < 2; ++i) { accS[i] = accS[i] * eb; accS[i] = MFMA16(af, *(const bf16x8*)(Vt + ((vt0 + i) * 16 + fr) * 40 + fq * 8), accS[i]); } }
        if (mode != 0) {
            if (wave < 4) { const int tt = wave >> 1, st = wave & 1; f32x4 a = (f32x4){0.f, 0.f, 0.f, 0.f};
                if (st <= tt) {
#pragma unroll
                    for (int ks = 0; ks < 2; ++ks) a = MFMA16(*(const bf16x8*)(Kn + (st * 16 + fr) * 72 + ks * 32 + fq * 8), *(const bf16x8*)(Qp + (tt * 16 + fr) * 72 + ks * 32 + fq * 8), a);
                    float m4[4];
#pragma unroll
                    for (int j = 0; j < 4; ++j) m4[j] = (st * 16 + fq * 4 + j <= tt * 16 + fr) ? a[j] : 0.f;
                    *(u32x2*)(Att + (tt * 16 + fr) * 40 + st * 16 + fq * 4) = pack4(m4);
                } else { *(u32x2*)(Att + (tt * 16 + fr) * 40 + st * 16 + fq * 4) = (u32x2){0u, 0u}; } }
            __syncthreads();
            if (wave < 2) { const int tt = wave; f32x4 o[4]; float ss = 0.f;
                const bf16x8 attf = *(const bf16x8*)(Att + (tt * 16 + fr) * 40 + fq * 8), q0 = *(const bf16x8*)(Qp + (tt * 16 + fr) * 72 + fq * 8), q1 = *(const bf16x8*)(Qp + (tt * 16 + fr) * 72 + 32 + fq * 8);
#pragma unroll
                for (int vt = 0; vt < 4; ++vt) { f32x4 a = MFMA16(*(const bf16x8*)(Vt + (vt * 16 + fr) * 40 + fq * 8), attf, ((f32x4){0.f, 0.f, 0.f, 0.f}));
                    a = MFMA16(*(const bf16x8*)(St + (vt * 16 + fr) * 72 + fq * 8), q0, a); a = MFMA16(*(const bf16x8*)(St + (vt * 16 + fr) * 72 + 32 + fq * 8), q1, a);
                    o[vt] = a; ss += a.x * a.x + a.y * a.y + a.z * a.z + a.w * a.w; }
                ss += shx(ss, lane, 16); ss += shx(ss, lane, 32);
                const float rn = rsqrtf(ss * (1.f / 64.f) + 1e-5f); const int t = tt * 16 + fr;
                if (t < L) { const int r = r0 + t;
#pragma unroll
                    for (int vt = 0; vt < 4; ++vt) { const int ci = hd * 64 + vt * 16 + fq * 4; const f32x4 ng = ngv[vt]; float pg[4], ov[4];
                        unpack4(pgv[vt], pg);
#pragma unroll
                        for (int j = 0; j < 4; ++j) ov[j] = o[vt][j] * rn * ng[j] * (pg[j] * sigm(pg[j]));
                        *(u32x2*)(MIXED + (size_t)r * 1024 + 256 + ci) = pack4(ov); } } }
            __syncthreads();
#pragma unroll
            for (int i = 0; i < 2; ++i) { float t4[4] = {accS[i][0], accS[i][1], accS[i][2], accS[i][3]}; *(u32x2*)(St + ((vt0 + i) * 16 + fr) * 72 + kt * 16 + fq * 4) = pack4(t4); }
        }
    }
    float* dst = nullptr;
    if (mode == 0) { const size_t bi = (size_t)((b * 4 + hd) * 16 + sc); dst = HST + bi * 4096; if (sg == 0) HD[bi * 64 + k] = __expf(dsum); }
    else if (mode == 1) { if (sc == 15) dst = P.out() + O_PHG + ((size_t)(l * 8 + b) * 4 + hd) * 4096; }
    else dst = P.out() + O_SHG + ((size_t)(l * 128 + b) * 4 + hd) * 4096;
    if (dst) {
#pragma unroll
        for (int jj = 0; jj < 4; ++jj)
#pragma unroll
            for (int i = 0; i < 2; ++i) dst[(kt * 16 + fq * 4 + jj) * 64 + (vt0 + i) * 16 + fr] = accS[i][jj]; }
    __syncthreads();
}

template <int CTRL> __device__ __forceinline__ float dpp_add(float x) { return x + __int_as_float(__builtin_amdgcn_update_dpp(0, __float_as_int(x), CTRL, 0xF, 0xF, false)); }
__device__ __forceinline__ float row16_sum(float x) { x = dpp_add<0xB1>(x); x = dpp_add<0x4E>(x); x = dpp_add<0x141>(x); x = dpp_add<0x140>(x); return x; }
#ifndef SCAN_EVEN
#define SCAN_EVEN 0
#endif
#if SCAN_EVEN
#define SCAN_LOADER(w) (((w) & 1) != 0)
#define SCAN_IDX(w) ((w) >> 1)
#else
#define SCAN_LOADER(w) ((w) >= 4)
#define SCAN_IDX(w) ((w) & 3)
#endif
__device__ __forceinline__ void rwkv_scan_task(const KP& P, int l, unsigned char* smem, bool prompt, int b, int hd, int rq) {
    const int tid = otid(), lane = tid & 63, wave = tid >> 6;
    const int T = prompt ? 2048 : 4, row0 = prompt ? b * 2048 : MP + b * 4;
    const float* RW = (const float*)(P.ws() + OFF_RW);
    const float* C12 = (const float*)(P.ws() + OFF_C12);
    unsigned char* Yb = P.ws() + OFF_PROJ + 2560;
    constexpr int BUFF = 32 * 340;
    float* buf = (float*)smem;
    const bool loader = SCAN_LOADER(wave);
    const int sw = SCAN_IDX(wave), ltid = sw * 64 + lane;
    const int rr = lane >> 4, i4 = (lane & 15) * 4, srow = rq * 16 + sw * 4 + rr;
    f32x4 S = (f32x4){0.f, 0.f, 0.f, 0.f};
    if (!loader && !prompt) S = *(const f32x4*)(P.in(5) + (((size_t)(l * 128 + b) * 4 + hd) * 64 + srow) * 64 + i4);
    const int nchunks = (T + 31) >> 5;
    __syncthreads();
#pragma unroll 1
    for (int c = -1; c < nchunks; ++c) {
        if (loader) {
            if (c + 1 < nchunks) { const int t0 = (c + 1) * 32, n = min(32, T - t0); float* bw = buf + ((c + 1) & 1) * BUFF;
                f32x4 x[5][2]; float vx[2]; float cx = 0.f;
#pragma unroll
                for (int i = 0; i < 2; ++i) { const int idx = ltid + 256 * i, stp = idx >> 4, q = idx & 15; const size_t o = (size_t)(row0 + t0 + stp) * 256 + hd * 64 + q * 4;
#pragma unroll
                    for (int vct = 0; vct < 5; ++vct) x[vct][i] = (stp < n) ? *(const f32x4*)(RW + vct * RWSZ + o) : (f32x4){0.f, 0.f, 0.f, 0.f};
                    vx[i] = (stp < n) ? RW[5 * RWSZ + (size_t)(row0 + t0 + stp) * 256 + hd * 64 + rq * 16 + q] : 0.f; }
                if (ltid < 64) { const int stp = ltid >> 1; if (stp < n) cx = C12[(size_t)(row0 + t0 + stp) * 16 + hd * 4 + (ltid & 1)]; }
#pragma unroll
                for (int i = 0; i < 2; ++i) { const int idx = ltid + 256 * i, stp = idx >> 4, q = idx & 15;
#pragma unroll
                    for (int vct = 0; vct < 5; ++vct) *(f32x4*)(bw + vct * 2048 + stp * 64 + q * 4) = x[vct][i];
                    bw[10240 + stp * 16 + q] = vx[i]; }
                if (ltid < 64) bw[10752 + (ltid >> 1) * 4 + (ltid & 1)] = cx;
            }
        } else if (c >= 0) {
            __builtin_amdgcn_s_setprio(3);
            const int t0 = c * 32; const float* br = buf + (c & 1) * BUFF;
#define SCAN_LD(s_, kk_, wr_, w_, kka_, kv_, v_, cc_) do { kk_ = *(const f32x4*)(br + (s_) * 64 + i4); wr_ = *(const f32x4*)(br + 2048 + (s_) * 64 + i4); w_ = *(const f32x4*)(br + 4096 + (s_) * 64 + i4); \
                kka_ = *(const f32x4*)(br + 6144 + (s_) * 64 + i4); kv_ = *(const f32x4*)(br + 8192 + (s_) * 64 + i4); v_ = br[10240 + (s_) * 16 + sw * 4 + rr]; cc_ = *(const f32x2v*)(br + 10752 + (s_) * 4); } while (0)
            f32x4 kk, wr, w, kka, kv; float v; f32x2v cc;
            f32x4 kk1, wr1, w1, kka1, kv1; float v1; f32x2v cc1;
            SCAN_LD(0, kk, wr, w, kka, kv, v, cc); SCAN_LD(1, kk1, wr1, w1, kka1, kv1, v1, cc1);
#pragma unroll 1
            for (int sb = 0; sb < 32; sb += 16) {
                float ysel = 0.f;
#pragma unroll
                for (int s2 = 0; s2 < 16; ++s2) { const int s = sb + s2;
                    f32x4 kk2, wr2, w2, kka2, kv2; float v2; f32x2v cc2;
                    SCAN_LD(s + 2, kk2, wr2, w2, kka2, kv2, v2, cc2);
                    asm volatile("" ::: "memory");
                    const f32x2v S01 = (f32x2v){S.x, S.y}, S23 = (f32x2v){S.z, S.w};
                    f32x2v d1 = S01 * (f32x2v){kk.x, kk.y}; d1 = __builtin_elementwise_fma(S23, (f32x2v){kk.z, kk.w}, d1);
                    f32x2v d2 = S01 * (f32x2v){wr.x, wr.y}; d2 = __builtin_elementwise_fma(S23, (f32x2v){wr.z, wr.w}, d2);
                    float p1 = d1.x + d1.y, p2 = d2.x + d2.y;
                    p1 = row16_sum(p1); p2 = row16_sum(p2);
                    const float sa = -p1, y = p2 + sa * cc.x + v * cc.y;
                    S = S * w + sa * kka + v * kv;
                    ysel = ((lane & 15) == s2) ? y : ysel;
                    kk = kk1; wr = wr1; w = w1; kka = kka1; kv = kv1; v = v1; cc = cc1;
                    kk1 = kk2; wr1 = wr2; w1 = w2; kka1 = kka2; kv1 = kv2; v1 = v2; cc1 = cc2; }
                ((float*)(Yb + (size_t)(row0 + t0 + sb + (lane & 15)) * 5120))[hd * 64 + srow] = ysel;
            }
#undef SCAN_LD
            __builtin_amdgcn_s_setprio(0);
        }
        __syncthreads();
    }
    if (!loader) { float* dst = P.out() + (prompt ? O_PWKV + (((size_t)(l * 8 + b) * 4 + hd) * 64 + srow) * 64 : O_SWKV + (((size_t)(l * 128 + b) * 4 + hd) * 64 + srow) * 64) + i4; *(f32x4*)dst = S; }
}

__device__ __forceinline__ void rwkv_sample_wave(const KP& P, int l, unsigned char* smem, int b, int hd, int half) {
    const int tid = otid(), lane = tid & 63, wave = tid >> 6;
    const float* RW = (const float*)(P.ws() + OFF_RW); const float* C12 = (const float*)(P.ws() + OFF_C12); unsigned char* Yb = P.ws() + OFF_PROJ + 2560;
    float* wl = (float*)smem + wave * 1600;
    const int srow = half * 32 + (lane >> 1), kh = (lane & 1) * 32;
    float S[32];
    { const float* sp = P.in(5) + (((size_t)(l * 128 + b) * 4 + hd) * 64 + srow) * 64 + kh;
#pragma unroll
        for (int q = 0; q < 8; ++q) { const f32x4 x = *(const f32x4*)(sp + 4 * q); S[4 * q] = x.x; S[4 * q + 1] = x.y; S[4 * q + 2] = x.z; S[4 * q + 3] = x.w; } }
#pragma unroll
    for (int st = 0; st < 4; ++st) { const size_t r = (size_t)(MP + b * 4 + st);
#pragma unroll
        for (int vct = 0; vct < 6; ++vct) wl[st * 400 + vct * 64 + lane] = RW[vct * RWSZ + r * 256 + hd * 64 + lane];
        if (lane < 2) wl[st * 400 + 384 + lane] = C12[r * 16 + hd * 4 + lane]; }
    LDSWAIT();
#pragma unroll 1
    for (int st = 0; st < 4; ++st) { const float* w5 = wl + st * 400; float p1 = 0.f, p2 = 0.f;
#pragma unroll
        for (int q = 0; q < 8; ++q) { const f32x4 kk = *(const f32x4*)(w5 + kh + 4 * q), wr = *(const f32x4*)(w5 + 64 + kh + 4 * q);
#pragma unroll
            for (int j = 0; j < 4; ++j) { p1 += S[4 * q + j] * kk[j]; p2 += S[4 * q + j] * wr[j]; } }
        p1 = dpp_add<0xB1>(p1); p2 = dpp_add<0xB1>(p2);
        const float sa = -p1, v = w5[320 + srow], c1 = w5[384], c2 = w5[385];
        if ((lane & 1) == 0) ((float*)(Yb + (size_t)(MP + b * 4 + st) * 5120))[hd * 64 + srow] = p2 + sa * c1 + v * c2;
#pragma unroll
        for (int q = 0; q < 8; ++q) { const f32x4 w = *(const f32x4*)(w5 + 128 + kh + 4 * q), kka = *(const f32x4*)(w5 + 192 + kh + 4 * q), kv = *(const f32x4*)(w5 + 256 + kh + 4 * q);
#pragma unroll
            for (int j = 0; j < 4; ++j) S[4 * q + j] = S[4 * q + j] * w[j] + sa * kka[j] + v * kv[j]; } }
    { float* dp = P.out() + O_SWKV + (((size_t)(l * 128 + b) * 4 + hd) * 64 + srow) * 64 + kh;
#pragma unroll
        for (int q = 0; q < 8; ++q) *(f32x4*)(dp + 4 * q) = (f32x4){S[4 * q], S[4 * q + 1], S[4 * q + 2], S[4 * q + 3]}; }
    LDSWAIT();
}

#ifndef PROBE_VAL
#define PROBE_VAL tacc
#endif
#ifndef PROBE_CMASK
#define PROBE_CMASK 15
#endif
#ifndef PROBE_DMASK
#define PROBE_DMASK 31
#endif
__device__ __forceinline__ void phaseC(const KP& P0, int l, unsigned char* smem) {
    { const KP P = get_kp(); float* z1 = (float*)(P.ws() + OFF_RSQ1); float* z2 = (float*)(P.ws() + OFF_RSQ2);
      for (int i = blockIdx.x * 512 + otid(); i < MP; i += gridDim.x * 512) { z1[i] = 0.f; z2[i] = 0.f; } }
    const int tid = otid();
    unsigned* ctr = (unsigned*)(P0.ws() + OFF_CTR) + 2 + l;
    volatile int* s_task = (volatile int*)(smem + LDS_TASK_OFF);
    for (;;) {
        __syncthreads();
        if (tid == 0) *s_task = (int)atomicAdd(ctr, 1u);
        __syncthreads();
        const int t = *s_task;
        if (t >= 1312) break;
        const KP P = get_kp();
#ifdef PROBE_SEL
        const unsigned long long c0_ = __builtin_amdgcn_s_memrealtime();
#endif
        const int pt = (t < 560 && !(t & 1)) ? (t >> 1) : -1, lt = (t < 560) ? ((t & 1) ? (t >> 1) : -1) : t - 280;
        if (pt >= 0) { if (pt < 248) rwkv_prep_tile<2>(P, l, smem, pt); else rwkv_prep_tile<1>(P, l, smem, 496 + (pt - 248)); }
        else if (lt < 256) s5_task(P, l, smem, 0, lt);
        else if (lt < 520) pool_tile(P, l, smem, lt - 256);
        else { const int u = lt - 520; hgrn_task(P, l, smem, 0, u >> 6, (u >> 4) & 3, u & 15); }
#ifdef PROBE_SEL
        if (l == 0 && tid == 0) { float* sl = (float*)(P.ws() + OFF_CTR) + 52 + (t < 280 ? 0 : (t < 536 ? 1 : (t < 800 ? 2 : 3))); *sl = (float)(__builtin_amdgcn_s_memrealtime() - c0_) * 0.01f; }
#endif
    }
}
__device__ __forceinline__ void phaseD(const KP& P0, int l, unsigned char* smem) {
    const int tid = otid();
#ifdef PROBE_SEL
    float ptt[5] = {0.f, 0.f, 0.f, 0.f, 0.f}, ptn[5] = {0.f, 0.f, 0.f, 0.f, 0.f}; unsigned long long pt0 = __builtin_amdgcn_s_memrealtime();
#endif
    if ((PROBE_DMASK & 1) && blockIdx.x < 128) rwkv_scan_task(P0, l, smem, true, blockIdx.x >> 4, (blockIdx.x >> 2) & 3, blockIdx.x & 3);
#ifdef PROBE_SEL
    ptt[0] = (float)(__builtin_amdgcn_s_memrealtime() - pt0) * 0.01f; ptn[0] = 1.f;
#endif
    unsigned* ctr = (unsigned*)(P0.ws() + OFF_CTR) + l;
    volatile int* s_task = (volatile int*)(smem + LDS_TASK_OFF);
    for (;;) {
        __syncthreads();
        if (tid == 0) *s_task = (int)atomicAdd(ctr, 1u);
        __syncthreads();
        const int t = *s_task;
        if (t >= 1416 + 576 + (l == 0 ? 160 : 0)) break;
        const KP P = get_kp();
#ifdef PROBE_SEL
        pt0 = __builtin_amdgcn_s_memrealtime();
#endif
        if (t < 264) s5_task(P, l, smem, 1, t);
        else if (t < 776) { const int u = t - 264; hgrn_task(P, l, smem, 1, u >> 6, (u >> 4) & 3, 15 - (u & 15)); }
        else if (t < 1288) { const int u = t - 776; if (PROBE_DMASK & 8) hgrn_task(P, l, smem, 2, u >> 2, u & 3, 0); }
        else if (t < 1416) { const int u = (t - 1288) * 8 + (tid >> 6); rwkv_sample_wave(P, l, smem, u >> 3, (u >> 1) & 3, u & 1); }
        else { const int it = (t - 1416) * 8 + (tid >> 6), lane = tid & 63; float* scr = (float*)smem + (tid >> 6) * (64 * 33);
            if (it < 512) transpose_item(P.in(35) + (size_t)l * 1024 * 1024, 1024, 1024, (bf16_t*)(P.ws() + OFF_WOUTT), scr, it, lane, nullptr);
            else if (it < 2560) transpose_item(P.in(37) + (size_t)l * 1024 * 4096, 1024, 4096, (bf16_t*)(P.ws() + OFF_UPT), scr, it - 512, lane, P.in(36) + l * 1024);
            else if (it < 4608) transpose_item(P.in(38) + (size_t)l * 4096 * 1024, 4096, 1024, (bf16_t*)(P.ws() + OFF_DOWNT), scr, it - 2560, lane, nullptr);
            else transpose_item(P.in(9) + (size_t)(l + 1) * 1024 * 2560, 1024, 2560, (bf16_t*)(P.ws() + OFF_WINT), scr, it - 4608, lane, P.in(8) + (l + 1) * 1024); }
#ifdef PROBE_SEL
        { const int ty = t < 512 ? 1 : (t < 776 ? 2 : (t < 1288 ? 3 : 4)); const float d = (float)(__builtin_amdgcn_s_memrealtime() - pt0) * 0.01f;
#pragma unroll
          for (int c = 1; c < 5; ++c) if (c == ty) { ptt[c] += d; ptn[c] += 1.f; } }
#endif
    }
#ifdef PROBE_SEL
    if (l == 0 && tid == 0 && (blockIdx.x == 0 || blockIdx.x == 200)) { float* sl = (float*)(P0.ws() + OFF_CTR) + (blockIdx.x == 0 ? 16 : 32);
#pragma unroll
        for (int c = 0; c < 5; ++c) { sl[c] = ptt[c]; sl[8 + c] = ptn[c]; } }
#endif
}
__device__ __forceinline__ void phaseE(const KP& P, int l) {
    const int tid = otid(), lane = tid & 63, wave = tid >> 6, gw = blockIdx.x * 8 + wave, NGW = gridDim.x * 8;
    const unsigned char* Yb = P.ws() + OFF_PROJ + 2560; const float* Vb = (const float*)(P.ws() + OFF_RW) + 5 * RWSZ; const float* C12 = (const float*)(P.ws() + OFF_C12);
    bf16_t* MIXED = (bf16_t*)(P.ws() + OFF_MIXED);
    const int c0 = lane * 4, hd = lane >> 4;
    const f32x4 lg = *(const f32x4*)(P.in(31) + l * 256 + c0), lbb = *(const f32x4*)(P.in(32) + l * 256 + c0);
#pragma unroll 1
    for (int rb = gw; rb < MT; rb += 8 * NGW) {
        f32x4 yv[8], vv[8]; u32x2 gv[8]; float bsv[8];
#pragma unroll
        for (int q = 0; q < 8; ++q) { const int r = min(rb + q * NGW, MT - 1);
            yv[q] = *(const f32x4*)((const float*)(Yb + (size_t)r * 5120) + c0); vv[q] = *(const f32x4*)(Vb + (size_t)r * 256 + c0);
            gv[q] = *(const u32x2*)(MIXED + (size_t)r * 1024 + 512 + c0); bsv[q] = C12[(size_t)r * 16 + hd * 4 + 2]; }
#pragma unroll
        for (int q = 0; q < 8; ++q) { const int r = rb + q * NGW; const f32x4 y = yv[q], v = vv[q];
            float s = y.x + y.y + y.z + y.w; s += shx(s, lane, 1); s += shx(s, lane, 2); s += shx(s, lane, 4); s += shx(s, lane, 8);
            const float mean = s * (1.f / 64.f); const f32x4 d = y - mean;
            float qq = d.x * d.x + d.y * d.y + d.z * d.z + d.w * d.w; qq += shx(qq, lane, 1); qq += shx(qq, lane, 2); qq += shx(qq, lane, 4); qq += shx(qq, lane, 8);
            const float rs = rsqrtf(qq * (1.f / 64.f) + 64e-5f); const float bs = bsv[q];
            float g[4], o[4]; unpack4(gv[q], g);
#pragma unroll
            for (int j = 0; j < 4; ++j) o[j] = (d[j] * rs * lg[j] + lbb[j] + bs * v[j]) * g[j];
            if (r < MT) *(u32x2*)(MIXED + (size_t)r * 1024 + 512 + c0) = pack4(o); }
    }
}

template <class Epi> __device__ __forceinline__ void run_gemm(unsigned char* smem, const bf16_t* A, const bf16_t* Bt, int M, int N, int K, const Epi& E) {
    pg8::Gemm g; g.A = A; g.Bt = Bt; g.M = M; g.N = N; g.K = K; g.ld = K;
    pg8::StaticOrder S; S.init(M, N, (int)gridDim.x, (int)blockIdx.x);
    __syncthreads();
    pg8::gemm_phase<Epi, pg8::StaticOrder, false>((PG8_LAS unsigned char*)smem, g, S, E, nullptr);
    __syncthreads();
}
struct ResidOrder {
    pg8::StaticOrder main; int S, kbytes, ntail, G, c;
    __device__ bool next(int i, pg8::Unit& u) const {
        if (main.next(i, u)) return true;
        const int L = i * G + c - main.nwg; if (L < 0 || L >= 8 * S) return false;
        const int t = L / S, ks = L - t * S; u.pm = 64 + (t >> 2); u.pn = t & 3; u.kb = ks * kbytes; u.nt = ntail; return true; }
    __device__ __forceinline__ void a_ready(const pg8::Unit&) const {}
    __device__ __forceinline__ void done(const pg8::Unit&) const {}
};
__device__ __forceinline__ void run_gemm_resid(unsigned char* smem, const bf16_t* A, const bf16_t* Bt, int K, int split, pg8::EpiResid& E) {
    pg8::Gemm g; g.A = A; g.Bt = Bt; g.M = MP; g.N = 1024; g.K = K; g.ld = K;
    ResidOrder S; S.main.init(MP, 1024, (int)gridDim.x, (int)blockIdx.x); S.S = split; S.kbytes = (K / split) * 2; S.ntail = (K / split) / 64; S.G = (int)gridDim.x; S.c = (int)blockIdx.x;
    E.kbytes = S.kbytes;
    __syncthreads();
    pg8::gemm_phase<pg8::EpiResid, ResidOrder, false>((PG8_LAS unsigned char*)smem, g, S, E, nullptr);
    __syncthreads();
}

__device__ __forceinline__ void gbar(unsigned* bar, unsigned& target) {
    __syncthreads();
    if (threadIdx.x == 0) {
        target += gridDim.x;
        __builtin_amdgcn_fence(__ATOMIC_RELEASE, "agent");
        __hip_atomic_fetch_add(bar, 1u, __ATOMIC_RELAXED, __HIP_MEMORY_SCOPE_AGENT);
        while (__hip_atomic_load(bar, __ATOMIC_RELAXED, __HIP_MEMORY_SCOPE_AGENT) < target) { }
        __builtin_amdgcn_fence(__ATOMIC_ACQUIRE, "agent");
    }
    __syncthreads();
}
#define SEAM(ID) do { if ((ID) == 0) grid.sync(); else gbar(bar, btarget); } while (0)
#ifdef PROBE_SEL
#define PH_END(ID) do { SEAM(ID); { const unsigned long long tn_ = __builtin_amdgcn_s_memrealtime(); const float d_ = (float)(tn_ - tprev) * 0.01f; tprev = tn_; const int ID_ = (ID); const int L_ = ID_ / 9, SUB_ = ID_ % 9; (void)L_; (void)SUB_; if (PROBE_SEL) tacc += d_; } } while (0)
#else
#define PH_END(ID) SEAM(ID)
#endif
__global__ void __launch_bounds__(512, 2) mega(Params Pk) {
    extern __shared__ __attribute__((aligned(16))) unsigned char smem[];
    cg::grid_group grid = cg::this_grid();
    unsigned long long tprev = 0ull; float tacc = 0.f;
    unsigned btarget = 0u; unsigned* bar = (unsigned*)(get_kp().ws() + OFF_CTR) + 8;
#ifdef PROBE_SEL
    tprev = __builtin_amdgcn_s_memrealtime();
#endif
#pragma unroll 1
    for (int ph = 0; ph < 18; ++ph) {
        int L = ph / 9; const int sub = ph - L * 9; L = __builtin_amdgcn_readfirstlane(L);
        if (sub == 0) phaseA(get_kp(), L, smem);
        else if (sub == 1 || sub == 7) { const KP P = get_kp(); pg8::EpiBf E; E.ACT = sub == 7; E.O = (bf16_t*)(P.ws() + (sub == 1 ? OFF_PROJ : OFF_HIDDEN)); E.ldc = sub == 1 ? 2560 : 4096; E.rsq = (const float*)(P.ws() + (sub == 1 ? OFF_RSQ1 : OFF_RSQ2));
            run_gemm(smem, (const bf16_t*)(P.ws() + (sub == 1 ? OFF_HB1 : OFF_XN2)), (const bf16_t*)(P.ws() + (sub == 1 ? OFF_WINT : OFF_UPT)), MT, sub == 1 ? 2560 : 4096, 1024, E); }
        else if (sub == 2) phaseC(get_kp(), L, smem);
        else if (sub == 3) phaseD(get_kp(), L, smem);
        else if (sub == 4) phaseE(get_kp(), L);
        else if (sub == 5 || sub == 8) { const KP P = get_kp(); pg8::EpiResid E; E.H = P.out(); E.Hin = (L == 0 && sub == 5) ? P.in(0) : P.out(); E.ldc = 1024; E.HB = (bf16_t*)(P.ws() + (sub == 5 ? OFF_XN2 : OFF_HB1)); E.rsq = (float*)(P.ws() + (sub == 5 ? OFF_RSQ2 : OFF_RSQ1));
            const bf16_t* A = (const bf16_t*)(P.ws() + (sub == 5 ? OFF_MIXED : OFF_HIDDEN)); const bf16_t* Bt = (const bf16_t*)(P.ws() + (sub == 5 ? OFF_WOUTT : OFF_DOWNT)); const int K = sub == 5 ? 1024 : 4096;
            E.PART = (float*)(P.ws() + OFF_PART); run_gemm_resid(smem, A, Bt, K, sub == 5 ? 4 : 8, E); }
        else phaseG(get_kp(), L, smem);
        PH_END(ph);
    }
#ifdef PROBE_SEL
    if (threadIdx.x == 0) { const KP P = get_kp(); ((int*)(P.ws() + WS_END))[blockIdx.x] = (int)((unsigned)__builtin_amdgcn_s_getreg((3 << 11) | 20) & 0xFu); }
#endif
    norm_rows(get_kp(), 0, 2);
#ifdef PROBE_SEL
    PH_END(18);
    float xmis = 0.f; { const KP P = get_kp(); const int* xt = (const int*)(P.ws() + WS_END); for (int i = 0; i < 256; ++i) xmis += (xt[i] != xt[i & 7]) ? 1.f : 0.f; } (void)xmis;
    if (blockIdx.x == 0) { const KP P = get_kp(); const float* sl = (const float*)(P.ws() + OFF_CTR); (void)sl; const float sc = 1.f + sqrtf((PROBE_VAL) * 1e-5f); for (int i = threadIdx.x; i < 16384; i += 512) P.out()[O_PSRE + i] *= sc; }
#endif
}

extern "C" void kernel_launch(void* const* d_in, const int* in_sizes, int n_in, void* d_out, int out_size, void* d_ws, size_t ws_size, hipStream_t stream) {
    static int grid = 0;
    if (grid == 0) {
        if (n_in != 40 || ws_size < WS_END) { fprintf(stderr, "kernel_launch: unexpected n_in %d / ws %zu\n", n_in, ws_size); grid = -1; return; }
        int dev = 0, cus = 0, per_cu = 0;
        hipGetDevice(&dev); hipDeviceGetAttribute(&cus, hipDeviceAttributeMultiprocessorCount, dev);
        if (hipFuncSetAttribute((const void*)mega, hipFuncAttributeMaxDynamicSharedMemorySize, LDS_BYTES) != hipSuccess) { fprintf(stderr, "kernel_launch: hipFuncSetAttribute failed\n"); grid = -1; return; }
        if (hipOccupancyMaxActiveBlocksPerMultiprocessor(&per_cu, (const void*)mega, 512, LDS_BYTES) != hipSuccess || per_cu < 1) { fprintf(stderr, "kernel_launch: occupancy query says %d\n", per_cu); per_cu = 1; }
        (void)hipGetLastError();
        grid = cus;
    }
    if (grid < 0) return;
    Params p{};
    for (int i = 0; i < 40; ++i) p.in[i] = (const float*)d_in[i];
    p.out = (float*)d_out; p.ws = (unsigned char*)d_ws;
    if (hipMemsetAsync((char*)d_ws + OFF_CTR + 32, 0, 4, stream) != hipSuccess) { fprintf(stderr, "kernel_launch: memset of the barrier word failed\n"); return; }
    void* args[] = {&p};
    hipError_t e = hipLaunchCooperativeKernel((const void*)mega, dim3(grid), dim3(512), args, LDS_BYTES, stream);
    if (e != hipSuccess) fprintf(stderr, "cooperative launch failed: %s (grid %d)\n", hipGetErrorString(e), grid);
}
```
